# Optimizing an MI355X kernel written in HIP

```python
import math
import jax
import jax.numpy as jnp
from jax import lax
import numpy as np

D_MODEL = 1024
BATCH = 2
SEQ = 8192
DEPTH = 2

GRID_W = 64
CTX_LEN = 256
N_BRANCH = 4
BRANCH_W = D_MODEL // N_BRANCH

HG_HEADS = 4
HG_DK = BRANCH_W // HG_HEADS
HG_DV = BRANCH_W // HG_HEADS
HG_CHUNK = 16

HY_W = BRANCH_W
HY_EMB = 33
HY_BANDS = (HY_EMB - 1) // 2
HY_ORDER = 64
HY_FAST_DECAY = 0.3
HY_SLOW_DECAY = 1.5
HY_TARGET = 1e-2

RET_HEADS = 4
RET_DK = BRANCH_W // (2 * RET_HEADS)
RET_DV = BRANCH_W // RET_HEADS
RET_CHUNK = 128
ROPE_BASE = 10000.0

S5_GROUP_CH = 16
S5_GROUPS = BRANCH_W // S5_GROUP_CH
S5_STATE = 64
S5_DT_MIN = 0.001
S5_DT_MAX = 0.1

MOE_GROUPS = 4
MOE_PER_GROUP = 8
MOE_EXPERTS = MOE_GROUPS * MOE_PER_GROUP
MOE_TOPK = 2
MOE_HIDDEN = D_MODEL // 2
MOE_BLOCK = 256

EPS = 1e-6

IN_SIZES = (BRANCH_W, BRANCH_W, BRANCH_W, BRANCH_W, BRANCH_W,
            3 * HY_W,
            RET_HEADS * RET_DK, RET_HEADS * RET_DK, BRANCH_W, BRANCH_W,
            BRANCH_W,
            N_BRANCH * D_MODEL)
N_IN = 5 * BRANCH_W + 3 * HY_W + 2 * RET_HEADS * RET_DK + 3 * BRANCH_W + N_BRANCH * D_MODEL

S5_DIR_PARAMS = ('s5_lam_re', 's5_lam_im', 's5_log_dt', 's5_b_re', 's5_b_im', 's5_c_re', 's5_c_im')

kernel_name = 'hybrid_gated_branch_hmoe_dit'


def rmsnorm(x, gain):
    xf = x.astype(jnp.float32)
    y = xf * lax.rsqrt(jnp.mean(xf * xf, axis=-1, keepdims=True) + EPS)
    return (y * gain.astype(jnp.float32)).astype(x.dtype)


def modulate(x, gain, shift, scale):
    return rmsnorm(x, gain) * (1.0 + scale) + shift


def split_heads(a, n):
    return a.reshape(a.shape[0], a.shape[1], n, a.shape[-1] // n)


def head_rmsnorm(o, gain):
    of = o.astype(jnp.float32)
    of = of * lax.rsqrt(jnp.mean(of * of, axis=-1, keepdims=True) + EPS)
    return of.reshape(o.shape[0], o.shape[1], -1) * gain


def head_groupnorm(o, gain):
    of = o.astype(jnp.float32)
    of = of - jnp.mean(of, axis=-1, keepdims=True)
    of = of * lax.rsqrt(jnp.mean(of * of, axis=-1, keepdims=True) + EPS)
    return of.reshape(o.shape[0], o.shape[1], -1) * gain


def bidirectional(scan_f, scan_b, ctx_f, ctx_b, lat_f, lat_b, s0):
    flip = lambda a: jnp.flip(a, axis=1)
    yc_f, sc_f = scan_f(ctx_f, s0)
    yl_f, _ = scan_f(lat_f, sc_f)
    yc_b, sc_b = scan_b(tuple(flip(a) for a in ctx_b), s0)
    yl_b, _ = scan_b(tuple(flip(a) for a in lat_b), sc_b)
    return yc_f + flip(yc_b), yl_f + flip(yl_b)


def hgrn2_gates(f_pre, lb):
    z = f_pre.astype(jnp.float32)
    f = lb + (1.0 - lb) * jax.nn.sigmoid(z)
    log_f = jnp.log(f)
    k = (1.0 - lb) * jax.nn.sigmoid(-z)
    return log_f, k


def gated_chunk_recurrence(q, k, v, log_f, s0):
    bsz, L, H, dk = q.shape
    dv = v.shape[-1]
    C = HG_CHUNK
    n = L // C
    q, k, log_f = (a.astype(jnp.float32).reshape(bsz, n, C, H, dk) for a in (q, k, log_f))
    v = v.astype(jnp.float32).reshape(bsz, n, C, H, dv)
    b = jnp.cumsum(log_f, axis=2)
    b_last = b[:, :, -1:]
    causal = jnp.tril(jnp.ones((C, C), dtype=bool))[None, None, :, :, None, None]
    rel = jnp.where(causal, b[:, :, :, None] - b[:, :, None], 0.0)
    dec = jnp.where(causal, jnp.exp(rel), 0.0)
    scores = jnp.einsum('bnthd,bnshd,bntshd->bnhts', q, k, dec)
    o = jnp.einsum('bnhts,bnshe->bnthe', scores, v)
    chunk_kv = jnp.einsum('bnshd,bnshe->nbhde', k * jnp.exp(b_last - b), v)
    chunk_decay = jnp.moveaxis(jnp.exp(b_last[:, :, 0]), 1, 0)

    def step(s, inp):
        dc, kv = inp
        return dc[..., None] * s + kv, s

    s_final, s_start = lax.scan(step, s0.astype(jnp.float32), (chunk_decay, chunk_kv))
    o = o + jnp.einsum('bnthd,nbhde->bnthe', q * jnp.exp(b), s_start)
    return o.reshape(bsz, L, H, dv), s_final


def rope(x, pos):
    d = x.shape[-1]
    freqs = ROPE_BASE ** (-jnp.arange(0, d, 2, dtype=jnp.float32) / d)
    ang = pos.astype(jnp.float32)[:, None] * freqs
    cos = jnp.cos(ang)[None, :, None, :]
    sin = jnp.sin(ang)[None, :, None, :]
    x1, x2 = jnp.split(x.astype(jnp.float32), 2, axis=-1)
    return jnp.concatenate([x1 * cos - x2 * sin, x1 * sin + x2 * cos], axis=-1)


def axial_rope(x, row_pos, col_pos):
    half = x.shape[-1] // 2
    return jnp.concatenate([rope(x[..., :half], row_pos), rope(x[..., half:], col_pos)], axis=-1)


def retention_chunked(q, k, v, log_gamma, s0):
    bsz, L, H, dk = q.shape
    dv = v.shape[-1]
    C = RET_CHUNK
    n = L // C
    q = q.astype(jnp.float32).reshape(bsz, n, C, H, dk)
    k = k.astype(jnp.float32).reshape(bsz, n, C, H, dk)
    v = v.astype(jnp.float32).reshape(bsz, n, C, H, dv)
    pos = jnp.arange(C, dtype=jnp.float32)
    rel = pos[:, None] - pos[None, :]
    lower = rel >= 0
    decay = jnp.where(lower, jnp.exp(jnp.where(lower, rel, 0.0) * log_gamma[:, None, None]), 0.0)
    scores = jnp.einsum('bnthd,bnshd->bnhts', q, k) * decay
    o = jnp.einsum('bnhts,bnshe->bnthe', scores, v)
    k_dec = jnp.exp((C - 1.0 - pos)[:, None] * log_gamma)
    q_dec = jnp.exp((pos + 1.0)[:, None] * log_gamma)
    chunk_kv = jnp.einsum('bnshd,bnshe,sh->nbhde', k, v, k_dec)
    g = jnp.exp(C * log_gamma)[:, None, None]

    def step(s, kv):
        return g * s + kv, s

    s_final, s_start = lax.scan(step, s0.astype(jnp.float32), chunk_kv)
    o = o + jnp.einsum('bnthd,nbhde,th->bnthe', q, s_start, q_dec)
    return o.reshape(bsz, L, H, dv), s_final


def short_conv_centred(u, w, b):
    up = jnp.pad(u, ((0, 0), (1, 1), (0, 0)))
    return up[:, :-2] * w[0] + up[:, 1:-1] * w[1] + up[:, 2:] * w[2] + b


def hyena_filters(L, w1, b1, fr1, w2, b2, fr2, w3):
    t = jnp.linspace(0.0, 1.0, L, dtype=jnp.float32)[:, None]
    w = (2.0 * math.pi / L) * jnp.arange(L, dtype=jnp.float32)[:, None]
    f = jnp.linspace(1e-4, HY_BANDS - 1.0, HY_BANDS, dtype=jnp.float32)[None, :]
    z = jnp.concatenate([t, jnp.cos(f * w), -jnp.sin(f * w)], axis=-1)
    hid = jnp.sin(fr1 * (z @ w1 + b1))
    hid = jnp.sin(fr2 * (hid @ w2 + b2))
    filt = (hid @ w3).astype(jnp.float32)
    deltas = jnp.abs(jnp.linspace(math.log(HY_TARGET) / HY_SLOW_DECAY,
                                  math.log(HY_TARGET) / HY_FAST_DECAY, HY_W, dtype=jnp.float32))
    window = jnp.exp(-t * deltas)
    h_fwd = filt[:, :HY_W] * window
    h_bwd = filt[:, HY_W:] * window
    filt2 = jnp.concatenate([h_fwd, jnp.zeros((1, HY_W), jnp.float32), h_bwd[1:][::-1]], axis=0)
    return filt2 * lax.rsqrt(jnp.sum(filt2 * filt2, axis=0, keepdims=True) + EPS)


def long_conv_fft(u, filt):
    L = u.shape[1]
    uf = jnp.fft.rfft(u.astype(jnp.float32), n=2 * L, axis=1)
    kf = jnp.fft.rfft(filt, n=2 * L, axis=0)
    return jnp.fft.irfft(uf * kf[None], n=2 * L, axis=1)[:, :L]


def hyena(u3, p):
    L = u3.shape[1]
    u3 = short_conv_centred(u3, p['hy_conv_w'], p['hy_conv_b'])
    x0, x1, v = jnp.split(u3, 3, axis=-1)
    v = (v * x1).astype(jnp.float32)
    filt = hyena_filters(L, p['hy_filt_w1'], p['hy_filt_b1'], p['hy_filt_freq1'],
                         p['hy_filt_w2'], p['hy_filt_b2'], p['hy_filt_freq2'], p['hy_filt_w3'])
    y = long_conv_fft(v, filt) + v * p['hy_skip']
    return y * x0


def _linear_combine(e1, e2):
    a1, b1 = e1
    a2, b2 = e2
    return a1 * a2, a2 * b1 + b2


def s5_scan(u, s0, lam_re, lam_im, log_dt, b_re, b_im, c_re, c_im):
    bsz, L, _ = u.shape
    uc = u.astype(jnp.float32).reshape(bsz, L, S5_GROUPS, S5_GROUP_CH).astype(jnp.complex64)
    lam = lax.complex(jnp.minimum(lam_re.astype(jnp.float32), -1e-4), lam_im.astype(jnp.float32))
    a_bar = jnp.exp(lam * jnp.exp(log_dt.astype(jnp.float32))[:, None])
    b_bar = ((a_bar - 1.0) / lam)[..., None] * lax.complex(b_re.astype(jnp.float32), b_im.astype(jnp.float32))
    bu = jnp.einsum('gpc,blgc->blgp', b_bar, uc)
    bu = bu.at[:, 0].add(a_bar * s0)
    _, xs = lax.associative_scan(_linear_combine, (jnp.broadcast_to(a_bar, bu.shape), bu), axis=1)
    c_mat = lax.complex(c_re.astype(jnp.float32), c_im.astype(jnp.float32))
    y = jnp.einsum('gcp,blgp->blgc', c_mat, xs).real
    return y.reshape(bsz, L, S5_GROUPS * S5_GROUP_CH), xs[:, -1]


def token_mixer(h, hc, row_pos, col_pos, p, with_ctx_out):
    splits = list(np.cumsum(IN_SIZES)[:-1])
    zl = jnp.split(h @ p['w_in'], splits, axis=-1)
    zc = jnp.split(hc @ p['w_in'], splits, axis=-1)
    bsz = h.shape[0]

    def hg_args(z, d):
        log_f, k = hgrn2_gates(split_heads(z[1 + d], HG_HEADS), p['hg_lb'][d])
        return (split_heads(z[0], HG_HEADS), k, split_heads(z[3], HG_HEADS), log_f)

    hg_scan = lambda args, s0: gated_chunk_recurrence(*args, s0)
    hg_s0 = jnp.zeros((bsz, HG_HEADS, HG_DK, HG_DV), jnp.float32)
    hg_c, hg_l = bidirectional(hg_scan, hg_scan, hg_args(zc, 0), hg_args(zc, 1),
                               hg_args(zl, 0), hg_args(zl, 1), hg_s0)
    hg_read = lambda o, z: head_rmsnorm(o, p['hg_norm']) * jax.nn.silu(z[4])

    log_gamma = jax.nn.log_sigmoid(p['ret_decay_logit'].astype(jnp.float32))

    def rt_args(z, rotate):
        q = split_heads(z[6], RET_HEADS)
        k = split_heads(z[7], RET_HEADS) * RET_DK ** -0.5
        if rotate:
            q, k = axial_rope(q, row_pos, col_pos), axial_rope(k, row_pos, col_pos)
        return (q, k, split_heads(z[8], RET_HEADS))

    rt_f = lambda args, s0: retention_chunked(*args, log_gamma[0], s0)
    rt_b = lambda args, s0: retention_chunked(*args, log_gamma[1], s0)
    rt_s0 = jnp.zeros((bsz, RET_HEADS, RET_DK, RET_DV), jnp.float32)
    rc_args, rl_args = rt_args(zc, False), rt_args(zl, True)
    rt_c, rt_l = bidirectional(rt_f, rt_b, rc_args, rc_args, rl_args, rl_args, rt_s0)
    rt_read = lambda o, z: head_groupnorm(o, p['ret_norm']) * jax.nn.silu(z[9])

    def s5_dir(d):
        prm = tuple(p[name][d] for name in S5_DIR_PARAMS)
        return lambda args, s0: s5_scan(args[0], s0, *prm)

    s5_s0 = jnp.zeros((bsz, S5_GROUPS, S5_STATE), jnp.complex64)
    s5_c, s5_l = bidirectional(s5_dir(0), s5_dir(1), (zc[10],), (zc[10],), (zl[10],), (zl[10],), s5_s0)

    def s5_read(y, z):
        y = jax.nn.gelu(y + z[10].astype(jnp.float32) * p['s5_d'])
        return (y @ p['s5_glu_w1']) * jax.nn.sigmoid(y @ p['s5_glu_w2'])

    def merge(z, branches):
        st = jnp.stack(branches, axis=2)
        proj = jnp.einsum('blnk,nkd->blnd', st, p['w_branch'])
        gates = jax.nn.sigmoid(z[11].reshape(st.shape[0], st.shape[1], N_BRANCH, D_MODEL))
        return jnp.sum(gates * proj, axis=2) @ p['w_out']

    out_l = merge(zl, [hg_read(hg_l, zl), hyena(zl[5], p), rt_read(rt_l, zl), s5_read(s5_l, zl)])
    if not with_ctx_out:
        return out_l, None
    out_c = merge(zc, [hg_read(hg_c, zc), hyena(zc[5], p), rt_read(rt_c, zc), s5_read(s5_c, zc)])
    return out_l, out_c


def swiglu(xb, w1, w3, w2):
    return (jax.nn.silu(xb @ w1) * (xb @ w3)) @ w2


def hierarchical_moe(h, p):
    n_tok, d = h.shape
    hf = h.astype(jnp.float32)
    grp_prob = jax.nn.softmax(hf @ p['moe_w_grp'].astype(jnp.float32) + p['moe_b_grp'], axis=-1)
    grp_p, grp_i = lax.top_k(grp_prob, 1)
    exp_logits = (hf @ p['moe_w_exp'].astype(jnp.float32) + p['moe_b_exp']).reshape(
        n_tok, MOE_GROUPS, MOE_PER_GROUP)
    exp_logits = jnp.take_along_axis(exp_logits, grp_i[:, :, None], axis=1)[:, 0]
    top_p, top_i = lax.top_k(jax.nn.softmax(exp_logits, axis=-1), MOE_TOPK)
    weight = (grp_p * top_p / jnp.sum(top_p, axis=-1, keepdims=True)).reshape(-1)
    expert = (grp_i * MOE_PER_GROUP + top_i).reshape(-1)
    token = jnp.repeat(jnp.arange(n_tok), MOE_TOPK)
    n_assign = n_tok * MOE_TOPK
    order = jnp.argsort(expert)
    e_s, tok_s, w_s = expert[order], token[order], weight[order]
    counts = jnp.zeros((MOE_EXPERTS,), jnp.int32).at[expert].add(1)
    padded = (counts + MOE_BLOCK - 1) // MOE_BLOCK * MOE_BLOCK
    pad_end = jnp.cumsum(padded)
    pad_start = pad_end - padded
    start = jnp.cumsum(counts) - counts
    dest = pad_start[e_s] + jnp.arange(n_assign) - start[e_s]
    n_blocks = -(-n_assign // MOE_BLOCK) + MOE_EXPERTS
    buf = jnp.zeros((n_blocks * MOE_BLOCK, d), h.dtype).at[dest].set(h[tok_s])
    block_expert = jnp.minimum(
        jnp.searchsorted(pad_end, jnp.arange(n_blocks) * MOE_BLOCK, side='right'), MOE_EXPERTS - 1)

    def expert_block(args):
        xb, e = args
        return swiglu(xb, p['moe_w1'][e], p['moe_w3'][e], p['moe_w2'][e])

    y = lax.map(expert_block, (buf.reshape(n_blocks, MOE_BLOCK, d), block_expert)).reshape(-1, d)
    out = jnp.zeros((n_tok, d), jnp.float32).at[tok_s].add(y[dest].astype(jnp.float32) * w_s[:, None])
    return out.astype(h.dtype)


def trunk_layer(x, ctx, c_act, c_ctx_act, row_pos, col_pos, p, last):
    sh1, sc1, g1, sh2, sc2, g2 = (m[:, None] for m in jnp.split(c_act @ p['w_mod'] + p['b_mod'], 6, axis=-1))
    csh1, csc1, cg1, csh2, csc2, cg2 = jnp.split(c_ctx_act @ p['w_mod'] + p['b_mod'], 6, axis=-1)
    h = modulate(x, p['norm1'], sh1, sc1)
    hc = modulate(ctx, p['norm1'], csh1, csc1)
    mix, mix_c = token_mixer(h, hc, row_pos, col_pos, p, not last)
    x = x + g1 * mix
    bsz, L, d = x.shape
    h2 = modulate(x, p['norm2'], sh2, sc2).reshape(-1, d)
    if last:
        return x + g2 * hierarchical_moe(h2, p).reshape(bsz, L, d), ctx
    ctx = ctx + cg1 * mix_c
    hc2 = modulate(ctx, p['norm2'], csh2, csc2).reshape(-1, d)
    n_ctx = hc2.shape[0]
    y = hierarchical_moe(jnp.concatenate([hc2, h2], axis=0), p)
    ctx = ctx + cg2 * y[:n_ctx].reshape(ctx.shape)
    x = x + g2 * y[n_ctx:].reshape(bsz, L, d)
    return x, ctx


def setup_inputs(seed: int = 0) -> dict:
    key = jax.random.key(seed)
    keys = jax.random.split(key, 64)
    counter = iter(range(64))

    def nrm(shape, scale):
        return scale * jax.random.normal(keys[next(counter)], shape, jnp.float32)

    def gain(shape):
        return 1.0 + nrm(shape, 0.01)

    L = DEPTH
    D = D_MODEL
    ret_logit0 = jnp.log(2.0 ** (5.0 + jnp.arange(RET_HEADS, dtype=jnp.float32)) - 1.0)
    lam_im0 = math.pi * jnp.arange(S5_STATE, dtype=jnp.float32)
    return {
        'x': nrm((BATCH, SEQ, D), 1.0),
        'c': nrm((BATCH, D), 1.0),
        'ctx': nrm((BATCH, CTX_LEN, D), 1.0),
        'c_ctx': nrm((D,), 1.0),
        'w_mod': nrm((L, D, 6 * D), 0.5 * D ** -0.5),
        'b_mod': nrm((L, 6 * D), 0.01),
        'norm1': gain((L, D)),
        'norm2': gain((L, D)),
        'w_in': nrm((L, D, N_IN), D ** -0.5),
        'hg_lb_logits': nrm((L, 2, HG_HEADS * HG_DK), 0.1),
        'hg_norm': gain((L, HG_HEADS * HG_DV)),
        'hy_conv_w': nrm((L, 3, 3 * HY_W), 3 ** -0.5),
        'hy_conv_b': nrm((L, 3 * HY_W), 0.01),
        'hy_filt_w1': nrm((L, HY_EMB, HY_ORDER), HY_EMB ** -0.5),
        'hy_filt_b1': nrm((L, HY_ORDER), 0.1),
        'hy_filt_freq1': gain((L, HY_ORDER)),
        'hy_filt_w2': nrm((L, HY_ORDER, HY_ORDER), HY_ORDER ** -0.5),
        'hy_filt_b2': nrm((L, HY_ORDER), 0.1),
        'hy_filt_freq2': gain((L, HY_ORDER)),
        'hy_filt_w3': nrm((L, HY_ORDER, 2 * HY_W), HY_ORDER ** -0.5),
        'hy_skip': nrm((L, HY_W), 1.0),
        'ret_decay_logit': ret_logit0 + nrm((L, 2, RET_HEADS), 0.01),
        'ret_norm': gain((L, RET_HEADS * RET_DV)),
        's5_lam_re': -0.5 + nrm((L, 2, S5_GROUPS, S5_STATE), 0.01),
        's5_lam_im': lam_im0 + nrm((L, 2, S5_GROUPS, S5_STATE), 0.01),
        's5_log_dt': jax.random.uniform(keys[next(counter)], (L, 2, S5_GROUPS), jnp.float32,
                                        math.log(S5_DT_MIN), math.log(S5_DT_MAX)),
        's5_b_re': nrm((L, 2, S5_GROUPS, S5_STATE, S5_GROUP_CH), S5_GROUP_CH ** -0.5),
        's5_b_im': nrm((L, 2, S5_GROUPS, S5_STATE, S5_GROUP_CH), S5_GROUP_CH ** -0.5),
        's5_c_re': nrm((L, 2, S5_GROUPS, S5_GROUP_CH, S5_STATE), S5_STATE ** -0.5),
        's5_c_im': nrm((L, 2, S5_GROUPS, S5_GROUP_CH, S5_STATE), S5_STATE ** -0.5),
        's5_d': nrm((L, BRANCH_W), 1.0),
        's5_glu_w1': nrm((L, BRANCH_W, BRANCH_W), BRANCH_W ** -0.5),
        's5_glu_w2': nrm((L, BRANCH_W, BRANCH_W), BRANCH_W ** -0.5),
        'w_branch': nrm((L, N_BRANCH, BRANCH_W, D), BRANCH_W ** -0.5),
        'w_out': nrm((L, D, D), D ** -0.5),
        'moe_w_grp': nrm((L, D, MOE_GROUPS), D ** -0.5),
        'moe_b_grp': nrm((L, MOE_GROUPS), 0.01),
        'moe_w_exp': nrm((L, D, MOE_EXPERTS), D ** -0.5),
        'moe_b_exp': nrm((L, MOE_EXPERTS), 0.01),
        'moe_w1': nrm((L, MOE_EXPERTS, D, MOE_HIDDEN), D ** -0.5),
        'moe_w3': nrm((L, MOE_EXPERTS, D, MOE_HIDDEN), D ** -0.5),
        'moe_w2': nrm((L, MOE_EXPERTS, MOE_HIDDEN, D), MOE_HIDDEN ** -0.5),
        'norm_final': gain((D,)),
    }


def reference(x, c, ctx, c_ctx, w_mod, b_mod, norm1, norm2, w_in, hg_lb_logits, hg_norm,
              hy_conv_w, hy_conv_b, hy_filt_w1, hy_filt_b1, hy_filt_freq1, hy_filt_w2, hy_filt_b2,
              hy_filt_freq2, hy_filt_w3, hy_skip, ret_decay_logit, ret_norm,
              s5_lam_re, s5_lam_im, s5_log_dt, s5_b_re, s5_b_im, s5_c_re, s5_c_im, s5_d,
              s5_glu_w1, s5_glu_w2, w_branch, w_out, moe_w_grp, moe_b_grp, moe_w_exp, moe_b_exp,
              moe_w1, moe_w3, moe_w2, norm_final):
    rows = x.shape[1] // GRID_W
    row_pos = jnp.repeat(jnp.arange(rows), GRID_W)
    col_pos = jnp.tile(jnp.arange(GRID_W), rows)
    lb_sm = jax.nn.softmax(hg_lb_logits.astype(jnp.float32), axis=0)
    lb_all = jnp.cumsum(lb_sm, axis=0) - lb_sm[0]
    c_act = jax.nn.silu(c)
    c_ctx_act = jax.nn.silu(c_ctx)
    stacked = dict(w_mod=w_mod, b_mod=b_mod, norm1=norm1, norm2=norm2, w_in=w_in, hg_norm=hg_norm,
                   hy_conv_w=hy_conv_w, hy_conv_b=hy_conv_b, hy_filt_w1=hy_filt_w1, hy_filt_b1=hy_filt_b1,
                   hy_filt_freq1=hy_filt_freq1, hy_filt_w2=hy_filt_w2, hy_filt_b2=hy_filt_b2,
                   hy_filt_freq2=hy_filt_freq2, hy_filt_w3=hy_filt_w3, hy_skip=hy_skip,
                   ret_decay_logit=ret_decay_logit, ret_norm=ret_norm,
                   s5_lam_re=s5_lam_re, s5_lam_im=s5_lam_im, s5_log_dt=s5_log_dt, s5_b_re=s5_b_re,
                   s5_b_im=s5_b_im, s5_c_re=s5_c_re, s5_c_im=s5_c_im, s5_d=s5_d,
                   s5_glu_w1=s5_glu_w1, s5_glu_w2=s5_glu_w2, w_branch=w_branch, w_out=w_out,
                   moe_w_grp=moe_w_grp, moe_b_grp=moe_b_grp, moe_w_exp=moe_w_exp, moe_b_exp=moe_b_exp,
                   moe_w1=moe_w1, moe_w3=moe_w3, moe_w2=moe_w2)
    for l in range(DEPTH):
        p = {name: arr[l] for name, arr in stacked.items()}
        p['hg_lb'] = lb_all[l].reshape(2, HG_HEADS, HG_DK)
        x, ctx = trunk_layer(x, ctx, c_act, c_ctx_act, row_pos, col_pos, p, l == DEPTH - 1)
    return rmsnorm(x, norm_final)
```

```cpp
#include <hip/hip_runtime.h>
#include <hip/hip_cooperative_groups.h>
#include <stdint.h>
#include <stdio.h>
namespace cg = cooperative_groups;

typedef unsigned short bf16_t;
typedef short bf16x8 __attribute__((ext_vector_type(8)));
typedef float f32x4 __attribute__((ext_vector_type(4)));
typedef float f32x16 __attribute__((ext_vector_type(16)));

#define DM 1024
#define NTOK 16896
#define NCTX 512
#define NLAT 16384
#define SEQL 8192
#define CTXL 256
#define NIN 7168
#define NMIX 3072
#define NSTEP 8448
#define EPSF 1e-6f
#define NCHUNK 132
#define FFT_N 16384
#define NTHREADS 512
#define NWAVES 8
#define LDS_FFT_BYTES 139264
#define LDS_BYTES (LDS_FFT_BYTES + 16)

#define C_HGQ 0
#define C_HGF 256
#define C_HGI 768
#define C_HGG 1024
#define C_HY 1280
#define C_RQ 2048
#define C_RK 2176
#define C_RV 2304
#define C_RG 2560
#define C_S5 2816

enum { I_X = 0, I_C, I_CTX, I_CCTX, I_WMOD, I_BMOD, I_NORM1, I_NORM2, I_WIN, I_HGLB, I_HGNORM, I_HYCW, I_HYCB, I_HYW1, I_HYB1, I_HYF1,
       I_HYW2, I_HYB2, I_HYF2, I_HYW3, I_HYSKIP, I_RETDEC, I_RETNORM, I_S5LRE, I_S5LIM, I_S5LDT, I_S5BRE, I_S5BIM, I_S5CRE, I_S5CIM,
       I_S5D, I_GLU1, I_GLU2, I_WBR, I_WOUT, I_WGRP, I_BGRP, I_WEXP, I_BEXP, I_MW1, I_MW3, I_MW2, I_NORMF, N_INPUTS };

constexpr size_t al256c(size_t x) { return (x + 255) & ~(size_t)255; }
struct WsLayout { size_t aslot, xbuf, hbf, zmix, rope, hgo, rto, s5o, br, s5g, mod, modpart, lb, s5a, s5b, hraw, hrawc, hscale, hscalec, twid, hgU, hgD, rtU, s5u, sX, sXS, s5Tz, s5Nn, s5Mm, WinT, WbrT, WoutT, GluT, xbar, cnt, alist, rw, rsel, total; };
constexpr WsLayout make_ws_layout() {
  WsLayout L{}; size_t off = 0;
  L.aslot = off; off = al256c(off + (size_t)NTOK * 2 * 4);
  L.xbuf = off; off = al256c(off + (size_t)NTOK * DM * 4);
  L.hbf = off; off = al256c(off + (size_t)NTOK * DM * 2);
  L.zmix = off; off = al256c(off + (size_t)NTOK * 4096 * 2);
  L.rope = off; off = al256c(off + 128 * 8 * 2 * 4);
  L.hgo = off; off = al256c(off + (size_t)2 * NTOK * 256 * 4);
  L.rto = off; off = al256c(off + (size_t)2 * NTOK * 256 * 4);
  L.s5o = off; off = al256c(off + (size_t)2 * NTOK * 256 * 4);
  L.br = off; off = al256c(off + (size_t)NTOK * DM * 2);
  L.s5g = off; off = al256c(off + (size_t)NTOK * 256 * 2);
  L.mod = off; off = al256c(off + (size_t)2 * 3 * 6144 * 4);
  L.modpart = off; off = al256c(off + (size_t)8 * 2 * 3 * 6144 * 4);
  L.lb = off; off = al256c(off + 1024 * 4);
  L.s5a = off; off = al256c(off + 4096 * 2 * 4);
  L.s5b = off; off = al256c(off + 4096 * 16 * 2 * 4);
  L.hraw = off; off = al256c(off + (size_t)2 * 2 * 256 * SEQL * 4);
  L.hrawc = off; off = al256c(off + (size_t)2 * 256 * CTXL * 4);
  L.hscale = off; off = al256c(off + 512 * 4);
  L.hscalec = off; off = al256c(off + 256 * 4);
  L.twid = off; off = al256c(off + (size_t)FFT_N * 2 * 4);
  L.hgU = off; off = al256c(off + (size_t)16 * NCHUNK * 4096 * 4);
  L.hgD = off; off = al256c(off + (size_t)16 * NCHUNK * 64 * 4);
  L.rtU = off; off = al256c(off + (size_t)16 * NCHUNK * 2048 * 4);
  L.s5u = off; off = al256c(off + (size_t)16 * 1280 * 256 * 2);
  L.sX = off; off = al256c(off + (size_t)16 * 1280 * 256 * 4);
  L.sXS = off; off = al256c(off + (size_t)16 * 1280 * 256 * 2);
  L.s5Tz = off; off = al256c(off + (size_t)32 * 65536 * 2);
  L.s5Nn = off; off = al256c(off + (size_t)32 * 65536 * 2);
  L.s5Mm = off; off = al256c(off + (size_t)32 * 65536 * 2);
  L.WinT = off; off = al256c(off + (size_t)2 * NIN * DM * 2);
  L.WbrT = off; off = al256c(off + (size_t)2 * 4 * DM * 256 * 2);
  L.WoutT = off; off = al256c(off + (size_t)2 * DM * DM * 2);
  L.GluT = off; off = al256c(off + (size_t)2 * 512 * 256 * 2);
  L.xbar = off; off = al256c(off + 3456 * 4);
  L.cnt = off; off = al256c(off + 64 * 32 * 4);
  L.alist = off; off = al256c(off + (size_t)32 * NTOK * 4);
  L.rw = off; off = al256c(off + (size_t)NTOK * 2 * 4);
  L.rsel = off; off = al256c(off + (size_t)NTOK * 4 * 4);
  L.total = off; return L;
}
constexpr WsLayout WS = make_ws_layout();
struct Params {
  const float* in[N_INPUTS];
  float* out;
  char* ws;
  __device__ __forceinline__ int* aslot() const { return (int*)(ws + WS.aslot); }
  __device__ __forceinline__ float* xbuf() const { return (float*)(ws + WS.xbuf); }
  __device__ __forceinline__ bf16_t* hbf() const { return (bf16_t*)(ws + WS.hbf); }
  __device__ __forceinline__ bf16_t* zmix() const { return (bf16_t*)(ws + WS.zmix); }
  __device__ __forceinline__ float* rope() const { return (float*)(ws + WS.rope); }
  __device__ __forceinline__ float* hgo() const { return (float*)(ws + WS.hgo); }
  __device__ __forceinline__ float* rto() const { return (float*)(ws + WS.rto); }
  __device__ __forceinline__ float* s5o() const { return (float*)(ws + WS.s5o); }
  __device__ __forceinline__ bf16_t* br() const { return (bf16_t*)(ws + WS.br); }
  __device__ __forceinline__ bf16_t* s5g() const { return (bf16_t*)(ws + WS.s5g); }
  __device__ __forceinline__ float* mod() const { return (float*)(ws + WS.mod); }
  __device__ __forceinline__ float* modpart() const { return (float*)(ws + WS.modpart); }
  __device__ __forceinline__ float* lb() const { return (float*)(ws + WS.lb); }
  __device__ __forceinline__ float* s5a() const { return (float*)(ws + WS.s5a); }
  __device__ __forceinline__ float* s5b() const { return (float*)(ws + WS.s5b); }
  __device__ __forceinline__ float* hraw() const { return (float*)(ws + WS.hraw); }
  __device__ __forceinline__ float* hrawc() const { return (float*)(ws + WS.hrawc); }
  __device__ __forceinline__ float* hscale() const { return (float*)(ws + WS.hscale); }
  __device__ __forceinline__ float* hscalec() const { return (float*)(ws + WS.hscalec); }
  __device__ __forceinline__ float* twid() const { return (float*)(ws + WS.twid); }
  __device__ __forceinline__ float* hgU() const { return (float*)(ws + WS.hgU); }
  __device__ __forceinline__ float* hgD() const { return (float*)(ws + WS.hgD); }
  __device__ __forceinline__ float* rtU() const { return (float*)(ws + WS.rtU); }
  __device__ __forceinline__ bf16_t* s5u() const { return (bf16_t*)(ws + WS.s5u); }
  __device__ __forceinline__ float* sX() const { return (float*)(ws + WS.sX); }
  __device__ __forceinline__ bf16_t* sXS() const { return (bf16_t*)(ws + WS.sXS); }
  __device__ __forceinline__ bf16_t* s5Tz() const { return (bf16_t*)(ws + WS.s5Tz); }
  __device__ __forceinline__ bf16_t* s5Nn() const { return (bf16_t*)(ws + WS.s5Nn); }
  __device__ __forceinline__ bf16_t* s5Mm() const { return (bf16_t*)(ws + WS.s5Mm); }
  __device__ __forceinline__ bf16_t* WinT() const { return (bf16_t*)(ws + WS.WinT); }
  __device__ __forceinline__ bf16_t* WbrT() const { return (bf16_t*)(ws + WS.WbrT); }
  __device__ __forceinline__ bf16_t* WoutT() const { return (bf16_t*)(ws + WS.WoutT); }
  __device__ __forceinline__ bf16_t* GluT() const { return (bf16_t*)(ws + WS.GluT); }
  __device__ __forceinline__ unsigned* xbar() const { return (unsigned*)(ws + WS.xbar); }
  __device__ __forceinline__ int* cnt() const { return (int*)(ws + WS.cnt); }
  __device__ __forceinline__ int* alist() const { return (int*)(ws + WS.alist); }
  __device__ __forceinline__ float* rw() const { return (float*)(ws + WS.rw); }
  __device__ __forceinline__ float* rsel() const { return (float*)(ws + WS.rsel); }
  __device__ __forceinline__ bf16_t* merged() const { return (bf16_t*)(ws + WS.hbf + 0); }
  __device__ __forceinline__ float* hyT() const { return (float*)(ws + WS.hgo + 0); }
  __device__ __forceinline__ float* hspec() const { return (float*)(ws + WS.s5o + 0); }
  __device__ __forceinline__ bf16_t* W13T() const { return (bf16_t*)(ws + WS.hgo + 0); }
  __device__ __forceinline__ bf16_t* W2T() const { return (bf16_t*)(ws + WS.hgo + (size_t)32 * DM * DM * 2); }
  __device__ __forceinline__ bf16_t* gates() const { return (bf16_t*)(ws + WS.zmix + 0); }
  __device__ __forceinline__ bf16_t* hid() const { return (bf16_t*)(ws + WS.zmix + 0); }
  __device__ __forceinline__ bf16_t* ybuf() const { return (bf16_t*)(ws + WS.zmix + al256c((size_t)NTOK * 2 * 512 * 2)); }
};

extern __shared__ __attribute__((aligned(16))) unsigned char smem[];

typedef float f32x2 __attribute__((ext_vector_type(2)));
typedef __bf16 bf16x2_t __attribute__((ext_vector_type(2)));
__device__ __forceinline__ unsigned pk2(float a, float b) { const f32x2 v = {a, b}; return __builtin_bit_cast(unsigned, __builtin_convertvector(v, bf16x2_t)); }
__device__ __forceinline__ bf16_t f2bf(float f) { return (bf16_t)(pk2(f, 0.f) & 0xffffu); }
__device__ __forceinline__ float bflo(unsigned u) { return __uint_as_float(u << 16); }
__device__ __forceinline__ float bfhi(unsigned u) { return __uint_as_float(u & 0xffff0000u); }
__device__ __forceinline__ float bf2f(bf16_t b) { return __uint_as_float(((unsigned)b) << 16); }
__device__ __forceinline__ float sigmoidf_(float x) { return 1.0f / (1.0f + expf(-x)); }
__device__ __forceinline__ float siluf_(float x) { return x / (1.0f + expf(-x)); }
__device__ __forceinline__ float gelu_tanh(float x) {
  float u = 0.7978845608028654f * (x + 0.044715f * x * x * x);
  return 0.5f * x * (1.0f + tanhf(u));
}
__device__ __forceinline__ float wave_sum(float v) {
#pragma unroll
  for (int o = 1; o < 64; o <<= 1) v += __shfl_xor(v, o);
  return v;
}
__device__ __forceinline__ int tok_mod_row(int tok) { return tok < NCTX ? 2 : ((tok - NCTX) >> 13); }
__device__ __forceinline__ int scan_tok(int s, int dir, int b) {
  if (s < CTXL) return b * CTXL + (dir ? (CTXL - 1 - s) : s);
  int u = s - CTXL;
  return NCTX + b * SEQL + (dir ? (SEQL - 1 - u) : u);
}
__device__ __forceinline__ int otid() { int t = threadIdx.x; asm volatile("" : "+v"(t)); return t; }
#define LDS_FENCE() asm volatile("s_waitcnt lgkmcnt(0)" ::: "memory")


#define XB_TMO      128
#define XB_XCNT(j)  (256  + 64 * (j))
#define XB_XSUB(j)  (1280 + 64 * (j))
#define XB_XGEN(j)  (2304 + 64 * (j))
#define XB_TOP      3328
#define XB_TOPGEN   3392
#define XCD_BAR_WORDS 3456
#define XB_SPIN_CAP (1u << 20)
#define LAS __attribute__((address_space(3)))
__device__ __forceinline__ unsigned xb_ld(unsigned* p)              { return __hip_atomic_load(p, __ATOMIC_RELAXED, __HIP_MEMORY_SCOPE_AGENT); }
__device__ __forceinline__ unsigned xb_add(unsigned* p, unsigned v) { return __hip_atomic_fetch_add(p, v, __ATOMIC_RELAXED, __HIP_MEMORY_SCOPE_AGENT); }
__device__ __forceinline__ unsigned xb_xcc_id() { return (unsigned)__builtin_amdgcn_s_getreg((3 << 11) | 20) & 0xFu; }
#define XB_SPIN(cond, bar) do { unsigned _sp = 0; while (cond) { __builtin_amdgcn_s_sleep(1); \
    if ((++_sp & 255u) == 0u) { if (xb_ld(&(bar)[XB_TMO])) break; if (_sp > XB_SPIN_CAP) { atomicAdd(&(bar)[XB_TMO], 1u); break; } } } } while (0)
struct XcdBarrier { unsigned* bar; unsigned x; volatile LAS unsigned* st; };
__device__ __forceinline__ XcdBarrier xcd_barrier_post(unsigned* bar, volatile LAS unsigned* st) {
  XcdBarrier b; b.bar = bar; b.x = xb_xcc_id(); b.st = st;
  if (threadIdx.x == 0) (void)xb_add(&bar[XB_XCNT(b.x)], 1u);
  return b;
}
__device__ __forceinline__ void xcd_barrier_complete(unsigned* bar, unsigned x, unsigned& nloc, unsigned& nx) {
  const unsigned G = gridDim.x * gridDim.y * gridDim.z;
  unsigned sum, cnt, mine, sp = 0u;
  for (;;) {
    sum = 0u; cnt = 0u; mine = 0u;
#pragma unroll
    for (unsigned j = 0; j < 16; ++j) { const unsigned c = xb_ld(&bar[XB_XCNT(j)]); sum += c; cnt += (c > 0u) ? 1u : 0u; mine = (j == x) ? c : mine; }
    if (sum == G) break;
    __builtin_amdgcn_s_sleep(1);
    if ((++sp & 255u) == 0u) { if (xb_ld(&bar[XB_TMO])) break; if (sp > XB_SPIN_CAP) { atomicAdd(&bar[XB_TMO], 1u); break; } }
  }
  nloc = mine > 0u ? mine : 1u; nx = cnt > 0u ? cnt : 1u;
}
__device__ __forceinline__ void xcd_barrier(const XcdBarrier& b) {
  asm volatile("s_waitcnt vmcnt(0)" ::: "memory");
  __syncthreads();
  if (threadIdx.x == 0) {
    unsigned* bar = b.bar;
    __builtin_amdgcn_s_waitcnt(0);
    unsigned nloc = b.st[0], nx = b.st[1];
    if (nloc == 0u) { xcd_barrier_complete(bar, b.x, nloc, nx); b.st[0] = nloc; b.st[1] = nx; }
    const unsigned old = xb_add(&bar[XB_XSUB(b.x)], 1u);
    const unsigned gen = old / nloc;
    if (old + 1u == (gen + 1u) * nloc) {
      __builtin_amdgcn_fence(__ATOMIC_RELEASE, "agent");
      asm volatile("s_waitcnt vmcnt(0)" ::: "memory");
      const unsigned og = xb_add(&bar[XB_TOP], 1u);
      const unsigned tg = og / nx;
      if (og + 1u == (tg + 1u) * nx) xb_add(&bar[XB_TOPGEN], 1u);
      else XB_SPIN(xb_ld(&bar[XB_TOPGEN]) == tg, bar);
      __builtin_amdgcn_fence(__ATOMIC_ACQUIRE, "agent");
      xb_add(&bar[XB_XGEN(b.x)], 1u);
      asm volatile("s_waitcnt vmcnt(0)" ::: "memory");
    } else {
      XB_SPIN(xb_ld(&bar[XB_XGEN(b.x)]) == gen, bar);
      __builtin_amdgcn_fence(__ATOMIC_ACQUIRE, "agent");
      asm volatile("s_waitcnt vmcnt(0)" ::: "memory");
    }
  }
  __syncthreads();
}

__device__ __forceinline__ void ph_setup1(const Params& p) {
  const int TID = otid();
  const int tid = TID, lane = tid & 63, wave = tid >> 6;
  const int gtid = blockIdx.x * NTHREADS + tid;
  const int gw = blockIdx.x * NWAVES + wave, nw = gridDim.x * NWAVES;
  float* sc = (float*)smem;
  for (int i = tid; i < 3072; i += NTHREADS) {
    int r = i >> 10, k = i & 1023;
    float v = r < 2 ? p.in[I_C][r * 1024 + k] : p.in[I_CCTX][k];
    sc[i] = siluf_(v);
  }
  __syncthreads();
  if (gtid < 64) p.cnt()[gtid * 32] = 0;
  if (gtid < 1024) { const int pos = gtid >> 3, j = gtid & 7; double sn, cs; sincos((double)pos * pow(10000.0, -(double)j / 8.0), &sn, &cs); p.rope()[gtid * 2] = (float)cs; p.rope()[gtid * 2 + 1] = (float)sn; }
  if (gtid < FFT_N) { double sn, cs; sincos(-2.0 * 3.14159265358979323846 * (double)gtid / (double)FFT_N, &sn, &cs); p.twid()[gtid * 2] = (float)cs; p.twid()[gtid * 2 + 1] = (float)sn; }
  if (gtid < 1024) {
    int l = gtid >> 9, dc = gtid & 511;
    float v = 0.f;
    if (l == 1) { float l0 = p.in[I_HGLB][dc], l1 = p.in[I_HGLB][512 + dc]; v = 1.0f / (1.0f + expf(l0 - l1)); }
    p.lb()[gtid] = v;
  }
  if (gtid < 4096) {
    double lr = fmin((double)p.in[I_S5LRE][gtid], -1e-4), li = (double)p.in[I_S5LIM][gtid];
    double dt = exp((double)p.in[I_S5LDT][gtid >> 6]);
    double mag = exp(lr * dt), sn, cs;
    sincos(li * dt, &sn, &cs);
    double are = mag * cs, aim = mag * sn;
    double den = lr * lr + li * li;
    double cr = ((are - 1.0) * lr + aim * li) / den, ci = (aim * lr - (are - 1.0) * li) / den;
    p.s5a()[gtid * 2] = (float)are; p.s5a()[gtid * 2 + 1] = (float)aim;
    for (int c = 0; c < 16; ++c) {
      double br = p.in[I_S5BRE][gtid * 16 + c], bi = p.in[I_S5BIM][gtid * 16 + c];
      p.s5b()[(gtid * 16 + c) * 2] = (float)(cr * br - ci * bi);
      p.s5b()[(gtid * 16 + c) * 2 + 1] = (float)(cr * bi + ci * br);
    }
  }
  for (int t = gw; t < 2 * 96 * 8; t += nw) {
    const int kp = t & 7, cgp = (t >> 3) % 96, l = t / (8 * 96);
    const int col = cgp * 64 + lane;
    const float* w = p.in[I_WMOD] + ((size_t)l * 1024 + kp * 128) * 6144 + col;
    float a0 = 0.f, a1 = 0.f, a2 = 0.f;
#pragma unroll 8
    for (int k = 0; k < 128; ++k) {
      float wv = w[(size_t)k * 6144];
      a0 += sc[kp * 128 + k] * wv; a1 += sc[1024 + kp * 128 + k] * wv; a2 += sc[2048 + kp * 128 + k] * wv;
    }
    float* o = p.modpart() + ((size_t)(kp * 2 + l) * 3) * 6144 + col;
    o[0] = a0; o[6144] = a1; o[2 * 6144] = a2;
  }
  float* w3l = (float*)smem;
  for (int lyr = 0; lyr < 2; ++lyr) {
    __syncthreads();
    { const f32x4* src = (const f32x4*)(p.in[I_HYW3] + (size_t)lyr * 64 * 512);
      for (int i = tid; i < 64 * 512 / 4; i += NTHREADS) ((f32x4*)w3l)[i] = src[i]; }
    __syncthreads();
    const int ngroups = lyr == 0 ? (SEQL + CTXL) / 8 : SEQL / 8;
    for (int g2 = gw; g2 < ngroups * 2; g2 += nw) {
      const int g = g2 >> 1, mh = g2 & 1;
      const bool isctx = g >= SEQL / 8;
      const int L = isctx ? CTXL : SEQL, i0 = (isctx ? g - SEQL / 8 : g) * 8;
      float* outp = isctx ? p.hrawc() : p.hraw() + (size_t)lyr * 2 * 256 * SEQL;
      float z[8], tt[8];
#pragma unroll
      for (int q = 0; q < 8; ++q) {
        const int i = i0 + q;
        tt[q] = (float)i / (float)(L - 1);
        const float w = (6.283185307179586f / (float)L) * (float)i;
        z[q] = 0.f;
        if (lane == 0) z[q] = tt[q];
        else if (lane < 33) {
          const int j = (lane - 1) & 15;
          const float f = 1e-4f + (float)j * ((15.0f - 1e-4f) / 15.0f);
          z[q] = lane < 17 ? cosf(f * w) : -sinf(f * w);
        }
      }
      const float* w1 = p.in[I_HYW1] + lyr * 33 * 64;
      float a[8];
      { const float b1 = p.in[I_HYB1][lyr * 64 + lane];
#pragma unroll
        for (int q = 0; q < 8; ++q) a[q] = b1; }
      for (int k = 0; k < 33; ++k) {
        const float wv = w1[k * 64 + lane];
#pragma unroll
        for (int q = 0; q < 8; ++q) a[q] += __shfl(z[q], k) * wv;
      }
      float h1[8];
      { const float f1 = p.in[I_HYF1][lyr * 64 + lane];
#pragma unroll
        for (int q = 0; q < 8; ++q) h1[q] = sinf(f1 * a[q]); }
      const float* w2 = p.in[I_HYW2] + lyr * 64 * 64;
      { const float b2 = p.in[I_HYB2][lyr * 64 + lane];
#pragma unroll
        for (int q = 0; q < 8; ++q) a[q] = b2; }
      for (int k = 0; k < 64; ++k) {
        const float wv = w2[k * 64 + lane];
#pragma unroll
        for (int q = 0; q < 8; ++q) a[q] += __shfl(h1[q], k) * wv;
      }
      float h2[8];
      { const float f2 = p.in[I_HYF2][lyr * 64 + lane];
#pragma unroll
        for (int q = 0; q < 8; ++q) h2[q] = sinf(f2 * a[q]); }
      const float lo = -4.605170185988091f / 1.5f, hi = -4.605170185988091f / 0.3f;
      float o[4][8];
#pragma unroll
      for (int m = 0; m < 4; ++m)
#pragma unroll
        for (int q = 0; q < 8; ++q) o[m][q] = 0.f;
      for (int k = 0; k < 64; ++k) {
        float hv[8];
#pragma unroll
        for (int q = 0; q < 8; ++q) hv[q] = __shfl(h2[q], k);
#pragma unroll
        for (int m = 0; m < 4; ++m) {
          const float wv = w3l[k * 512 + (mh * 4 + m) * 64 + lane];
#pragma unroll
          for (int q = 0; q < 8; ++q) o[m][q] += hv[q] * wv;
        }
      }
#pragma unroll
      for (int m = 0; m < 4; ++m) {
        const int c = (mh * 4 + m) * 64 + lane, cc = c & 255;
        const float delta = fabsf(lo + (float)cc * ((hi - lo) / 255.0f));
#pragma unroll
        for (int q = 0; q < 8; ++q) o[m][q] *= expf(-tt[q] * delta);
        float* dst = outp + ((size_t)(c >> 8) * 256 + cc) * L + i0;
        *(f32x4*)dst = (f32x4){o[m][0], o[m][1], o[m][2], o[m][3]};
        *(f32x4*)(dst + 4) = (f32x4){o[m][4], o[m][5], o[m][6], o[m][7]};
      }
    }
  }
  __syncthreads();
}

__device__ __forceinline__ void ph_setup2(const Params& p) {
  const int TID = otid();
  const int tid = TID;
  const int gtid = blockIdx.x * NTHREADS + tid, nthr = gridDim.x * NTHREADS;
  for (int i = gtid; i < 2 * 3 * 6144; i += nthr) {
    const int l = i / (3 * 6144), j = i % 6144;
    float a = p.in[I_BMOD][l * 6144 + j];
#pragma unroll
    for (int kp = 0; kp < 8; ++kp) a += p.modpart()[(size_t)kp * (2 * 3 * 6144) + i];
    p.mod()[i] = a;
  }
  float* red = (float*)smem;
  for (int t = blockIdx.x; t < 768; t += gridDim.x) {
    const int set = t >> 8, c = t & 255;
    const int L = set < 2 ? SEQL : CTXL;
    const float* raw = set < 2 ? p.hraw() + (size_t)set * 2 * 256 * SEQL : p.hrawc();
    float s = 0.f;
    for (int i = tid; i < L; i += NTHREADS) {
      float a = raw[(size_t)c * L + i]; s += a * a;
      if (i >= 1) { float b = raw[((size_t)256 + c) * L + i]; s += b * b; }
    }
    s = wave_sum(s);
    __syncthreads();
    if ((tid & 63) == 0) red[tid >> 6] = s;
    __syncthreads();
    if (tid == 0) {
      float tot = 0.f;
      for (int w = 0; w < NWAVES; ++w) tot += red[w];
      float sc = 1.0f / sqrtf(tot + EPSF);
      if (set < 2) p.hscale()[set * 256 + c] = sc; else p.hscalec()[c] = sc;
    }
  }
}


__device__ __forceinline__ void ph_setup_s5(const Params& p) {
  const int tid = otid();
  float* apw = (float*)smem;
  float* Kc = apw + 4352;
  float* Bl = Kc + 8192;
  float* Cl = Bl + 4096;
  for (int item = blockIdx.x; item < 256; item += gridDim.x) {
    const int lg = item >> 3, part = item & 7;
    const int l = lg >> 4, g = lg & 15;
    __syncthreads();
    for (int e = tid; e < 2 * 64 * 17; e += NTHREADS) {
      const int dir = e / (64 * 17), rem = e % (64 * 17), pp = rem / 17, m = rem % 17;
      const int sidx = ((l * 2 + dir) * 16 + g) * 64 + pp;
      const double lr = fmin((double)p.in[I_S5LRE][sidx], -1e-4), li = (double)p.in[I_S5LIM][sidx], dt = exp((double)p.in[I_S5LDT][sidx >> 6]);
      const double mag = exp((double)m * lr * dt); double sn, cs;
      sincos((double)m * li * dt, &sn, &cs);
      apw[e * 2] = (float)(mag * cs); apw[e * 2 + 1] = (float)(mag * sn);
    }
    for (int e = tid; e < 4096; e += NTHREADS) {
      const int dir = e >> 11, r = e & 2047;
      Bl[e] = p.s5b()[(size_t)(((l * 2 + dir) * 16 + g) * 64) * 32 + r];
      const int c = (r >> 7), pp = (r >> 1) & 63, ri = r & 1;
      Cl[e] = (ri ? p.in[I_S5CIM] : p.in[I_S5CRE])[(((l * 2 + dir) * 16 + g) * 16 + c) * 64 + pp];
    }
    __syncthreads();
    for (int e = tid; e < 8192; e += NTHREADS) {
      const int dir = e >> 12, lag = (e >> 8) & 15, c = (e >> 4) & 15, cp = e & 15;
      float acc = 0.f;
      for (int pp = 0; pp < 64; ++pp) {
        const float ar = apw[((dir * 64 + pp) * 17 + lag) * 2], ai = apw[((dir * 64 + pp) * 17 + lag) * 2 + 1];
        const float br = Bl[((dir * 64 + pp) * 16 + cp) * 2], bi = Bl[((dir * 64 + pp) * 16 + cp) * 2 + 1];
        const float cre = Cl[((dir * 16 + c) * 64 + pp) * 2], cim = Cl[((dir * 16 + c) * 64 + pp) * 2 + 1];
        acc += cre * (ar * br - ai * bi) - cim * (ar * bi + ai * br);
      }
      Kc[e] = acc;
    }
    __syncthreads();
    bf16_t* Tz = p.s5Tz() + (size_t)lg * 65536;
    bf16_t* Nn = p.s5Nn() + (size_t)lg * 65536;
    bf16_t* Mm = p.s5Mm() + (size_t)lg * 65536;
    for (int e = part * 8192 + tid; e < (part + 1) * 8192; e += NTHREADS) {
      const int n = e >> 8, k = e & 255;
      {
        const int t = n >> 4, c = n & 15, tp = k >> 4, cp = k & 15;
        float v = 0.f;
        if (t >= tp) v += Kc[((0 * 16 + (t - tp)) * 16 + c) * 16 + cp];
        if (tp >= t) v += Kc[((1 * 16 + (tp - t)) * 16 + c) * 16 + cp];
        if (t == tp && c == cp) v += p.in[I_S5D][l * 256 + g * 16 + c];
        Tz[e] = f2bf(v);
      }
      {
        const int dir = n >> 7, pp = (n >> 1) & 63, ri = n & 1, tp = k >> 4, cp = k & 15;
        const int m = dir ? tp : 15 - tp;
        const float ar = apw[((dir * 64 + pp) * 17 + m) * 2], ai = apw[((dir * 64 + pp) * 17 + m) * 2 + 1];
        const float br = Bl[((dir * 64 + pp) * 16 + cp) * 2], bi = Bl[((dir * 64 + pp) * 16 + cp) * 2 + 1];
        Nn[e] = f2bf(ri ? (ar * bi + ai * br) : (ar * br - ai * bi));
      }
      {
        const int t = n >> 4, c = n & 15, dir = k >> 7, pp = (k >> 1) & 63, ri = k & 1;
        const int m = dir ? 16 - t : t + 1;
        const float ar = apw[((dir * 64 + pp) * 17 + m) * 2], ai = apw[((dir * 64 + pp) * 17 + m) * 2 + 1];
        const float cre = Cl[((dir * 16 + c) * 64 + pp) * 2], cim = Cl[((dir * 16 + c) * 64 + pp) * 2 + 1];
        Mm[e] = f2bf(ri ? -(cre * ai + cim * ar) : (cre * ar - cim * ai));
      }
    }
  }
}

__device__ __forceinline__ void ph_norm1(const Params& p, int l) {
  const int TID = otid();
  const int lane = TID & 63, wave = TID >> 6;
  for (int tok = blockIdx.x * NWAVES + wave; tok < NTOK; tok += gridDim.x * NWAVES) {
    const int r = tok_mod_row(tok);
    f32x4* xr = (f32x4*)(p.xbuf() + (size_t)tok * DM);
    const f32x4* src = l == 0 ? (tok < NCTX ? (const f32x4*)(p.in[I_CTX] + (size_t)tok * DM) : (const f32x4*)(p.in[I_X] + (size_t)(tok - NCTX) * DM))
                              : (const f32x4*)xr;
    f32x4 v[4];
    float ss = 0.f;
#pragma unroll
    for (int j = 0; j < 4; ++j) {
      v[j] = src[lane + 64 * j];
      if (l == 1) {
        const int c = (lane + 64 * j) * 4;
        f32x4 g = *(const f32x4*)(p.mod() + (size_t)(0 * 3 + r) * 6144 + 5 * 1024 + c);
        const uint2 y0b = *(const uint2*)(p.ybuf() + (size_t)p.aslot()[tok * 2] * DM + c), y1b = *(const uint2*)(p.ybuf() + (size_t)p.aslot()[tok * 2 + 1] * DM + c);
        const f32x4 y0 = {bflo(y0b.x), bfhi(y0b.x), bflo(y0b.y), bfhi(y0b.y)}, y1 = {bflo(y1b.x), bfhi(y1b.x), bflo(y1b.y), bfhi(y1b.y)};
        v[j] = v[j] + g * (y0 + y1);
      }
      if (l == 1) xr[lane + 64 * j] = v[j];
      ss += v[j].x * v[j].x + v[j].y * v[j].y + v[j].z * v[j].z + v[j].w * v[j].w;
    }
    ss = wave_sum(ss);
    const float rs = 1.0f / sqrtf(ss * (1.0f / DM) + EPSF);
    const float* gain = p.in[I_NORM1] + l * DM;
    const float* mrow = p.mod() + (size_t)(l * 3 + r) * 6144;
    uint2* ho = (uint2*)(p.hbf() + (size_t)tok * DM);
#pragma unroll
    for (int j = 0; j < 4; ++j) {
      const int c = (lane + 64 * j) * 4;
      f32x4 g = *(const f32x4*)(gain + c), sh = *(const f32x4*)(mrow + c), sc = *(const f32x4*)(mrow + 1024 + c);
      f32x4 h = v[j] * rs * g * (1.0f + sc) + sh;
      ho[lane + 64 * j] = make_uint2(pk2(h.x, h.y), pk2(h.z, h.w));
    }
  }
}

__device__ __forceinline__ void ph_reads(const Params& p, int l, int tok_lo) {
  const int TID = otid();
  const int lane = TID & 63, wave = TID >> 6;
  const int c = lane * 4;
  {
    bf16_t* tile = (bf16_t*)smem;
    for (int tt = blockIdx.x; tt < NLAT / 64; tt += gridDim.x) {
      __syncthreads();
      for (int i = TID; i < 256 * 8; i += NTHREADS) {
        const int ch = i >> 3, t8 = (i & 7) * 8;
        const uint4 v = *(const uint4*)((const bf16_t*)(p.hspec() + (size_t)ch * FFT_N * 2) + tt * 64 + t8);
        unsigned* d = (unsigned*)(tile + ch * 66 + t8);
        d[0] = v.x; d[1] = v.y; d[2] = v.z; d[3] = v.w;
      }
      __syncthreads();
#pragma unroll
      for (int k = 0; k < 8; ++k) {
        const int tk = wave * 8 + k;
        const unsigned lo = (unsigned)tile[(c + 0) * 66 + tk] | ((unsigned)tile[(c + 1) * 66 + tk] << 16);
        const unsigned hi = (unsigned)tile[(c + 2) * 66 + tk] | ((unsigned)tile[(c + 3) * 66 + tk] << 16);
        *(uint2*)(p.br() + (size_t)(NCTX + tt * 64 + tk) * DM + 256 + c) = make_uint2(lo, hi);
      }
    }
    __syncthreads();
  }
  for (int tok = tok_lo + blockIdx.x * NWAVES + wave; tok < NTOK; tok += gridDim.x * NWAVES) {
    const bf16_t* z = p.zmix() + (size_t)tok * NMIX;
    {
      f32x4 o = *(const f32x4*)(p.hgo() + (size_t)tok * 256 + c) + *(const f32x4*)(p.hgo() + ((size_t)NTOK + tok) * 256 + c);
      float ss = o.x * o.x + o.y * o.y + o.z * o.z + o.w * o.w;
#pragma unroll
      for (int m = 1; m < 16; m <<= 1) ss += __shfl_xor(ss, m);
      float rs = 1.0f / sqrtf(ss * (1.0f / 64.0f) + EPSF);
      f32x4 g = *(const f32x4*)(p.in[I_HGNORM] + l * 256 + c);
      const uint2 gtb = *(const uint2*)(z + C_HGG + c);
      const f32x4 gt = {bflo(gtb.x), bfhi(gtb.x), bflo(gtb.y), bfhi(gtb.y)};
      uint2 w = make_uint2(pk2(o.x * rs * g.x * siluf_(gt.x), o.y * rs * g.y * siluf_(gt.y)), pk2(o.z * rs * g.z * siluf_(gt.z), o.w * rs * g.w * siluf_(gt.w)));
      *(uint2*)(p.br() + (size_t)tok * DM + c) = w;
    }
    {
      f32x4 o = *(const f32x4*)(p.rto() + (size_t)tok * 256 + c) + *(const f32x4*)(p.rto() + ((size_t)NTOK + tok) * 256 + c);
      float sm_ = o.x + o.y + o.z + o.w;
#pragma unroll
      for (int m = 1; m < 16; m <<= 1) sm_ += __shfl_xor(sm_, m);
      float mean = sm_ * (1.0f / 64.0f);
      o = o - mean;
      float ss = o.x * o.x + o.y * o.y + o.z * o.z + o.w * o.w;
#pragma unroll
      for (int m = 1; m < 16; m <<= 1) ss += __shfl_xor(ss, m);
      float rs = 1.0f / sqrtf(ss * (1.0f / 64.0f) + EPSF);
      f32x4 g = *(const f32x4*)(p.in[I_RETNORM] + l * 256 + c);
      const uint2 gtb = *(const uint2*)(z + C_RG + c);
      const f32x4 gt = {bflo(gtb.x), bfhi(gtb.x), bflo(gtb.y), bfhi(gtb.y)};
      uint2 w = make_uint2(pk2(o.x * rs * g.x * siluf_(gt.x), o.y * rs * g.y * siluf_(gt.y)), pk2(o.z * rs * g.z * siluf_(gt.z), o.w * rs * g.w * siluf_(gt.w)));
      *(uint2*)(p.br() + (size_t)tok * DM + 512 + c) = w;
    }
  }
}

__device__ __forceinline__ void ph_router(const Params& p, int l, int tok_lo) {
  const int TID = otid();
  const int lane = TID & 63, wave = TID >> 6;
  const float* gain = p.in[I_NORM2] + l * DM;
  const float* wg = p.in[I_WGRP] + (size_t)l * DM * 4;
  float* wl = (float*)smem;
  int* lcnt = (int*)(smem + 131072);
  int* lbase = lcnt + 32;
  int* las_ex = lbase + 32;
  int* las_pos = las_ex + 160;
  int* las_id = las_pos + 160;
  __syncthreads();
  if (TID < 32) lcnt[TID] = 0;
  if (TID < 160) las_ex[TID] = -1;
  {
    const f32x4* src = (const f32x4*)(p.in[I_WEXP] + (size_t)l * DM * 32);
    for (int i = TID; i < DM * 32 / 4; i += NTHREADS) ((f32x4*)wl)[i] = src[i];
  }
  __syncthreads();
  const int rstride = gridDim.x * NWAVES;
  for (int tok0 = tok_lo + blockIdx.x * NWAVES + wave, kit = 0; tok0 < NTOK; tok0 += 2 * rstride, kit += 2) {
    int tk[2]; bool ok[2];
    tk[0] = tok0; ok[0] = true; tk[1] = tok0 + rstride; ok[1] = tk[1] < NTOK; if (!ok[1]) tk[1] = tok0;
    f32x4 h[2][4]; float ss[2];
#pragma unroll
    for (int u = 0; u < 2; ++u) {
      const f32x4* xr = (const f32x4*)(p.xbuf() + (size_t)tk[u] * DM);
      ss[u] = 0.f;
#pragma unroll
      for (int j = 0; j < 4; ++j) { h[u][j] = xr[lane + 64 * j]; ss[u] += h[u][j].x * h[u][j].x + h[u][j].y * h[u][j].y + h[u][j].z * h[u][j].z + h[u][j].w * h[u][j].w; }
    }
#pragma unroll
    for (int u = 0; u < 2; ++u) ss[u] = wave_sum(ss[u]);
    float lg[2][4];
#pragma unroll
    for (int u = 0; u < 2; ++u) {
      const float rs = 1.0f / sqrtf(ss[u] * (1.0f / DM) + EPSF);
      const float* mrow = p.mod() + (size_t)(l * 3 + tok_mod_row(tk[u])) * 6144 + 3 * 1024;
      uint2* ho = (uint2*)(p.hbf() + (size_t)tk[u] * DM);
#pragma unroll
      for (int i = 0; i < 4; ++i) lg[u][i] = 0.f;
#pragma unroll
      for (int j = 0; j < 4; ++j) {
        const int c = (lane + 64 * j) * 4;
        const f32x4 g = *(const f32x4*)(gain + c), sh = *(const f32x4*)(mrow + c), sc = *(const f32x4*)(mrow + 1024 + c);
        h[u][j] = h[u][j] * rs * g * (1.0f + sc) + sh;
        if (ok[u]) ho[lane + 64 * j] = make_uint2(pk2(h[u][j].x, h[u][j].y), pk2(h[u][j].z, h[u][j].w));
#pragma unroll
        for (int q = 0; q < 4; ++q) {
          const f32x4 wgv = *(const f32x4*)(wg + (size_t)(c + q) * 4);
#pragma unroll
          for (int i = 0; i < 4; ++i) lg[u][i] += h[u][j][q] * wgv[i];
        }
      }
    }
    int gi[2]; float grp_p[2];
#pragma unroll
    for (int u = 0; u < 2; ++u) {
      float gl[4];
#pragma unroll
      for (int i = 0; i < 4; ++i) gl[i] = wave_sum(lg[u][i]) + p.in[I_BGRP][l * 4 + i];
      int g_ = 0; float gm = gl[0];
#pragma unroll
      for (int i = 1; i < 4; ++i) if (gl[i] > gm) { gm = gl[i]; g_ = i; }
      float gs = 0.f;
#pragma unroll
      for (int i = 0; i < 4; ++i) gs += expf(gl[i] - gm);
      grp_p[u] = 1.0f / gs;
      gi[u] = __builtin_amdgcn_readfirstlane(g_);
    }
    float le[2][8];
#pragma unroll
    for (int u = 0; u < 2; ++u) {
#pragma unroll
      for (int i = 0; i < 8; ++i) le[u][i] = 0.f;
#pragma unroll
      for (int j = 0; j < 4; ++j) {
        const int c = (lane + 64 * j) * 4;
#pragma unroll
        for (int q = 0; q < 4; ++q) {
          const f32x4 w0 = *(const f32x4*)&wl[(c + q) * 32 + gi[u] * 8], w1 = *(const f32x4*)&wl[(c + q) * 32 + gi[u] * 8 + 4];
          const float hv = h[u][j][q];
          le[u][0] += hv * w0.x; le[u][1] += hv * w0.y; le[u][2] += hv * w0.z; le[u][3] += hv * w0.w;
          le[u][4] += hv * w1.x; le[u][5] += hv * w1.y; le[u][6] += hv * w1.z; le[u][7] += hv * w1.w;
        }
      }
    }
#pragma unroll
    for (int u = 0; u < 2; ++u) {
      float el[8];
#pragma unroll
      for (int i = 0; i < 8; ++i) el[i] = wave_sum(le[u][i]) + p.in[I_BEXP][l * 32 + gi[u] * 8 + i];
      int i1 = 0; float m1 = el[0];
#pragma unroll
      for (int i = 1; i < 8; ++i) if (el[i] > m1) { m1 = el[i]; i1 = i; }
      int i2 = i1 == 0 ? 1 : 0; float m2 = -3.0e38f;
#pragma unroll
      for (int i = 0; i < 8; ++i) if (i != i1 && el[i] > m2) { m2 = el[i]; i2 = i; }
      const float e2 = expf(m2 - m1);
      const float w1 = grp_p[u] / (1.0f + e2), w2 = grp_p[u] * e2 / (1.0f + e2);
      if (lane == 0 && ok[u]) {
        const int tok = tk[u];
        const int ex1 = gi[u] * 8 + i1, ex2 = gi[u] * 8 + i2;
        p.rw()[tok * 2] = w1; p.rw()[tok * 2 + 1] = w2;
        const int slot = ((kit + u) * NWAVES + wave) * 2;
        las_ex[slot] = ex1; las_pos[slot] = atomicAdd(&lcnt[ex1], 1); las_id[slot] = tok * 2;
        las_ex[slot + 1] = ex2; las_pos[slot + 1] = atomicAdd(&lcnt[ex2], 1); las_id[slot + 1] = tok * 2 + 1;
      }
    }
  }
  __syncthreads();
  if (TID < 32) lbase[TID] = lcnt[TID] > 0 ? atomicAdd(&p.cnt()[(l * 32 + TID) * 32], lcnt[TID]) : 0;
  __syncthreads();
  if (TID < 160 && las_ex[TID] >= 0) p.alist()[las_ex[TID] * NTOK + lbase[las_ex[TID]] + las_pos[TID]] = las_id[TID];
}

__device__ __forceinline__ void ph_final(const Params& p) {
  const int TID = otid();
  const int lane = TID & 63, wave = TID >> 6;
  const int rstride = gridDim.x * NWAVES;
  for (int tok0 = NCTX + blockIdx.x * NWAVES + wave; tok0 < NTOK; tok0 += 2 * rstride) {
    int tk[2]; bool ok[2];
    tk[0] = tok0; ok[0] = true; tk[1] = tok0 + rstride; ok[1] = tk[1] < NTOK; if (!ok[1]) tk[1] = tok0;
    int sl[2][2];
#pragma unroll
    for (int u = 0; u < 2; ++u) { sl[u][0] = p.aslot()[tk[u] * 2]; sl[u][1] = p.aslot()[tk[u] * 2 + 1]; }
    f32x4 v[2][4]; float ss[2];
#pragma unroll
    for (int u = 0; u < 2; ++u) {
      const f32x4* xr = (const f32x4*)(p.xbuf() + (size_t)tk[u] * DM);
      const float* grow = p.mod() + (size_t)(1 * 3 + tok_mod_row(tk[u])) * 6144 + 5 * 1024;
      ss[u] = 0.f;
#pragma unroll
      for (int j = 0; j < 4; ++j) {
        const int c = (lane + 64 * j) * 4;
        const f32x4 g = *(const f32x4*)(grow + c);
        const uint2 y0b = *(const uint2*)(p.ybuf() + (size_t)sl[u][0] * DM + c), y1b = *(const uint2*)(p.ybuf() + (size_t)sl[u][1] * DM + c);
        const f32x4 y0 = {bflo(y0b.x), bfhi(y0b.x), bflo(y0b.y), bfhi(y0b.y)}, y1 = {bflo(y1b.x), bfhi(y1b.x), bflo(y1b.y), bfhi(y1b.y)};
        v[u][j] = xr[lane + 64 * j] + g * (y0 + y1);
        ss[u] += v[u][j].x * v[u][j].x + v[u][j].y * v[u][j].y + v[u][j].z * v[u][j].z + v[u][j].w * v[u][j].w;
      }
    }
#pragma unroll
    for (int u = 0; u < 2; ++u) ss[u] = wave_sum(ss[u]);
#pragma unroll
    for (int u = 0; u < 2; ++u) {
      if (!ok[u]) continue;
      const float rs = 1.0f / sqrtf(ss[u] * (1.0f / DM) + EPSF);
      f32x4* o = (f32x4*)(p.out + (size_t)(tk[u] - NCTX) * DM);
#pragma unroll
      for (int j = 0; j < 4; ++j) {
        const int c = (lane + 64 * j) * 4;
        const f32x4 g = *(const f32x4*)(p.in[I_NORMF] + c);
        o[lane + 64 * j] = v[u][j] * rs * g;
      }
    }
  }
}

__device__ __forceinline__ void hyena_task(const Params& p, int l, int L, int tok0, int b, int c, const float* raw, const float* scale) {
  const int TID = otid();
  float* sm = (float*)smem;
  float* su = sm; float* sx0 = sm + L; float* shf = sm + 2 * L; float* shb = sm + 3 * L;
  const int tokb = tok0 + b * L;
  const float* cw = p.in[I_HYCW] + l * 3 * 768;
  const float* cb = p.in[I_HYCB] + l * 768;
  const float w00 = cw[c], w01 = cw[768 + c], w02 = cw[1536 + c], b0 = cb[c];
  const float w10 = cw[256 + c], w11 = cw[768 + 256 + c], w12 = cw[1536 + 256 + c], b1 = cb[256 + c];
  const float w20 = cw[512 + c], w21 = cw[768 + 512 + c], w22 = cw[1536 + 512 + c], b2 = cb[512 + c];
  __syncthreads();
  for (int t = TID; t < L; t += NTHREADS) {
    const bf16_t* zc = p.zmix() + (size_t)(tokb + t) * NMIX + C_HY + c;
    float x0m = 0.f, x1m = 0.f, vm = 0.f, x0p = 0.f, x1p = 0.f, vp = 0.f;
    if (t > 0) { x0m = bf2f(zc[-NMIX]); x1m = bf2f(zc[-NMIX + 256]); vm = bf2f(zc[-NMIX + 512]); }
    if (t < L - 1) { x0p = bf2f(zc[NMIX]); x1p = bf2f(zc[NMIX + 256]); vp = bf2f(zc[NMIX + 512]); }
    float x0 = x0m * w00 + bf2f(zc[0]) * w01 + x0p * w02 + b0;
    float x1 = x1m * w10 + bf2f(zc[256]) * w11 + x1p * w12 + b1;
    float v = vm * w20 + bf2f(zc[512]) * w21 + vp * w22 + b2;
    su[t] = v * x1; sx0[t] = x0;
    shf[t] = raw[(size_t)c * L + t];
    shb[t] = raw[((size_t)256 + c) * L + t];
  }
  __syncthreads();
  const float scl = scale[c], skip = p.in[I_HYSKIP][l * 256 + c];
  for (int t = TID; t < L; t += NTHREADS) {
    float a0 = 0.f, a1 = 0.f;
    for (int s = 0; s <= t; ++s) a0 += shf[t - s] * su[s];
    for (int s = t + 1; s < L; ++s) a1 += shb[s - t] * su[s];
    float y = (a0 + a1) * scl + su[t] * skip;
    p.br()[(size_t)(tokb + t) * DM + 256 + c] = f2bf(y * sx0[t]);
  }
}

struct __attribute__((aligned(8))) cf { float x, y; };
__device__ __forceinline__ cf cadd(cf a, cf b) { return {a.x + b.x, a.y + b.y}; }
__device__ __forceinline__ cf csub(cf a, cf b) { return {a.x - b.x, a.y - b.y}; }
__device__ __forceinline__ cf cmul(cf a, cf b) { return {a.x * b.x - a.y * b.y, a.x * b.y + a.y * b.x}; }
__device__ __forceinline__ cf cmulc(cf a, cf b) { return {a.x * b.x + a.y * b.y, a.y * b.x - a.x * b.y}; }
__device__ __forceinline__ int fphys(int i) { return i + ((i >> 6) << 2); }
#define FFT_PHYS_N (FFT_N + (FFT_N >> 6) * 4)

template <bool INV>
__device__ __forceinline__ void dft4(cf& a0, cf& a1, cf& a2, cf& a3) {
  const cf s02 = cadd(a0, a2), d02 = csub(a0, a2), s13 = cadd(a1, a3), d13 = csub(a1, a3);
  a0 = cadd(s02, s13); a2 = csub(s02, s13);
  if (!INV) { a1 = {d02.x + d13.y, d02.y - d13.x}; a3 = {d02.x - d13.y, d02.y + d13.x}; }
  else      { a1 = {d02.x - d13.y, d02.y + d13.x}; a3 = {d02.x + d13.y, d02.y - d13.x}; }
}
template <bool INV>
__device__ __forceinline__ void dft16(cf (&x)[16]) {
#pragma unroll
  for (int a0 = 0; a0 < 4; ++a0) dft4<INV>(x[a0], x[a0 + 4], x[a0 + 8], x[a0 + 12]);
  const float C1 = 0.92387953251128674f, S1 = 0.38268343236508977f, R2 = 0.70710678118654752f;
  const cf w1 = {C1, -S1}, w2 = {R2, -R2}, w3 = {S1, -C1}, w4 = {0.f, -1.f}, w6 = {-R2, -R2}, w9 = {-C1, S1};
#define TW(idx, w) x[idx] = INV ? cmulc(x[idx], w) : cmul(x[idx], w)
  TW(1 + 4 * 1, w1); TW(2 + 4 * 1, w2); TW(3 + 4 * 1, w3);
  TW(1 + 4 * 2, w2); TW(2 + 4 * 2, w4); TW(3 + 4 * 2, w6);
  TW(1 + 4 * 3, w3); TW(2 + 4 * 3, w6); TW(3 + 4 * 3, w9);
#undef TW
#pragma unroll
  for (int c0 = 0; c0 < 4; ++c0) dft4<INV>(x[4 * c0], x[4 * c0 + 1], x[4 * c0 + 2], x[4 * c0 + 3]);
}
#define RC16(c) (((c) >> 2) + 4 * ((c) & 3))

__device__ __forceinline__ void tw_powers(cf w1, cf (&w)[16]) {
  w[0] = {1.f, 0.f}; w[1] = w1;
  w[2] = cmul(w1, w1); w[3] = cmul(w[2], w1); w[4] = cmul(w[2], w[2]); w[5] = cmul(w[4], w1); w[6] = cmul(w[3], w[3]); w[7] = cmul(w[4], w[3]);
  w[8] = cmul(w[4], w[4]); w[9] = cmul(w[8], w1); w[10] = cmul(w[5], w[5]); w[11] = cmul(w[8], w[3]); w[12] = cmul(w[6], w[6]); w[13] = cmul(w[8], w[5]);
  w[14] = cmul(w[7], w[7]); w[15] = cmul(w[8], w[7]);
}

template <bool INV>
__device__ __forceinline__ void r16_group(cf* X, int base, int S, cf w1) {
  cf x[16], w[16];
  tw_powers(w1, w);
#pragma unroll
  for (int a = 0; a < 16; ++a) x[a] = X[fphys(base + S * a)];
  if (INV) {
#pragma unroll
    for (int c = 1; c < 16; ++c) x[c] = cmulc(x[c], w[c]);
  }
  dft16<INV>(x);
#pragma unroll
  for (int c = 0; c < 16; ++c) {
    cf v = x[RC16(c)];
    if (!INV && c > 0) v = cmul(v, w[c]);
    X[fphys(base + S * c)] = v;
  }
}
template <bool INV>
__device__ __forceinline__ void r4_group(cf* X, int base) {
  cf a0 = X[fphys(base)], a1 = X[fphys(base + 1)], a2 = X[fphys(base + 2)], a3 = X[fphys(base + 3)];
  dft4<INV>(a0, a1, a2, a3);
  X[fphys(base)] = a0; X[fphys(base + 1)] = a1; X[fphys(base + 2)] = a2; X[fphys(base + 3)] = a3;
}
template <bool INV>
__device__ __forceinline__ void fft_pass(cf* X, const cf* tw, int pass, int tid, int nthr) {
  if (pass == 1) {
    for (int g = tid; g < 1024; g += nthr) r16_group<INV>(X, g, 1024, tw[g]);
  } else if (pass == 2) {
    for (int g = tid; g < 1024; g += nthr) { const int c1 = g >> 6, b2 = g & 63; r16_group<INV>(X, c1 * 1024 + b2, 64, tw[16 * b2]); }
  } else if (pass == 3) {
    for (int g = tid; g < 1024; g += nthr) { const int blk = g >> 2, b3 = g & 3; r16_group<INV>(X, blk * 64 + b3, 4, tw[256 * b3]); }
  } else {
    for (int g = tid; g < 4096; g += nthr) r4_group<INV>(X, 4 * g);
  }
}

__device__ __forceinline__ void ph_hy_transpose(const Params& p) {
  const int tid = otid();
  float* tile = (float*)smem;
  for (int t = blockIdx.x; t < (NLAT / 64) * 12; t += gridDim.x) {
    const int tt = t / 12, ct = t % 12, tok0 = tt * 64, col0 = ct * 64;
    __syncthreads();
    {
      const int r = tid >> 3, c8 = (tid & 7) * 8;
      const bf16_t* src = p.zmix() + (size_t)(NCTX + tok0 + r) * NMIX + C_HY + col0 + c8;
      const uint4 raw = *(const uint4*)src;
      float* d = tile + r * 65 + c8;
      d[0] = bflo(raw.x); d[1] = bfhi(raw.x); d[2] = bflo(raw.y); d[3] = bfhi(raw.y); d[4] = bflo(raw.z); d[5] = bfhi(raw.z); d[6] = bflo(raw.w); d[7] = bfhi(raw.w);
    }
    __syncthreads();
    {
      const int cc = tid >> 3, r8 = (tid & 7) * 8;
      f32x4 a, b;
      a.x = tile[(r8 + 0) * 65 + cc]; a.y = tile[(r8 + 1) * 65 + cc]; a.z = tile[(r8 + 2) * 65 + cc]; a.w = tile[(r8 + 3) * 65 + cc];
      b.x = tile[(r8 + 4) * 65 + cc]; b.y = tile[(r8 + 5) * 65 + cc]; b.z = tile[(r8 + 6) * 65 + cc]; b.w = tile[(r8 + 7) * 65 + cc];
      float* dst = p.hyT() + (size_t)(col0 + cc) * NLAT + tok0 + r8;
      *(f32x4*)dst = a; *(f32x4*)(dst + 4) = b;
    }
  }
}
__device__ __forceinline__ void ph_s5_regroup(const Params& p) {
  const int gtid = blockIdx.x * NTHREADS + otid(), nthr = gridDim.x * NTHREADS;
  for (int idx = gtid; idx < NTOK * 16; idx += nthr) {
    const int tok = idx >> 4, g = idx & 15;
    const uint4* src = (const uint4*)(p.zmix() + (size_t)tok * NMIX + C_S5 + g * 16);
    uint4* dst = (uint4*)(p.s5u() + ((size_t)g * 1280 + (tok >> 4)) * 256 + (tok & 15) * 16);
    const uint4 a = src[0], b = src[1];
    dst[0] = a; dst[1] = b;
  }
}
__device__ __forceinline__ float conv3_at(const float* col, int t, float w0, float w1, float w2, float b) {
  const float m = t > 0 ? col[t - 1] : 0.f, pl = t < SEQL - 1 ? col[t + 1] : 0.f;
  return m * w0 + col[t] * w1 + pl * w2 + b;
}
__device__ __forceinline__ void hyena_fft_task(const Params& p, int l, int c) {
  const int tid = otid();
  cf* X = (cf*)smem;
  const cf* tw = (const cf*)p.twid();
  const float* hf = p.hraw() + ((size_t)l * 2 * 256 + c) * SEQL;
  const float* hb = p.hraw() + ((size_t)l * 2 * 256 + 256 + c) * SEQL;
  __syncthreads();
  for (int n = tid; n < FFT_N; n += NTHREADS) {
    const float v = n < SEQL ? hf[n] : (n == SEQL ? 0.f : hb[FFT_N - n]);
    X[fphys(n)] = cf{v, 0.f};
  }
  __syncthreads();
  for (int ps = 1; ps <= 4; ++ps) { fft_pass<false>(X, tw, ps, tid, NTHREADS); __syncthreads(); }
  cf* Kg = (cf*)p.hspec() + (size_t)c * FFT_N;
  for (int i = 0; i < 32; ++i) Kg[i * NTHREADS + tid] = X[fphys(i * NTHREADS + tid)];
  __syncthreads();
  const float* cw = p.in[I_HYCW] + l * 3 * 768;
  const float* cb = p.in[I_HYCB] + l * 768;
  const float w00 = cw[c], w01 = cw[768 + c], w02 = cw[1536 + c], b0 = cb[c];
  const float w10 = cw[256 + c], w11 = cw[768 + 256 + c], w12 = cw[1536 + 256 + c], b1 = cb[256 + c];
  const float w20 = cw[512 + c], w21 = cw[768 + 512 + c], w22 = cw[1536 + 512 + c], b2 = cb[512 + c];
  const float* x0c = p.hyT() + (size_t)c * NLAT;
  const float* x1c = p.hyT() + (size_t)(256 + c) * NLAT;
  const float* vc = p.hyT() + (size_t)(512 + c) * NLAT;
  for (int n = tid; n < FFT_N; n += NTHREADS) {
    cf z = {0.f, 0.f};
    if (n < SEQL) {
      z.x = conv3_at(vc, n, w20, w21, w22, b2) * conv3_at(x1c, n, w10, w11, w12, b1);
      z.y = conv3_at(vc + SEQL, n, w20, w21, w22, b2) * conv3_at(x1c + SEQL, n, w10, w11, w12, b1);
    }
    X[fphys(n)] = z;
  }
  __syncthreads();
  for (int ps = 1; ps <= 4; ++ps) { fft_pass<false>(X, tw, ps, tid, NTHREADS); __syncthreads(); }
#pragma unroll 4
  for (int i = 0; i < 32; ++i) { const int ph = fphys(i * NTHREADS + tid); X[ph] = cmul(X[ph], Kg[i * NTHREADS + tid]); }
  __syncthreads();
  for (int ps = 4; ps >= 1; --ps) { fft_pass<true>(X, tw, ps, tid, NTHREADS); __syncthreads(); }
  const float scl = p.hscale()[l * 256 + c] * (1.0f / (float)FFT_N), skip = p.in[I_HYSKIP][l * 256 + c];
  for (int t = tid; t < SEQL; t += NTHREADS) {
    const cf y = X[fphys(t)];
    const float u0 = conv3_at(vc, t, w20, w21, w22, b2) * conv3_at(x1c, t, w10, w11, w12, b1);
    const float u1 = conv3_at(vc + SEQL, t, w20, w21, w22, b2) * conv3_at(x1c + SEQL, t, w10, w11, w12, b1);
    const float x00 = conv3_at(x0c, t, w00, w01, w02, b0), x01 = conv3_at(x0c + SEQL, t, w00, w01, w02, b0);
    bf16_t* hyo = (bf16_t*)(p.hspec() + (size_t)c * FFT_N * 2);
    hyo[t] = f2bf((y.x * scl + u0 * skip) * x00);
    hyo[SEQL + t] = f2bf((y.y * scl + u1 * skip) * x01);
  }
}

__device__ __forceinline__ void unpack8(const uint4 r, float (&v)[8]) {
  v[0] = bflo(r.x); v[1] = bfhi(r.x); v[2] = bflo(r.y); v[3] = bfhi(r.y); v[4] = bflo(r.z); v[5] = bfhi(r.z); v[6] = bflo(r.w); v[7] = bfhi(r.w);
}
__device__ __forceinline__ float fsigmoid(float x) { return __builtin_amdgcn_rcpf(1.0f + __builtin_amdgcn_exp2f(-1.4426950408889634f * x)); }

template <bool PASSC>
__device__ __forceinline__ void hgrn_task(const Params& p, int l, int task, float* wl  ) {
  const int lane = otid() & 63;
  const int chunk = task % NCHUNK, r = task / NCHUNK, h = r & 3, dir = (r >> 2) & 1, b = r >> 3;
  float* lf = wl; float* lq = wl + 1024; float* lv = wl + 2048;
  f32x2 S[32];
  if (PASSC) {
#pragma unroll
    for (int d = 0; d < 32; ++d) { S[d].x = p.hgU()[((size_t)task * 64 + 2 * d) * 64 + lane]; S[d].y = p.hgU()[((size_t)task * 64 + 2 * d + 1) * 64 + lane]; }
  } else {
#pragma unroll
    for (int d = 0; d < 32; ++d) S[d] = (f32x2){0.f, 0.f};
  }
  const int d8 = (lane & 7) * 8;
  float lb8[8], dp[8];
#pragma unroll
  for (int j = 0; j < 8; ++j) { lb8[j] = p.lb()[(l * 2 + dir) * 256 + h * 64 + d8 + j]; dp[j] = 1.0f; }
  uint4 rf[2], rq[2], rv[2];
  auto gload = [&](int sub) {
#pragma unroll
    for (int k = 0; k < 2; ++k) {
      const int i = (lane >> 3) + 8 * k;
      const bf16_t* z = p.zmix() + (size_t)scan_tok(chunk * 64 + sub * 16 + i, dir, b) * NMIX + h * 64 + d8;
      rf[k] = *(const uint4*)(z + C_HGF + dir * 256);
      if (PASSC) rq[k] = *(const uint4*)(z + C_HGQ);
      rv[k] = *(const uint4*)(z + C_HGI);
    }
  };
  float* outp = p.hgo() + (size_t)dir * NTOK * 256;
  gload(0);
  for (int sub = 0; sub < 4; ++sub) {
    LDS_FENCE();
#pragma unroll
    for (int k = 0; k < 2; ++k) {
      const int i = (lane >> 3) + 8 * k;
      float t8[8];
      unpack8(rf[k], t8);
#pragma unroll
      for (int j = 0; j < 8; ++j) { t8[j] = lb8[j] + (1.0f - lb8[j]) * fsigmoid(t8[j]); dp[j] *= t8[j]; }
      *(f32x4*)&lf[i * 64 + d8] = (f32x4){t8[0], t8[1], t8[2], t8[3]}; *(f32x4*)&lf[i * 64 + d8 + 4] = (f32x4){t8[4], t8[5], t8[6], t8[7]};
      if (PASSC) { unpack8(rq[k], t8); *(f32x4*)&lq[i * 64 + d8] = (f32x4){t8[0], t8[1], t8[2], t8[3]}; *(f32x4*)&lq[i * 64 + d8 + 4] = (f32x4){t8[4], t8[5], t8[6], t8[7]}; }
      unpack8(rv[k], t8);
      *(f32x4*)&lv[i * 64 + d8] = (f32x4){t8[0], t8[1], t8[2], t8[3]}; *(f32x4*)&lv[i * 64 + d8 + 4] = (f32x4){t8[4], t8[5], t8[6], t8[7]};
    }
    LDS_FENCE();
    if (sub < 3) gload(sub + 1);
    const int s0 = chunk * 64 + sub * 16;
    for (int i = 0; i < 16; ++i) {
      const float v = lv[i * 64 + lane];
      const f32x2 v2 = {v, v};
      f32x2 o2 = {0.f, 0.f};
#pragma unroll
      for (int d4 = 0; d4 < 16; ++d4) {
        const f32x4 f4 = *(const f32x4*)&lf[i * 64 + d4 * 4];
        const f32x2 fa = {f4.x, f4.y}, fb = {f4.z, f4.w};
        S[2 * d4] = fa * (S[2 * d4] - v2) + v2;
        S[2 * d4 + 1] = fb * (S[2 * d4 + 1] - v2) + v2;
        if (PASSC) {
          const f32x4 q4 = *(const f32x4*)&lq[i * 64 + d4 * 4];
          o2 = S[2 * d4] * (f32x2){q4.x, q4.y} + o2;
          o2 = S[2 * d4 + 1] * (f32x2){q4.z, q4.w} + o2;
        }
      }
      if (PASSC) outp[(size_t)scan_tok(s0 + i, dir, b) * 256 + h * 64 + lane] = o2.x + o2.y;
    }
  }
  if (!PASSC) {
#pragma unroll
    for (int d = 0; d < 32; ++d) { p.hgU()[((size_t)task * 64 + 2 * d) * 64 + lane] = S[d].x; p.hgU()[((size_t)task * 64 + 2 * d + 1) * 64 + lane] = S[d].y; }
#pragma unroll
    for (int j = 0; j < 8; ++j) { dp[j] *= __shfl_xor(dp[j], 8); dp[j] *= __shfl_xor(dp[j], 16); dp[j] *= __shfl_xor(dp[j], 32); }
    if (lane < 8) {
#pragma unroll
      for (int j = 0; j < 8; ++j) p.hgD()[(size_t)task * 64 + d8 + j] = dp[j];
    }
  }
}

template <bool PASSC>
__device__ __forceinline__ void ret_task(const Params& p, int l, int task, float* wl) {
  const int lane = otid() & 63;
  const int chunk = task % NCHUNK, r = task / NCHUNK, h = r & 3, dir = (r >> 2) & 1, b = r >> 3;
  float* lq = wl; float* lk = wl + 512; float* lv = wl + 1024;
  const float gamma = sigmoidf_(p.in[I_RETDEC][(l * 2 + dir) * 4 + h]);
  const f32x2 g2 = {gamma, gamma};
  f32x2 S[16];
  if (PASSC) {
#pragma unroll
    for (int d = 0; d < 16; ++d) { S[d].x = p.rtU()[((size_t)task * 32 + 2 * d) * 64 + lane]; S[d].y = p.rtU()[((size_t)task * 32 + 2 * d + 1) * 64 + lane]; }
  } else {
#pragma unroll
    for (int d = 0; d < 16; ++d) S[d] = (f32x2){0.f, 0.f};
  }
  const int qi = lane >> 2, qd8 = (lane & 3) * 8;
  const int vd8 = (lane & 7) * 8;
  uint4 rq, rk, rv[2];
  auto gload = [&](int sub) {
    const bf16_t* z = p.zmix() + (size_t)scan_tok(chunk * 64 + sub * 16 + qi, dir, b) * NMIX + h * 32 + qd8;
    if (PASSC) rq = *(const uint4*)(z + C_RQ);
    rk = *(const uint4*)(z + C_RK);
#pragma unroll
    for (int k = 0; k < 2; ++k) {
      const int i = (lane >> 3) + 8 * k;
      rv[k] = *(const uint4*)(p.zmix() + (size_t)scan_tok(chunk * 64 + sub * 16 + i, dir, b) * NMIX + C_RV + h * 64 + vd8);
    }
  };
  float* outp = p.rto() + (size_t)dir * NTOK * 256;
  gload(0);
  for (int sub = 0; sub < 4; ++sub) {
    const int s0 = chunk * 64 + sub * 16;
    LDS_FENCE();
    {
      const int tok = scan_tok(s0 + qi, dir, b);
      float kq[8], kk[8];
      if (PASSC) unpack8(rq, kq);
      unpack8(rk, kk);
#pragma unroll
      for (int j = 0; j < 8; ++j) kk[j] *= 0.17677669529663687f;
      if (tok >= NCTX) {
        const int tt = (tok - NCTX) & (SEQL - 1);
        const int pos = (qd8 & 16) ? (tt & 63) : (tt >> 6);
        const float* cs = p.rope() + pos * 16;
        const bool second = qd8 & 8;
#pragma unroll
        for (int j = 0; j < 8; ++j) {
          const float c = cs[2 * j], s = cs[2 * j + 1];
          const float okk = __shfl_xor(kk[j], 1);
          kk[j] = second ? (okk * s + kk[j] * c) : (kk[j] * c - okk * s);
          if (PASSC) { const float oq = __shfl_xor(kq[j], 1); kq[j] = second ? (oq * s + kq[j] * c) : (kq[j] * c - oq * s); }
        }
      }
      if (PASSC) { *(f32x4*)&lq[qi * 32 + qd8] = (f32x4){kq[0], kq[1], kq[2], kq[3]}; *(f32x4*)&lq[qi * 32 + qd8 + 4] = (f32x4){kq[4], kq[5], kq[6], kq[7]}; }
      *(f32x4*)&lk[qi * 32 + qd8] = (f32x4){kk[0], kk[1], kk[2], kk[3]}; *(f32x4*)&lk[qi * 32 + qd8 + 4] = (f32x4){kk[4], kk[5], kk[6], kk[7]};
#pragma unroll
      for (int k = 0; k < 2; ++k) {
        const int i = (lane >> 3) + 8 * k;
        float t8[8];
        unpack8(rv[k], t8);
        *(f32x4*)&lv[i * 64 + vd8] = (f32x4){t8[0], t8[1], t8[2], t8[3]}; *(f32x4*)&lv[i * 64 + vd8 + 4] = (f32x4){t8[4], t8[5], t8[6], t8[7]};
      }
    }
    LDS_FENCE();
    if (sub < 3) gload(sub + 1);
    for (int i = 0; i < 16; ++i) {
      const float v = lv[i * 64 + lane];
      const f32x2 v2 = {v, v};
      f32x2 o2 = {0.f, 0.f};
#pragma unroll
      for (int d4 = 0; d4 < 8; ++d4) {
        const f32x4 k4 = *(const f32x4*)&lk[i * 32 + d4 * 4];
        S[2 * d4] = g2 * S[2 * d4] + (f32x2){k4.x, k4.y} * v2;
        S[2 * d4 + 1] = g2 * S[2 * d4 + 1] + (f32x2){k4.z, k4.w} * v2;
        if (PASSC) {
          const f32x4 q4 = *(const f32x4*)&lq[i * 32 + d4 * 4];
          o2 = S[2 * d4] * (f32x2){q4.x, q4.y} + o2;
          o2 = S[2 * d4 + 1] * (f32x2){q4.z, q4.w} + o2;
        }
      }
      if (PASSC) outp[(size_t)scan_tok(s0 + i, dir, b) * 256 + h * 64 + lane] = o2.x + o2.y;
    }
  }
  if (!PASSC) {
#pragma unroll
    for (int d = 0; d < 16; ++d) { p.rtU()[((size_t)task * 32 + 2 * d) * 64 + lane] = S[d].x; p.rtU()[((size_t)task * 32 + 2 * d + 1) * 64 + lane] = S[d].y; }
  }
}

__device__ __forceinline__ f32x4 mfma16(bf16x8 x, bf16x8 y, f32x4 c) { return __builtin_amdgcn_mfma_f32_16x16x32_bf16(x, y, c, 0, 0, 0); }
__device__ __forceinline__ float fexp(float x) { return __builtin_amdgcn_exp2f(1.4426950408889634f * x); }

template <int DK, bool PASSC, bool RET>
__device__ __forceinline__ void chunk_task(const Params& p, int l, int task, unsigned char* wlds  ) {
  const int lane = otid() & 63, fr = lane & 15, fq = lane >> 4;
  const int chunk = task % NCHUNK, r = task / NCHUNK, h = r & 3, dir = (r >> 2) & 1, b = r >> 3;
  constexpr int NDT = DK / 16, NKS = DK / 32;
  bf16_t* Qh = (bf16_t*)wlds;
  bf16_t* Kt = Qh + 1024;
  bf16_t* KtT = Kt + 1024;
  bf16_t* VT = KtT + 1024;
  bf16_t* Pm = VT + 1024;
  bf16_t* ST = Pm + 256;
  float* Dl = (float*)(ST + 4096);
  float* Ustate = RET ? p.rtU() : p.hgU();
  f32x4 S[NDT][4];
#pragma unroll
  for (int dt = 0; dt < NDT; ++dt)
#pragma unroll
    for (int et = 0; et < 4; ++et) {
      if (PASSC) {
#pragma unroll
        for (int j = 0; j < 4; ++j) S[dt][et][j] = Ustate[((size_t)task * DK + 16 * dt + 4 * fq + j) * 64 + 16 * et + fr];
      } else S[dt][et] = (f32x4){0.f, 0.f, 0.f, 0.f};
    }
  float lbv = 0.f, gam = 1.f;
  if (RET) gam = sigmoidf_(p.in[I_RETDEC][(l * 2 + dir) * 4 + h]);
  else if (lane < DK) lbv = p.lb()[(l * 2 + dir) * 256 + h * 64 + lane];
  float btot = 1.f;
  const int colF = RET ? (C_RK + h * 32) : (C_HGF + dir * 256 + h * 64);
  const int colQ = RET ? (C_RQ + h * 32) : (C_HGQ + h * 64);
  const int colV = RET ? (C_RV + h * 64) : (C_HGI + h * 64);
  const int lq = lane < DK ? lane : 0;
  unsigned rf[16], rq[16], rv[16];
  auto gload = [&](int sub) {
#pragma unroll
    for (int t = 0; t < 16; ++t) {
      const bf16_t* z = p.zmix() + (size_t)scan_tok(chunk * 64 + sub * 16 + t, dir, b) * NMIX;
      rf[t] = z[colF + lq];
      if (PASSC) rq[t] = z[colQ + lq];
      rv[t] = z[colV + lane];
    }
  };
  float* outp = (RET ? p.rto() : p.hgo()) + (size_t)dir * NTOK * 256;
  gload(0);
  for (int sub = 0; sub < 4; ++sub) {
    const int s0 = chunk * 64 + sub * 16;
    LDS_FENCE();
    {
      float kk[16], qq[16];
#pragma unroll
      for (int t = 0; t < 16; ++t) { kk[t] = __uint_as_float(rf[t] << 16); qq[t] = PASSC ? __uint_as_float(rq[t] << 16) : 0.f; }
      unsigned vpk[8];
#pragma unroll
      for (int t = 0; t < 8; ++t) vpk[t] = (rv[2 * t] & 0xffffu) | (rv[2 * t + 1] << 16);
      *(uint4*)&VT[lane * 16] = make_uint4(vpk[0], vpk[1], vpk[2], vpk[3]);
      *(uint4*)&VT[lane * 16 + 8] = make_uint4(vpk[4], vpk[5], vpk[6], vpk[7]);
      if (sub < 3) gload(sub + 1);
      if (RET) {
        const bool lat = scan_tok(s0, dir, b) >= NCTX;
        f32x2 cs[16];
#pragma unroll
        for (int t = 0; t < 16; ++t) {
          const int tt = (scan_tok(s0 + t, dir, b) - NCTX) & (SEQL - 1);
          const int pos = lat ? ((lane & 16) ? (tt & 63) : (tt >> 6)) : 0;
          cs[t] = *(const f32x2*)&p.rope()[pos * 16 + 2 * (lane & 7)];
        }
        const bool second = lane & 8;
#pragma unroll
        for (int t = 0; t < 16; ++t) {
          kk[t] *= 0.17677669529663687f;
          const float ok = __shfl_xor(kk[t], 8), oq = __shfl_xor(qq[t], 8);
          const float c = cs[t].x, sn = cs[t].y;
          kk[t] = second ? (ok * sn + kk[t] * c) : (kk[t] * c - ok * sn);
          qq[t] = second ? (oq * sn + qq[t] * c) : (qq[t] * c - oq * sn);
        }
      }
      float cprod = 1.0f;
      unsigned kpk[8];
      float ktv[16];
#pragma unroll
      for (int t = 0; t < 16; ++t) {
        float f, kv;
        if (RET) { f = gam; kv = kk[t]; }
        else { f = lbv + (1.0f - lbv) * fsigmoid(kk[t]); kv = 1.0f - f; }
        cprod *= f;
        const float e1 = fmaxf(cprod, 1e-30f), e2 = __builtin_amdgcn_rcpf(e1);
        ktv[t] = kv * e2;
        if (PASSC) {
          const unsigned qk = pk2(qq[t] * e1, ktv[t]);
          if (lane < DK) { Qh[t * DK + lane] = (bf16_t)(qk & 0xffffu); Kt[t * DK + lane] = (bf16_t)(qk >> 16); }
        }
      }
#pragma unroll
      for (int t = 0; t < 8; ++t) kpk[t] = pk2(ktv[2 * t], ktv[2 * t + 1]);
      if (lane < DK) {
        *(uint4*)&KtT[lane * 16] = make_uint4(kpk[0], kpk[1], kpk[2], kpk[3]);
        *(uint4*)&KtT[lane * 16 + 8] = make_uint4(kpk[4], kpk[5], kpk[6], kpk[7]);
        Dl[lane] = cprod;
      }
      btot *= cprod;
    }
    const bf16x8 zero8 = {0, 0, 0, 0, 0, 0, 0, 0};
    if (PASSC) {
#pragma unroll
      for (int dt = 0; dt < NDT; ++dt)
#pragma unroll
        for (int et = 0; et < 4; ++et)
          *(uint2*)&ST[(16 * et + fr) * DK + 16 * dt + 4 * fq] = make_uint2(pk2(S[dt][et][0], S[dt][et][1]), pk2(S[dt][et][2], S[dt][et][3]));
      LDS_FENCE();
      f32x4 P = {0.f, 0.f, 0.f, 0.f};
#pragma unroll
      for (int ks = 0; ks < NKS; ++ks) {
        const bf16x8 X = *(const bf16x8*)&Kt[fr * DK + 32 * ks + 8 * fq];
        const bf16x8 Y = *(const bf16x8*)&Qh[fr * DK + 32 * ks + 8 * fq];
        P = mfma16(X, Y, P);
      }
#pragma unroll
      for (int j = 0; j < 4; ++j) if (4 * fq + j > fr) P[j] = 0.f;
      *(uint2*)&Pm[fr * 16 + 4 * fq] = make_uint2(pk2(P[0], P[1]), pk2(P[2], P[3]));
      LDS_FENCE();
      const bf16x8 Yp = fq < 2 ? *(const bf16x8*)&Pm[fr * 16 + 8 * fq] : zero8;
      bf16x8 Yq[NKS];
#pragma unroll
      for (int ks = 0; ks < NKS; ++ks) Yq[ks] = *(const bf16x8*)&Qh[fr * DK + 32 * ks + 8 * fq];
      const size_t orow = (size_t)scan_tok(s0 + fr, dir, b) * 256 + h * 64 + 4 * fq;
#pragma unroll
      for (int et = 0; et < 4; ++et) {
        f32x4 O = {0.f, 0.f, 0.f, 0.f};
        const bf16x8 Xv = fq < 2 ? *(const bf16x8*)&VT[(16 * et + fr) * 16 + 8 * fq] : zero8;
        O = mfma16(Xv, Yp, O);
#pragma unroll
        for (int ks = 0; ks < NKS; ++ks) {
          const bf16x8 Xs = *(const bf16x8*)&ST[(16 * et + fr) * DK + 32 * ks + 8 * fq];
          O = mfma16(Xs, Yq[ks], O);
        }
        *(f32x4*)(outp + orow + 16 * et) = O;
      }
    } else {
      LDS_FENCE();
    }
    {
      bf16x8 Yv[4];
#pragma unroll
      for (int et = 0; et < 4; ++et) Yv[et] = fq < 2 ? *(const bf16x8*)&VT[(16 * et + fr) * 16 + 8 * fq] : zero8;
#pragma unroll
      for (int dt = 0; dt < NDT; ++dt) {
        const bf16x8 Xk = fq < 2 ? *(const bf16x8*)&KtT[(16 * dt + fr) * 16 + 8 * fq] : zero8;
        const f32x4 D4 = *(const f32x4*)&Dl[16 * dt + 4 * fq];
#pragma unroll
        for (int et = 0; et < 4; ++et) { S[dt][et] = mfma16(Xk, Yv[et], S[dt][et]); S[dt][et] = S[dt][et] * D4; }
      }
    }
  }
  if (!PASSC) {
#pragma unroll
    for (int dt = 0; dt < NDT; ++dt)
#pragma unroll
      for (int et = 0; et < 4; ++et)
#pragma unroll
        for (int j = 0; j < 4; ++j) Ustate[((size_t)task * DK + 16 * dt + 4 * fq + j) * 64 + 16 * et + fr] = S[dt][et][j];
    if (!RET && lane < DK) p.hgD()[(size_t)task * 64 + lane] = btot;
  }
}

template <bool PASSC>
__device__ __forceinline__ void ph_mix_tasks(const Params& p, int l) {
  const int TID = otid();
  const int wave = TID >> 6;
  unsigned char* wl = smem + wave * 17152;
  const int gw = blockIdx.x * NWAVES + wave, nw = gridDim.x * NWAVES;
  if (PASSC && l == 1) {
    for (int t = gw; t < 16 * 128; t += nw) chunk_task<64, PASSC, false>(p, l, (t >> 7) * NCHUNK + 4 + (t & 127), wl);
    for (int t = gw; t < 16 * 128; t += nw) chunk_task<32, PASSC, true>(p, l, (t >> 7) * NCHUNK + 4 + (t & 127), wl);
  } else {
    for (int t = gw; t < 16 * NCHUNK; t += nw) chunk_task<64, PASSC, false>(p, l, t, wl);
    for (int t = gw >= 64 ? gw - 64 : gw + nw - 64; t < 16 * NCHUNK; t += nw) chunk_task<32, PASSC, true>(p, l, t, wl);
  }
  for (int t = gw >= 64 ? gw - 64 : gw + nw - 64; t < 16 * NCHUNK; t += nw) chunk_task<32, PASSC, true>(p, l, t, wl);
}

__device__ __forceinline__ void ph_scan(const Params& p, int l) {
  const int TID = otid();
  const int gtid = blockIdx.x * NTHREADS + TID, nthr = gridDim.x * NTHREADS;
  for (int idx = gtid; idx < 16 * 4096 + 16 * 2048; idx += nthr) {
    if (idx < 16 * 4096) {
      const int r = idx >> 12, de = idx & 4095, d = de >> 6;
      float s = 0.f;
      float* U = p.hgU() + (size_t)r * NCHUNK * 4096 + de;
      const float* D = p.hgD() + (size_t)r * NCHUNK * 64 + d;
      for (int j0 = 0; j0 < NCHUNK; j0 += 12) {
        float u[12], dd[12];
#pragma unroll
        for (int j = 0; j < 12; ++j) { u[j] = U[(size_t)(j0 + j) * 4096]; dd[j] = D[(j0 + j) * 64]; }
#pragma unroll
        for (int j = 0; j < 12; ++j) { U[(size_t)(j0 + j) * 4096] = s; s = fmaf(dd[j], s, u[j]); }
      }
    } else {
      const int i2 = idx - 16 * 4096;
      const int r = i2 >> 11, de = i2 & 2047, h = r & 3, dir = (r >> 2) & 1;
      const float gamma = sigmoidf_(p.in[I_RETDEC][(l * 2 + dir) * 4 + h]);
      const float g64 = powf(gamma, 64.0f);
      float s = 0.f;
      float* U = p.rtU() + (size_t)r * NCHUNK * 2048 + de;
      for (int j0 = 0; j0 < NCHUNK; j0 += 12) {
        float u[12];
#pragma unroll
        for (int j = 0; j < 12; ++j) u[j] = U[(size_t)(j0 + j) * 2048];
#pragma unroll
        for (int j = 0; j < 12; ++j) { U[(size_t)(j0 + j) * 2048] = s; s = fmaf(g64, s, u[j]); }
      }
    }
  }
}


__device__ __forceinline__ void ph_s5_scan(const Params& p, int l) {
  const int tid = otid();
  f32x2* xl = (f32x2*)smem;
  float* Tl = (float*)smem + 33 * 512 * 2;
  if (blockIdx.x < 128) {
    const int blk = blockIdx.x;
    const int phalf = blk & 1, dir = (blk >> 1) & 1, g = (blk >> 2) & 15, b = blk >> 6;
    const int pl = tid & 31, seg = tid >> 5, pp = phalf * 32 + pl;
    const int sidx = ((l * 2 + dir) * 16 + g) * 64 + pp;
    float ar = p.s5a()[sidx * 2], ai = p.s5a()[sidx * 2 + 1];
#pragma unroll
    for (int k = 0; k < 4; ++k) { const float nr = ar * ar - ai * ai, ni = 2.0f * ar * ai; ar = nr; ai = ni; }
    const unsigned colo = (unsigned)(dir * 128 + pp * 2);
    const char* xbase = (const char*)(p.sX() + (size_t)g * 1280 * 256);
    char* sbase = (char*)(p.sXS() + (size_t)g * 1280 * 256);
    const int sgn = dir ? -1 : 1, offC = b * 16 + (dir ? 15 : 0), offL = b * 512 + (dir ? 559 : 16);
    for (int i0 = 0; i0 < 33; i0 += 11) {
      f32x2 t[11];
#pragma unroll
      for (int k = 0; k < 11; ++k) {
        const int jj = seg * 33 + i0 + k;
        const int row = (jj < 16 ? offC : offL) + sgn * jj;
        t[k] = *(const f32x2*)(xbase + ((unsigned)row * 256u + colo) * 4u);
      }
#pragma unroll
      for (int k = 0; k < 11; ++k) xl[(i0 + k) * 512 + tid] = t[k];
    }
    float sr = 0.f, si = 0.f;
#pragma unroll 3
    for (int i = 0; i < 33; ++i) { const f32x2 t = xl[i * 512 + tid]; xl[i * 512 + tid] = (f32x2){sr, si}; const float nr = ar * sr - ai * si + t.x, ni = ar * si + ai * sr + t.y; sr = nr; si = ni; }
    Tl[tid * 2] = sr; Tl[tid * 2 + 1] = si;
    __syncthreads();
    float br = ar, bi = ai;
#pragma unroll
    for (int k = 0; k < 5; ++k) { const float nr = br * br - bi * bi, ni = 2.0f * br * bi; br = nr; bi = ni; }
    { const float nr = br * ar - bi * ai, ni = br * ai + bi * ar; br = nr; bi = ni; }
    float cr = 0.f, ci = 0.f;
    for (int s2 = 0; s2 < seg; ++s2) { const float tr = Tl[(s2 * 32 + pl) * 2], ti = Tl[(s2 * 32 + pl) * 2 + 1]; const float nr = br * cr - bi * ci + tr, ni = br * ci + bi * cr + ti; cr = nr; ci = ni; }
    float pr = 1.f, pi = 0.f;
#pragma unroll 3
    for (int i = 0; i < 33; ++i) {
      const int jj = seg * 33 + i;
      const int row = (jj < 16 ? offC : offL) + sgn * jj;
      const f32x2 x = xl[i * 512 + tid];
      const float vr = x.x + pr * cr - pi * ci, vi = x.y + pr * ci + pi * cr;
      *(unsigned*)(sbase + ((unsigned)row * 256u + colo) * 2u) = pk2(vr, vi);
      const float nr = pr * ar - pi * ai, ni = pr * ai + pi * ar; pr = nr; pi = ni;
    }
  }
}

__device__ __forceinline__ void cvt_item(const float* W, int ldw, bf16_t* WT, int ldt, int k0, int n0, int ilv, float* scr, int lane) {
  f32x4 v[8];
#pragma unroll
  for (int i = 0; i < 8; ++i) { const int pc = lane + 64 * i; v[i] = *(const f32x4*)(W + (size_t)(k0 + (pc >> 3)) * ldw + n0 + (pc & 7) * 4); }
#pragma unroll
  for (int i = 0; i < 8; ++i) { const int pc = lane + 64 * i; float* d = scr + (pc >> 3) * 33 + (pc & 7) * 4; d[0] = v[i].x; d[1] = v[i].y; d[2] = v[i].z; d[3] = v[i].w; }
  LDS_FENCE();
  const int c = lane & 7;
#pragma unroll
  for (int j = 0; j < 4; ++j) {
    const int n = (lane >> 3) + 8 * j;
    const float* s = scr + (8 * c) * 33 + n;
    uint4 o;
    o.x = pk2(s[0 * 33], s[1 * 33]); o.y = pk2(s[2 * 33], s[3 * 33]); o.z = pk2(s[4 * 33], s[5 * 33]); o.w = pk2(s[6 * 33], s[7 * 33]);
    const int nn = n0 + n;
    const int ilvm = ilv & 255;
    const int drow = ilvm == 0 ? nn : ilvm == 3 ? (nn < NMIX ? nn : NMIX + ((nn - NMIX) & 1023) * 4 + ((nn - NMIX) >> 10)) : ((nn >> 4) * 32 + (ilvm - 1) * 16 + (nn & 15));
    const int drow2 = (ilv & 256) && !((ilv & 255) == 3 && nn >= NMIX) ? ((drow & ~31) | (16 * ((drow >> 2) & 1) + 4 * ((drow >> 3) & 3) + (drow & 3))) : drow;
    *(uint4*)(WT + (size_t)drow2 * ldt + k0 + 8 * c) = o;
  }
  LDS_FENCE();
}
__device__ __forceinline__ void ph_cvt_static(const Params& p) {
  const int tid = otid(), lane = tid & 63, wave = tid >> 6;
  float* scr = (float*)smem + 4096 + wave * 2112;
  constexpr int I_IN = 16 * 224, I_BR = 4 * 4 * 32, I_OUT = 16 * 32, I_GLU = 2 * 4 * 8, I_L = I_IN + I_BR + I_OUT + I_GLU;
  for (int it = blockIdx.x * NWAVES + wave; it < 2 * I_L; it += gridDim.x * NWAVES) {
    const int l = it / I_L; int r = it % I_L;
    if (r < I_IN) { const int kb = r / 224, nb = r % 224; cvt_item(p.in[I_WIN] + (size_t)l * DM * NIN, NIN, p.WinT() + (size_t)l * NIN * DM, DM, kb * 64, nb * 32, 3 | 256, scr, lane); continue; }
    r -= I_IN;
    if (r < I_BR) { const int n = r / 128, q = r % 128, kb = q / 32, nb = q % 32;
      cvt_item(p.in[I_WBR] + (size_t)(l * 4 + n) * 256 * DM, DM, p.WbrT() + (size_t)(l * 4 + n) * DM * 256, 256, kb * 64, nb * 32, 256, scr, lane); continue; }
    r -= I_BR;
    if (r < I_OUT) { const int kb = r / 32, nb = r % 32; cvt_item(p.in[I_WOUT] + (size_t)l * DM * DM, DM, p.WoutT() + (size_t)l * DM * DM, DM, kb * 64, nb * 32, 0, scr, lane); continue; }
    r -= I_OUT;
    { const int which = r / 32, q = r % 32, kb = q / 8, nb = q % 8;
      cvt_item(p.in[which ? I_GLU2 : I_GLU1] + (size_t)l * 256 * 256, 256, p.GluT() + (size_t)l * 512 * 256, 256, kb * 64, nb * 32, 1 + which, scr, lane); }
  }
}
__device__ __forceinline__ void ph_cvt_moe(const Params& p, int l) {
  const int tid = otid(), lane = tid & 63, wave = tid >> 6;
  float* scr = (float*)smem + wave * 2112;
  for (int it = blockIdx.x * NWAVES + wave; it < 32 * 768; it += gridDim.x * NWAVES) {
    const int e = it / 768; int r = it % 768;
    if (r < 512) { const int which = r >> 8, q = r & 255, kb = q / 16, nb = q % 16;
      cvt_item(p.in[which ? I_MW3 : I_MW1] + (size_t)(l * 32 + e) * DM * 512, 512, p.W13T() + (size_t)e * DM * DM, DM, kb * 64, nb * 32, 1 + which, scr, lane); }
    else { r -= 512; const int kb = r / 32, nb = r % 32;
      cvt_item(p.in[I_MW2] + (size_t)(l * 32 + e) * 512 * DM, DM, p.W2T() + (size_t)e * DM * 512, 512, kb * 64, nb * 32, 256, scr, lane); }
  }
}

namespace g8 {
constexpr int BM = 256, BK = 64, HALF = 128, HTB = HALF * BK * 2, STAGE_BYTES = 8 * HTB, NXCD = 8, WGM = 8;
__device__ __forceinline__ int lds_byte(int r, int c) { const int st = (r >> 4) * 2 + (c >> 5), rr = r & 15, cc = c & 31, ob = rr * 64 + cc * 2; return st * 1024 + (ob ^ (((ob >> 9) & 1) << 5)); }
__device__ __forceinline__ void stage_rc(int b, int& R, int& C) { const int st = b / 1024, sb = b % 1024, swz = sb ^ (((sb >> 9) & 1) << 5); R = (st >> 1) * 16 + swz / 64; C = (st & 1) * 32 + (swz % 64) / 2; }

struct Unit { const char* A; const char* B; int pm, pn, aux, keep, info; };
typedef f32x4 Acc[2][2][4][2];

__device__ __forceinline__ bool static_tile(int L, int nM, int nN, int& pm, int& pn) {
  const int nwg = nM * nN;
  if (L >= nwg) return false;
  int wgid = L; { const int q = nwg / NXCD, r = nwg % NXCD, xcd = wgid % NXCD, off = wgid / NXCD; wgid = (xcd < r ? xcd * (q + 1) : r * (q + 1) + (xcd - r) * q) + off; }
  const int nig = WGM * nN, gid = wgid / nig, fm = gid * WGM, gsz = (nM - fm) < WGM ? (nM - fm) : WGM;
  pm = fm + ((wgid % nig) % gsz); pn = (wgid % nig) / gsz;
  return true;
}

template <class Src, class Epi>
__device__ __forceinline__ void gemm_stream(LAS unsigned char* lds, const Src& S, const Epi& E, const int K, const int ldb) {
  const int tid = otid(), wid = __builtin_amdgcn_readfirstlane(tid >> 6), lane = tid & 63, wr = wid >> 2, wc = wid & 3, fr = lane & 15, fq = lane >> 4;
  const int nt = K / BK;
  int Rs[2], Cs[2]; unsigned voffB[2];
#pragma unroll
  for (int i = 0; i < 2; ++i) { stage_rc(tid * 16 + i * 8192, Rs[i], Cs[i]); voffB[i] = (unsigned)(Rs[i] * ldb + Cs[i]) * 2u; }
  const size_t kstep = (size_t)(BK * 2);
  const size_t hstepB = (size_t)HALF * ldb * 2;
  const unsigned ldsw = (unsigned)wid * 1024u;
  const int aoff = lds_byte(wr * 64 + fr, fq * 8), boff = lds_byte(wc * 32 + fr, fq * 8);
#define G8_SA(b, h) (((b) * 2 + (h)) * HTB)
#define G8_SB(b, h) ((4 + (b) * 2 + (h)) * HTB)
#define G8_STAGE(bufoff, gbase, voff) do { _Pragma("unroll") for (int _i = 0; _i < 2; ++_i) \
        __builtin_amdgcn_global_load_lds((const unsigned*)((const char*)(gbase) + (voff)[_i]), (LAS unsigned*)(lds + (bufoff) + ldsw + _i * 8192), 16, 0, 0); } while (0)
#define G8_LDA(dst, b, h) do { _Pragma("unroll") for (int m = 0; m < 4; ++m) _Pragma("unroll") for (int k = 0; k < 2; ++k) dst[m][k] = *(const LAS bf16x8*)(lds + G8_SA(b, h) + aoff + m * 2048 + k * 1024); } while (0)
#define G8_LDB(dst, b, h) do { _Pragma("unroll") for (int n = 0; n < 2; ++n) _Pragma("unroll") for (int k = 0; k < 2; ++k) dst[n][k] = *(const LAS bf16x8*)(lds + G8_SB(b, h) + boff + n * 2048 + k * 1024); } while (0)
#define G8_MMA(ai, bj, At, Bt) do { __builtin_amdgcn_s_setprio(1); _Pragma("unroll") for (int m = 0; m < 4; ++m) _Pragma("unroll") for (int n = 0; n < 2; ++n) _Pragma("unroll") for (int k = 0; k < 2; ++k) \
        acc[ai][bj][m][n] = __builtin_amdgcn_mfma_f32_16x16x32_bf16(Bt[n][k], At[m][k], acc[ai][bj][m][n], 0, 0, 0); __builtin_amdgcn_s_setprio(0); } while (0)
#define G8_WAIT_V(n) asm volatile("s_waitcnt vmcnt(" #n ")" ::: "memory")
#define G8_WAIT_L(n) asm volatile("s_waitcnt lgkmcnt(" #n ")" ::: "memory")
#define G8_BAR __builtin_amdgcn_s_barrier()
#define G8_SCHED __builtin_amdgcn_sched_barrier(0)
  Unit cur, nxt; int ui = 0;
  if (!S.next(0, cur)) return;
  unsigned vAc[2][2], vAn[2][2];
  S.voff(cur, Rs, Cs, vAc);
  Acc acc;
#pragma unroll
  for (int a = 0; a < 2; ++a)
#pragma unroll
    for (int b = 0; b < 2; ++b)
#pragma unroll
      for (int m = 0; m < 4; ++m)
#pragma unroll
        for (int n = 0; n < 2; ++n) acc[a][b][m][n] = (f32x4){0.f, 0.f, 0.f, 0.f};
  bf16x8 At[4][2], B0[2][2], B1[2][2];
  const char* cA = cur.A; const char* cB = cur.B;
  G8_STAGE(G8_SB(0, 0), cB, voffB); G8_STAGE(G8_SA(0, 0), cA, vAc[0]); G8_STAGE(G8_SB(0, 1), cB + hstepB, voffB); G8_STAGE(G8_SA(0, 1), cA, vAc[1]);
  if (wr == 1) G8_BAR;
  G8_WAIT_V(4); G8_BAR;
  G8_STAGE(G8_SB(1, 0), cB + kstep, voffB); G8_STAGE(G8_SA(1, 0), cA + kstep, vAc[0]); G8_STAGE(G8_SB(1, 1), cB + hstepB + kstep, voffB);
  G8_WAIT_V(6); G8_BAR;
  for (;;) {
    const bool has_next = S.next(ui + 1, nxt);
    if (has_next) S.voff(nxt, Rs, Cs, vAn);
    else { vAn[0][0] = vAc[0][0]; vAn[0][1] = vAc[0][1]; vAn[1][0] = vAc[1][0]; vAn[1][1] = vAc[1][1]; }
    const char* nA = has_next ? nxt.A : cA; const char* nB = has_next ? nxt.B : cB;
    for (int t = 0; t < nt; t += 2) {
      const bool last = (t == nt - 2);
      const char* a1 = cA + (size_t)(t + 1) * kstep;
      const char* a2 = last ? nA : cA + (size_t)(t + 2) * kstep; const char* b2 = last ? nB : cB + (size_t)(t + 2) * kstep;
      const char* a3 = a2 + kstep; const char* b3 = b2 + kstep;
      unsigned va2[2][2];
      va2[0][0] = last ? vAn[0][0] : vAc[0][0]; va2[0][1] = last ? vAn[0][1] : vAc[0][1]; va2[1][0] = last ? vAn[1][0] : vAc[1][0]; va2[1][1] = last ? vAn[1][1] : vAc[1][1];
      G8_LDB(B0, 0, 0); G8_SCHED; G8_LDA(At, 0, 0); G8_STAGE(G8_SA(1, 1), a1, vAc[1]);
      G8_WAIT_L(8); G8_BAR; G8_WAIT_L(0); G8_MMA(0, 0, At, B0); G8_BAR; G8_SCHED;
      G8_LDB(B1, 0, 1); G8_STAGE(G8_SB(0, 0), b2, voffB);
      G8_BAR; G8_WAIT_L(0); G8_MMA(0, 1, At, B1); G8_BAR;
      G8_LDA(At, 0, 1); G8_STAGE(G8_SA(0, 0), a2, va2[0]);
      G8_BAR; G8_WAIT_L(0); G8_MMA(1, 0, At, B0); G8_BAR; G8_SCHED;
      G8_STAGE(G8_SB(0, 1), b2 + hstepB, voffB);
      G8_WAIT_V(6); G8_BAR; G8_MMA(1, 1, At, B1); G8_BAR;
      G8_LDB(B0, 1, 0); G8_SCHED; G8_LDA(At, 1, 0); G8_STAGE(G8_SA(0, 1), a2, va2[1]);
      G8_WAIT_L(8); G8_BAR; G8_WAIT_L(0); G8_MMA(0, 0, At, B0); G8_BAR; G8_SCHED;
      G8_LDB(B1, 1, 1); G8_STAGE(G8_SB(1, 0), b3, voffB);
      G8_BAR; G8_WAIT_L(0); G8_MMA(0, 1, At, B1); G8_BAR;
      G8_LDA(At, 1, 1); G8_STAGE(G8_SA(1, 0), a3, va2[0]);
      G8_BAR; G8_WAIT_L(0); G8_MMA(1, 0, At, B0); G8_BAR; G8_SCHED;
      G8_STAGE(G8_SB(1, 1), b3 + hstepB, voffB);
      G8_WAIT_V(6); G8_BAR; G8_MMA(1, 1, At, B1); G8_BAR;
    }
    E(acc, cur, wr, wc, fr, fq);
    if (!has_next) break;
    if (!cur.keep) {
#pragma unroll
      for (int a = 0; a < 2; ++a)
#pragma unroll
        for (int b = 0; b < 2; ++b)
#pragma unroll
          for (int m = 0; m < 4; ++m)
#pragma unroll
            for (int n = 0; n < 2; ++n) acc[a][b][m][n] = (f32x4){0.f, 0.f, 0.f, 0.f};
    }
    cur = nxt; cA = nA; cB = nB; ++ui;
    vAc[0][0] = vAn[0][0]; vAc[0][1] = vAn[0][1]; vAc[1][0] = vAn[1][0]; vAc[1][1] = vAn[1][1];
  }
  G8_WAIT_V(0);
  if (wr == 0) G8_BAR;
  G8_BAR;
#undef G8_SA
#undef G8_SB
#undef G8_STAGE
#undef G8_LDA
#undef G8_LDB
#undef G8_MMA
#undef G8_WAIT_V
#undef G8_WAIT_L
#undef G8_BAR
#undef G8_SCHED
}

struct DenseSrc {
  const bf16_t* A; const bf16_t* B; int lda, ldb, nM, nN, G, c;
  __device__ __forceinline__ bool next(int i, Unit& u) const {
    int pm, pn;
    if (!static_tile(i * G + c, nM, nN, pm, pn)) return false;
    u.A = (const char*)(A + (size_t)pm * 256 * lda); u.B = (const char*)(B + (size_t)pn * 256 * ldb); u.pm = pm; u.pn = pn; u.aux = 0; u.keep = 0; u.info = 0;
    return true;
  }
  __device__ __forceinline__ void voff(const Unit&, const int (&R)[2], const int (&C)[2], unsigned (&v)[2][2]) const {
#pragma unroll
    for (int h = 0; h < 2; ++h)
#pragma unroll
      for (int i = 0; i < 2; ++i) v[h][i] = (unsigned)((h * 128 + R[i]) * lda + C[i]) * 2u;
  }
};
struct MergeSrc {
  const bf16_t* A; const bf16_t* B; int nM, G, c;
  __device__ __forceinline__ bool next(int i, Unit& u) const {
    int pm, pn;
    if (!static_tile((i >> 2) * G + c, nM, 4, pm, pn)) return false;
    const int n = i & 3;
    u.A = (const char*)(A + (size_t)pm * 256 * DM + n * 256); u.B = (const char*)(B + ((size_t)n * DM + pn * 256) * 256); u.pm = pm; u.pn = pn; u.aux = n; u.keep = n < 3; u.info = 0;
    return true;
  }
  __device__ __forceinline__ void voff(const Unit&, const int (&R)[2], const int (&C)[2], unsigned (&v)[2][2]) const {
#pragma unroll
    for (int h = 0; h < 2; ++h)
#pragma unroll
      for (int i = 0; i < 2; ++i) v[h][i] = (unsigned)((h * 128 + R[i]) * DM + C[i]) * 2u;
  }
};
__device__ __forceinline__ void moe_build_table(const int* cnt) {
  const int TID = otid();
  int* tb = (int*)(smem + 131072);
  __syncthreads();
  if (TID < 32) tb[TID * 4 + 2] = cnt[TID * 32];
  __syncthreads();
  if (TID < 64) {
    const int lane = TID;
    const int ce = lane < 32 ? tb[lane * 4 + 2] : 0;
    int pre = ce;
#pragma unroll
    for (int o = 1; o < 32; o <<= 1) { const int t = __shfl_up(pre, o); if ((lane & 31) >= o) pre += t; }
    if (lane < 32) tb[lane * 4 + 1] = pre - ce;
    bool asg = lane >= 32 || ce <= 0;
    int gcount = 0, gload = 0;
    for (int it = 0; it < 32; ++it) {
      int key = asg ? -1 : (ce * 64 + (63 - lane));
#pragma unroll
      for (int o = 1; o < 64; o <<= 1) key = max(key, __shfl_xor(key, o));
      if (key < 0) break;
      const int be = 63 - (key & 63), bc = key >> 6;
      int gk = lane < 8 ? (gload * 8 + lane) : 0x7fffffff;
#pragma unroll
      for (int o = 1; o < 8; o <<= 1) gk = min(gk, __shfl_xor(gk, o));
      const int bx = __shfl(gk, 0) & 7;
      if (lane == bx) { int* g = tb + 256 + bx * 80; g[2 + gcount] = be; g[40 + gcount] = gload; gcount += 1; gload += (bc + 255) >> 8; }
      if (lane == be) asg = true;
    }
    if (lane < 8) { tb[256 + lane * 80] = gcount; tb[256 + lane * 80 + 1] = gload; }
  }
  __syncthreads();
}
template <bool GATHER>
struct MoeSrc {
  const int* alist; const bf16_t* A; const bf16_t* B; int lda, ldb, G, c; size_t bexp;
  __device__ __forceinline__ bool next(int i, Unit& u) const {
    const int* tb = (const int*)(smem + 131072);
    const int x = c & 7, j = c >> 3, q = i * (G >> 3) + j, tq = q >> 2, pn = q & 3;
    const int* g = tb + 256 + x * 80;
    if (tq >= __builtin_amdgcn_readfirstlane(g[1])) return false;
    const int ng = __builtin_amdgcn_readfirstlane(g[0]);
    int k = 0;
    for (int kk = 1; kk < ng; ++kk) if (__builtin_amdgcn_readfirstlane(g[40 + kk]) <= tq) k = kk;
    const int e = __builtin_amdgcn_readfirstlane(g[2 + k]), t0 = __builtin_amdgcn_readfirstlane(g[40 + k]);
    const int s0 = __builtin_amdgcn_readfirstlane(tb[e * 4 + 1]), ce = __builtin_amdgcn_readfirstlane(tb[e * 4 + 2]);
    const int r0 = (tq - t0) * 256;
    u.aux = s0 + r0; u.pm = min(256, ce - r0); u.pn = pn; u.keep = 0; u.info = (e << 16) | r0;
    u.A = (const char*)A; u.B = (const char*)(B + (size_t)e * bexp + (size_t)pn * 256 * ldb);
    return true;
  }
  __device__ __forceinline__ void voff(const Unit& u, const int (&R)[2], const int (&C)[2], unsigned (&v)[2][2]) const {
    const int e = u.info >> 16, r0 = u.info & 0xffff;
#pragma unroll
    for (int h = 0; h < 2; ++h)
#pragma unroll
      for (int i = 0; i < 2; ++i) {
        const int r = min(h * 128 + R[i], u.pm - 1);
        const int row = GATHER ? (alist[e * NTOK + r0 + r] >> 1) : (u.aux + r);
        v[h][i] = (unsigned)(row * lda + C[i]) * 2u;
      }
  }
};
#define G8_FOREACH(...)                                                                                           \
  _Pragma("unroll") for (int ai = 0; ai < 2; ++ai) _Pragma("unroll") for (int m = 0; m < 4; ++m) {                  \
    const int trow = ai * 128 + wr * 64 + m * 16 + fr;                                                            \
    _Pragma("unroll") for (int bj = 0; bj < 2; ++bj) _Pragma("unroll") for (int n = 0; n < 2; ++n) {                \
      const int tcol = bj * 128 + wc * 32 + n * 16 + fq * 4;                                                      \
      const f32x4 v = acc[ai][bj][m][n];                                                                          \
      __VA_ARGS__                                                                                                     \
    }                                                                                                             \
  }
#define G8_FOREACH_P(...)                                                                                         \
  _Pragma("unroll") for (int ai = 0; ai < 2; ++ai) _Pragma("unroll") for (int m = 0; m < 4; ++m) {                  \
    const int trow = ai * 128 + wr * 64 + m * 16 + fr;                                                            \
    _Pragma("unroll") for (int bj = 0; bj < 2; ++bj) {                                                              \
      const int tcol8 = bj * 128 + wc * 32 + fq * 8;                                                              \
      const f32x4 v0 = acc[ai][bj][m][0], v1 = acc[ai][bj][m][1];                                                 \
      __VA_ARGS__                                                                                                 \
    }                                                                                                             \
  }
struct EpiF32 {
  float* C; int ldc;
  __device__ __forceinline__ void operator()(Acc& acc, const Unit& u, int wr, int wc, int fr, int fq) const {
    G8_FOREACH({ *(f32x4*)(C + (size_t)(u.pm * 256 + trow) * ldc + u.pn * 256 + tcol) = v; })
  }
};
struct EpiBf16 {
  bf16_t* O; int ldc;
  __device__ __forceinline__ void operator()(Acc& acc, const Unit& u, int wr, int wc, int fr, int fq) const {
    G8_FOREACH({ *(uint2*)(O + (size_t)(u.pm * 256 + trow) * ldc + u.pn * 256 + tcol) = make_uint2(pk2(v.x, v.y), pk2(v.z, v.w)); })
  }
};
struct EpiZmix {
  bf16_t* Z; float* hyT; bf16_t* s5u;
  __device__ __forceinline__ void operator()(Acc& acc, const Unit& u, int wr, int wc, int fr, int fq) const {
    if (u.pn == 11) {
      G8_FOREACH_P({
        const int tok = u.pm * 256 + trow;
        *(uint4*)(s5u + ((size_t)(tcol8 >> 4) * 1280 + (tok >> 4)) * 256 + (tok & 15) * 16 + (tcol8 & 15)) = make_uint4(pk2(v0.x, v0.y), pk2(v0.z, v0.w), pk2(v1.x, v1.y), pk2(v1.z, v1.w));
      })
    } else if (u.pn >= 5 && u.pn <= 7 && u.pm >= 2) {
      G8_FOREACH_P({
        float* d = hyT + (size_t)((u.pn - 5) * 256 + tcol8) * NLAT + (u.pm * 256 + trow - NCTX);
        d[0] = v0.x; d[NLAT] = v0.y; d[2 * NLAT] = v0.z; d[3 * NLAT] = v0.w;
        d[4 * NLAT] = v1.x; d[5 * NLAT] = v1.y; d[6 * NLAT] = v1.z; d[7 * NLAT] = v1.w;
      })
    } else {
      G8_FOREACH_P({ *(uint4*)(Z + (size_t)(u.pm * 256 + trow) * NMIX + u.pn * 256 + tcol8) = make_uint4(pk2(v0.x, v0.y), pk2(v0.z, v0.w), pk2(v1.x, v1.y), pk2(v1.z, v1.w)); })
    }
  }
};
struct EpiGlu {
  bf16_t* O;
  __device__ __forceinline__ void operator()(Acc& acc, const Unit& u, int wr, int wc, int fr, int fq) const {
#pragma unroll
    for (int ai = 0; ai < 2; ++ai)
#pragma unroll
      for (int m = 0; m < 4; ++m) {
        const int trow = ai * 128 + wr * 64 + m * 16 + fr;
#pragma unroll
        for (int bj = 0; bj < 2; ++bj) {
          const f32x4 a = acc[ai][bj][m][0], b = acc[ai][bj][m][1];
          const int oc = (u.pn * 256 + bj * 128 + wc * 32) / 2 + fq * 4;
          *(uint2*)(O + (size_t)(u.pm * 256 + trow) * DM + 768 + oc) =
              make_uint2(pk2(a.x * sigmoidf_(b.x), a.y * sigmoidf_(b.y)), pk2(a.z * sigmoidf_(b.z), a.w * sigmoidf_(b.w)));
        }
      }
  }
};
struct EpiGates {
  bf16_t* gf;
  int tok_lo;
  __device__ __forceinline__ void operator()(Acc& acc, const Unit& u, int wr, int wc, int fr, int fq) const {
    const bool b0 = fq & 1, b1 = fq & 2;
    bf16_t* base = gf + ((size_t)fq * NTOK + tok_lo + u.pm * 256 + wr * 64 + fr) * 1024 + ((u.pn * 256 + wc * 32) >> 2);
#pragma unroll
    for (int ai = 0; ai < 2; ++ai)
#pragma unroll
      for (int m = 0; m < 4; ++m) {
        bf16_t* rowp = base + (size_t)(ai * 128 + m * 16) * 1024;
        asm volatile("" : "+v"(rowp));
#pragma unroll
        for (int bj = 0; bj < 2; ++bj)
#pragma unroll
          for (int n = 0; n < 2; ++n) {
            const f32x4 v = acc[ai][bj][m][n];
            const float e0 = __builtin_amdgcn_exp2f(-1.4426950408889634f * v.x), e1 = __builtin_amdgcn_exp2f(-1.4426950408889634f * v.y);
            const float e2 = __builtin_amdgcn_exp2f(-1.4426950408889634f * v.z), e3 = __builtin_amdgcn_exp2f(-1.4426950408889634f * v.w);
            float F[4];
            F[0] = (1.0f + e1) * __builtin_amdgcn_rcpf(1.0f + e0); F[1] = (1.0f + e2) * __builtin_amdgcn_rcpf(1.0f + e1);
            F[2] = (1.0f + e3) * __builtin_amdgcn_rcpf(1.0f + e2); F[3] = __builtin_amdgcn_rcpf(1.0f + e3);
            const float sa0 = b0 ? F[0] : F[1], sa1 = b0 ? F[2] : F[3];
            const float ra0 = __shfl_xor(sa0, 16), ra1 = __shfl_xor(sa1, 16);
            const float x00 = b0 ? ra0 : F[0], x01 = b0 ? F[1] : ra0, x10 = b0 ? ra1 : F[2], x11 = b0 ? F[3] : ra1;
            const float sb0 = b1 ? x00 : x10, sb1 = b1 ? x01 : x11;
            const float rb0 = __shfl_xor(sb0, 32), rb1 = __shfl_xor(sb1, 32);
            const float y00 = b1 ? rb0 : x00, y01 = b1 ? rb1 : x01, y10 = b1 ? x10 : rb0, y11 = b1 ? x11 : rb1;
            *(uint2*)(rowp + bj * 32 + n * 4) = make_uint2(pk2(y00, y01), pk2(y10, y11));
          }
      }
  }
};
struct EpiMerge {
  const bf16_t* gf;
  bf16_t* O;
  int tok_lo;
  __device__ __forceinline__ void operator()(Acc& acc, const Unit& u, int wr, int wc, int fr, int fq) const {
    const int n = u.aux;
    const bf16_t* gp = gf + ((size_t)n * NTOK + tok_lo + u.pm * 256 + wr * 64 + fr) * 1024 + u.pn * 256 + wc * 32 + fq * 8;
    bf16_t* op = O + (size_t)(u.pm * 256 + wr * 64 + fr) * DM + u.pn * 256 + wc * 32 + fq * 8;
#pragma unroll
    for (int ai = 0; ai < 2; ++ai) {
      const bf16_t* gpa = gp + (size_t)ai * 128 * 1024;
      bf16_t* opa = op + (size_t)ai * 128 * DM;
      asm volatile("" : "+v"(gpa), "+v"(opa));
      uint4 g[4][2];
#pragma unroll
      for (int m = 0; m < 4; ++m)
#pragma unroll
        for (int bj = 0; bj < 2; ++bj) g[m][bj] = *(const uint4*)(gpa + m * 16 * 1024 + bj * 128);
#pragma unroll
      for (int m = 0; m < 4; ++m)
#pragma unroll
        for (int bj = 0; bj < 2; ++bj) {
          const uint4 a = g[m][bj];
          f32x4 v0 = acc[ai][bj][m][0], v1 = acc[ai][bj][m][1];
          v0.x *= __uint_as_float(a.x << 16); v0.y *= __uint_as_float(a.x & 0xffff0000u); v0.z *= __uint_as_float(a.y << 16); v0.w *= __uint_as_float(a.y & 0xffff0000u);
          v1.x *= __uint_as_float(a.z << 16); v1.y *= __uint_as_float(a.z & 0xffff0000u); v1.z *= __uint_as_float(a.w << 16); v1.w *= __uint_as_float(a.w & 0xffff0000u);
          if (n < 3) { acc[ai][bj][m][0] = v0; acc[ai][bj][m][1] = v1; }
          else *(uint4*)(opa + m * 16 * DM + bj * 128) = make_uint4(pk2(v0.x, v0.y), pk2(v0.z, v0.w), pk2(v1.x, v1.y), pk2(v1.z, v1.w));
        }
    }
  }
};
struct EpiWout {
  float* X; const float* mod_l; int tok_lo; const float* Rc; const float* Rx;
  __device__ __forceinline__ void operator()(Acc& acc, const Unit& u, int wr, int wc, int fr, int fq) const {
    const float* grow = mod_l + (size_t)tok_mod_row(tok_lo + u.pm * 256) * 6144 + 2 * 1024 + u.pn * 256 + wc * 32 + fq * 4;
    f32x4 g[2][2];
#pragma unroll
    for (int bj = 0; bj < 2; ++bj)
#pragma unroll
      for (int n = 0; n < 2; ++n) g[bj][n] = *(const f32x4*)(grow + bj * 128 + n * 16);
#pragma unroll
    for (int ai = 0; ai < 2; ++ai)
#pragma unroll
      for (int mh = 0; mh < 2; ++mh) {
        f32x4 xv[2][2][2];
#pragma unroll
        for (int m2 = 0; m2 < 2; ++m2)
#pragma unroll
          for (int bj = 0; bj < 2; ++bj)
#pragma unroll
            for (int n = 0; n < 2; ++n)
              xv[m2][bj][n] = *(const f32x4*)(((tok_lo + u.pm * 256) < NCTX ? Rc : Rx) + (size_t)(u.pm * 256 + ai * 128 + wr * 64 + (mh * 2 + m2) * 16 + fr) * DM + u.pn * 256 + bj * 128 + wc * 32 + n * 16 + fq * 4);
#pragma unroll
        for (int m2 = 0; m2 < 2; ++m2)
#pragma unroll
          for (int bj = 0; bj < 2; ++bj)
#pragma unroll
            for (int n = 0; n < 2; ++n)
              *(f32x4*)(X + (size_t)(u.pm * 256 + ai * 128 + wr * 64 + (mh * 2 + m2) * 16 + fr) * DM + u.pn * 256 + bj * 128 + wc * 32 + n * 16 + fq * 4) =
                  xv[m2][bj][n] + g[bj][n] * acc[ai][bj][mh * 2 + m2][n];
      }
  }
};
struct EpiMoe1 {
  bf16_t* hid;
  __device__ __forceinline__ void operator()(Acc& acc, const Unit& u, int wr, int wc, int fr, int fq) const {
#pragma unroll
    for (int ai = 0; ai < 2; ++ai)
#pragma unroll
      for (int m = 0; m < 4; ++m) {
        const int trow = ai * 128 + wr * 64 + m * 16 + fr;
        if (trow < u.pm) {
#pragma unroll
          for (int bj = 0; bj < 2; ++bj) {
            const f32x4 a = acc[ai][bj][m][0], b = acc[ai][bj][m][1];
            const int oc = (u.pn * 256 + bj * 128 + wc * 32) / 2 + fq * 4;
            *(uint2*)(hid + (size_t)(u.aux + trow) * 512 + oc) = make_uint2(pk2(siluf_(a.x) * b.x, siluf_(a.y) * b.y), pk2(siluf_(a.z) * b.z, siluf_(a.w) * b.w));
          }
        }
      }
  }
};
struct EpiMoe2 {
  bf16_t* ybuf; const float* rw; const int* alist; int* aslot;
  __device__ __forceinline__ void operator()(Acc& acc, const Unit& u, int wr, int wc, int fr, int fq) const {
    const int e = u.info >> 16, r0 = u.info & 0xffff;
    int as[2][4]; float ws[2][4];
#pragma unroll
    for (int ai = 0; ai < 2; ++ai)
#pragma unroll
      for (int m = 0; m < 4; ++m) { const int trow = ai * 128 + wr * 64 + m * 16 + fr; as[ai][m] = alist[e * NTOK + r0 + min(trow, u.pm - 1)]; }
#pragma unroll
    for (int ai = 0; ai < 2; ++ai)
#pragma unroll
      for (int m = 0; m < 4; ++m) ws[ai][m] = rw[as[ai][m]];
#pragma unroll
    for (int ai = 0; ai < 2; ++ai)
#pragma unroll
      for (int m = 0; m < 4; ++m) {
        const int trow = ai * 128 + wr * 64 + m * 16 + fr;
        if (trow < u.pm) {
          if (u.pn == 0 && wc == 0 && fq == 0) aslot[as[ai][m]] = u.aux + trow;
          bf16_t* yrow = ybuf + (size_t)(u.aux + trow) * DM + u.pn * 256 + wc * 32 + fq * 8;
#pragma unroll
          for (int bj = 0; bj < 2; ++bj) {
            const f32x4 v0 = acc[ai][bj][m][0] * ws[ai][m], v1 = acc[ai][bj][m][1] * ws[ai][m];
            *(uint4*)(yrow + bj * 128) = make_uint4(pk2(v0.x, v0.y), pk2(v0.z, v0.w), pk2(v1.x, v1.y), pk2(v1.z, v1.w));
          }
        }
      }
  }
};
struct S5Src {
  const bf16_t* U; const bf16_t* XS; const bf16_t* M1; const bf16_t* M2; int two, G, c;
  __device__ __forceinline__ bool next(int i, Unit& u) const {
    const int L = (two ? (i >> 1) : i) * G + c;
    if (L >= 80) return false;
    const int g = L / 5, rt = L % 5, sub = two ? (i & 1) : 0;
    u.A = (const char*)((sub ? XS : U) + ((size_t)g * 1280 + rt * 256) * 256);
    u.B = (const char*)((sub ? M2 : M1) + (size_t)g * 65536);
    u.pm = rt; u.pn = 0; u.aux = g; u.keep = two && sub == 0; u.info = sub;
    return true;
  }
  __device__ __forceinline__ void voff(const Unit&, const int (&R)[2], const int (&C)[2], unsigned (&v)[2][2]) const {
#pragma unroll
    for (int h = 0; h < 2; ++h)
#pragma unroll
      for (int i = 0; i < 2; ++i) v[h][i] = (unsigned)((h * 128 + R[i]) * 256 + C[i]) * 2u;
  }
};
struct EpiS5X {
  float* X;
  __device__ __forceinline__ void operator()(Acc& acc, const Unit& u, int wr, int wc, int fr, int fq) const {
    G8_FOREACH({ *(f32x4*)(X + ((size_t)u.aux * 1280 + u.pm * 256 + trow) * 256 + tcol) = v; })
  }
};
struct EpiS5Y {
  bf16_t* s5g;
  __device__ __forceinline__ void operator()(Acc& acc, const Unit& u, int wr, int wc, int fr, int fq) const {
    if (u.info == 0) return;
    G8_FOREACH({
      const int row = u.pm * 256 + trow;
      if (row < NTOK / 16) {
        const int tok = row * 16 + (tcol >> 4);
        *(uint2*)(s5g + (size_t)tok * 256 + u.aux * 16 + (tcol & 15)) = make_uint2(pk2(gelu_tanh(v.x), gelu_tanh(v.y)), pk2(gelu_tanh(v.z), gelu_tanh(v.w)));
      }
    })
  }
};
}

__device__ __forceinline__ void ph_gemm_s5_pass1(const Params& p, int l) {
  g8::S5Src S{p.s5u(), p.sXS(), p.s5Nn() + (size_t)l * 16 * 65536, p.s5Nn(), 0, (int)gridDim.x, (int)blockIdx.x};
  g8::EpiS5X E{p.sX()};
  g8::gemm_stream((LAS unsigned char*)smem, S, E, 256, 256);
}
__device__ __forceinline__ void ph_gemm_s5_pass2(const Params& p, int l) {
  g8::S5Src S{p.s5u(), p.sXS(), p.s5Tz() + (size_t)l * 16 * 65536, p.s5Mm() + (size_t)l * 16 * 65536, 1, (int)gridDim.x, (int)blockIdx.x};
  g8::EpiS5Y E{p.s5g()};
  g8::gemm_stream((LAS unsigned char*)smem, S, E, 256, 256);
}
__device__ __forceinline__ void ph_gemm_zmix(const Params& p, int l) {
  g8::DenseSrc S{p.hbf(), p.WinT() + (size_t)l * NIN * DM, DM, DM, NTOK / 256, NMIX / 256, (int)gridDim.x, (int)blockIdx.x};
  g8::EpiZmix E{p.zmix(), p.hyT(), p.s5u()};
  g8::gemm_stream((LAS unsigned char*)smem, S, E, DM, DM);
}
__device__ __forceinline__ void ph_gemm_gates_glu(const Params& p, int l, int tok_lo) {
  const int nM = (NTOK - tok_lo) / 256;
  {
    g8::DenseSrc S{p.hbf() + (size_t)tok_lo * DM, p.WinT() + ((size_t)l * NIN + NMIX) * DM, DM, DM, nM, 16, (int)gridDim.x, (int)blockIdx.x};
    g8::EpiGates E{p.gates(), tok_lo};
    g8::gemm_stream((LAS unsigned char*)smem, S, E, DM, DM);
  }
  {
    g8::DenseSrc S{p.s5g() + (size_t)tok_lo * 256, p.GluT() + (size_t)l * 512 * 256, 256, 256, nM, 2, (int)gridDim.x, (int)blockIdx.x};
    g8::EpiGlu E{p.br() + (size_t)tok_lo * DM};
    g8::gemm_stream((LAS unsigned char*)smem, S, E, 256, 256);
  }
}
__device__ __forceinline__ void ph_gemm_merge(const Params& p, int l, int tok_lo) {
  g8::MergeSrc S{p.br() + (size_t)tok_lo * DM, p.WbrT() + (size_t)l * 4 * DM * 256, (NTOK - tok_lo) / 256, (int)gridDim.x, (int)blockIdx.x};
  g8::EpiMerge E{p.gates(), p.merged() + (size_t)tok_lo * DM, tok_lo};
  g8::gemm_stream((LAS unsigned char*)smem, S, E, 256, 256);
}
__device__ __forceinline__ void ph_gemm_wout(const Params& p, int l, int tok_lo) {
  g8::DenseSrc S{p.merged() + (size_t)tok_lo * DM, p.WoutT() + (size_t)l * DM * DM, DM, DM, (NTOK - tok_lo) / 256, 4, (int)gridDim.x, (int)blockIdx.x};
  g8::EpiWout E{p.xbuf() + (size_t)tok_lo * DM, p.mod() + (size_t)l * 3 * 6144, tok_lo,
                l == 0 ? p.in[I_CTX] : p.xbuf() + (size_t)tok_lo * DM, l == 0 ? p.in[I_X] - (size_t)NCTX * DM : p.xbuf() + (size_t)tok_lo * DM};
  g8::gemm_stream((LAS unsigned char*)smem, S, E, DM, DM);
}
__device__ __forceinline__ void ph_gemm_moe1(const Params& p, int l) {
  g8::moe_build_table(p.cnt() + l * 32 * 32);
  g8::MoeSrc<true> S{p.alist(), p.hbf(), p.W13T(), DM, DM, (int)gridDim.x, (int)blockIdx.x, (size_t)DM * DM};
  g8::EpiMoe1 E{p.hid()};
  g8::gemm_stream((LAS unsigned char*)smem, S, E, DM, DM);
}
__device__ __forceinline__ void ph_gemm_moe2(const Params& p, int l) {
  g8::moe_build_table(p.cnt() + l * 32 * 32);
  g8::MoeSrc<false> S{p.alist(), p.hid(), p.W2T(), 512, 512, (int)gridDim.x, (int)blockIdx.x, (size_t)DM * 512};
  g8::EpiMoe2 E{p.ybuf(), p.rw(), p.alist(), p.aslot()};
  g8::gemm_stream((LAS unsigned char*)smem, S, E, 512, 512);
}

template <int l>
__device__ __forceinline__ void layer_body(const Params& p, const XcdBarrier& xb) {
    const int lo = (l == 1) ? NCTX : 0;
    ph_norm1(p, l);
    xcd_barrier(xb);
    ph_gemm_zmix(p, l);
    xcd_barrier(xb);
    for (int t = blockIdx.x; t < 256; t += gridDim.x) hyena_fft_task(p, l, t);
    if (l == 0) for (int t = blockIdx.x; t < 512; t += gridDim.x) hyena_task(p, l, CTXL, 0, t >> 8, t & 255, p.hrawc(), p.hscalec());
    __syncthreads();
    ph_mix_tasks<false>(p, l);
    __syncthreads();
    ph_gemm_s5_pass1(p, l);
    xcd_barrier(xb);
    ph_scan(p, l);
    ph_s5_scan(p, l);
    xcd_barrier(xb);
    ph_mix_tasks<true>(p, l);
    __syncthreads();
    ph_gemm_s5_pass2(p, l);
    xcd_barrier(xb);
    ph_reads(p, l, lo);
    xcd_barrier(xb);
    ph_cvt_moe(p, l);
    __syncthreads();
    ph_gemm_gates_glu(p, l, lo);
    xcd_barrier(xb);
    ph_gemm_merge(p, l, lo);
    xcd_barrier(xb);
    ph_gemm_wout(p, l, lo);
    xcd_barrier(xb);
    ph_router(p, l, lo);
    xcd_barrier(xb);
    ph_gemm_moe1(p, l);
    xcd_barrier(xb);
    ph_gemm_moe2(p, l);
    ph_gemm_moe2(p, l);
    xcd_barrier(xb);
}

__global__ void __launch_bounds__(NTHREADS) mega(Params p) {
  cg::grid_group grid = cg::this_grid();
  volatile LAS unsigned* st = (volatile LAS unsigned*)((LAS unsigned char*)smem + LDS_FFT_BYTES);
  if (threadIdx.x == 0) { st[0] = 0u; st[1] = 0u; st[2] = 0u; st[3] = 0u; }
  __syncthreads();
  const XcdBarrier xb = xcd_barrier_post(p.xbar(), st);
  ph_setup1(p);
  ph_cvt_static(p);
  ph_cvt_static(p);
  grid.sync();
  ph_setup2(p);
  __syncthreads();
  ph_setup_s5(p);
  xcd_barrier(xb);
  layer_body<0>(p, xb);
  layer_body<1>(p, xb);
  ph_final(p);
}

static inline size_t al256(size_t x) { return (x + 255) & ~(size_t)255; }

extern "C" void kernel_launch(void* const* d_in, const int* in_sizes, int n_in, void* d_out, int out_size, void* d_ws, size_t ws_size,
                              hipStream_t stream) {
  static int grid_blocks = 0;
  if (grid_blocks == 0) {
    int dev = 0, cus = 0, per_cu = 0;
    (void)hipGetDevice(&dev);
    (void)hipDeviceGetAttribute(&cus, hipDeviceAttributeMultiprocessorCount, dev);
    (void)hipFuncSetAttribute((const void*)mega, hipFuncAttributeMaxDynamicSharedMemorySize, LDS_BYTES);
    (void)hipOccupancyMaxActiveBlocksPerMultiprocessor(&per_cu, (const void*)mega, NTHREADS, LDS_BYTES);
    if (per_cu < 1) { fprintf(stderr, "kernel_launch: occupancy query says %d blocks/CU\n", per_cu); per_cu = 1; }
    if (per_cu > 1) per_cu = 1;
    grid_blocks = cus * per_cu;
  }
  Params p{};
  for (int i = 0; i < N_INPUTS; ++i) p.in[i] = (const float*)d_in[i];
  p.out = (float*)d_out;
  p.ws = (char*)d_ws;
  if (WS.total > ws_size) { fprintf(stderr, "kernel_launch: workspace too small: need %zu have %zu\n", (size_t)WS.total, ws_size); return; }
  (void)hipMemsetAsync(p.ws + WS.xbar, 0, XCD_BAR_WORDS * 4, stream);
  void* args[] = {&p};
  hipError_t e = hipLaunchCooperativeKernel((const void*)mega, dim3(grid_blocks), dim3(NTHREADS), args, LDS_BYTES, stream);
  if (e != hipSuccess) fprintf(stderr, "kernel_launch: cooperative launch failed: %s (grid %d)\n", hipGetErrorString(e), grid_blocks);
}
```

```cpp
#include <hip/hip_runtime.h>
#include <hip/hip_cooperative_groups.h>
#include <stdint.h>
#include <stdio.h>
namespace cg = cooperative_groups;

typedef unsigned short bf16_t;
typedef short bf16x8 __attribute__((ext_vector_type(8)));
typedef float f32x4 __attribute__((ext_vector_type(4)));
typedef float f32x16 __attribute__((ext_vector_type(16)));

#define DM 1024
#define NTOK 16896
#define NCTX 512
#define NLAT 16384
#define SEQL 8192
#define CTXL 256
#define NIN 7168
#define NMIX 3072
#define NSTEP 8448
#define EPSF 1e-6f
#define NCHUNK 132
#define FFT_N 16384
#define NTHREADS 512
#define NWAVES 8
#define LDS_FFT_BYTES 139264
#define LDS_BYTES (LDS_FFT_BYTES + 16)

#define C_HGQ 0
#define C_HGF 256
#define C_HGI 768
#define C_HGG 1024
#define C_HY 1280
#define C_RQ 2048
#define C_RK 2176
#define C_RV 2304
#define C_RG 2560
#define C_S5 2816

enum { I_X = 0, I_C, I_CTX, I_CCTX, I_WMOD, I_BMOD, I_NORM1, I_NORM2, I_WIN, I_HGLB, I_HGNORM, I_HYCW, I_HYCB, I_HYW1, I_HYB1, I_HYF1,
       I_HYW2, I_HYB2, I_HYF2, I_HYW3, I_HYSKIP, I_RETDEC, I_RETNORM, I_S5LRE, I_S5LIM, I_S5LDT, I_S5BRE, I_S5BIM, I_S5CRE, I_S5CIM,
       I_S5D, I_GLU1, I_GLU2, I_WBR, I_WOUT, I_WGRP, I_BGRP, I_WEXP, I_BEXP, I_MW1, I_MW3, I_MW2, I_NORMF, N_INPUTS };

constexpr size_t al256c(size_t x) { return (x + 255) & ~(size_t)255; }
struct WsLayout { size_t aslot, xbuf, hbf, zmix, rope, hgo, rto, s5o, br, s5g, mod, modpart, lb, s5a, s5b, hraw, hrawc, hscale, hscalec, twid, hgU, hgD, rtU, s5u, sX, sXS, s5Tz, s5Nn, s5Mm, WinT, WbrT, WoutT, GluT, xbar, cnt, alist, rw, rsel, total; };
constexpr WsLayout make_ws_layout() {
  WsLayout L{}; size_t off = 0;
  L.aslot = off; off = al256c(off + (size_t)NTOK * 2 * 4);
  L.xbuf = off; off = al256c(off + (size_t)NTOK * DM * 4);
  L.hbf = off; off = al256c(off + (size_t)NTOK * DM * 2);
  L.zmix = off; off = al256c(off + (size_t)NTOK * 4096 * 2);
  L.rope = off; off = al256c(off + 128 * 8 * 2 * 4);
  L.hgo = off; off = al256c(off + (size_t)2 * NTOK * 256 * 4);
  L.rto = off; off = al256c(off + (size_t)2 * NTOK * 256 * 4);
  L.s5o = off; off = al256c(off + (size_t)2 * NTOK * 256 * 4);
  L.br = off; off = al256c(off + (size_t)NTOK * DM * 2);
  L.s5g = off; off = al256c(off + (size_t)NTOK * 256 * 2);
  L.mod = off; off = al256c(off + (size_t)2 * 3 * 6144 * 4);
  L.modpart = off; off = al256c(off + (size_t)8 * 2 * 3 * 6144 * 4);
  L.lb = off; off = al256c(off + 1024 * 4);
  L.s5a = off; off = al256c(off + 4096 * 2 * 4);
  L.s5b = off; off = al256c(off + 4096 * 16 * 2 * 4);
  L.hraw = off; off = al256c(off + (size_t)2 * 2 * 256 * SEQL * 4);
  L.hrawc = off; off = al256c(off + (size_t)2 * 256 * CTXL * 4);
  L.hscale = off; off = al256c(off + 512 * 4);
  L.hscalec = off; off = al256c(off + 256 * 4);
  L.twid = off; off = al256c(off + (size_t)FFT_N * 2 * 4);
  L.hgU = off; off = al256c(off + (size_t)16 * NCHUNK * 4096 * 4);
  L.hgD = off; off = al256c(off + (size_t)16 * NCHUNK * 64 * 4);
  L.rtU = off; off = al256c(off + (size_t)16 * NCHUNK * 2048 * 4);
  L.s5u = off; off = al256c(off + (size_t)16 * 1280 * 256 * 2);
  L.sX = off; off = al256c(off + (size_t)16 * 1280 * 256 * 4);
  L.sXS = off; off = al256c(off + (size_t)16 * 1280 * 256 * 2);
  L.s5Tz = off; off = al256c(off + (size_t)32 * 65536 * 2);
  L.s5Nn = off; off = al256c(off + (size_t)32 * 65536 * 2);
  L.s5Mm = off; off = al256c(off + (size_t)32 * 65536 * 2);
  L.WinT = off; off = al256c(off + (size_t)2 * NIN * DM * 2);
  L.WbrT = off; off = al256c(off + (size_t)2 * 4 * DM * 256 * 2);
  L.WoutT = off; off = al256c(off + (size_t)2 * DM * DM * 2);
  L.GluT = off; off = al256c(off + (size_t)2 * 512 * 256 * 2);
  L.xbar = off; off = al256c(off + 3456 * 4);
  L.cnt = off; off = al256c(off + 64 * 32 * 4);
  L.alist = off; off = al256c(off + (size_t)32 * NTOK * 4);
  L.rw = off; off = al256c(off + (size_t)NTOK * 2 * 4);
  L.rsel = off; off = al256c(off + (size_t)NTOK * 4 * 4);
  L.total = off; return L;
}
constexpr WsLayout WS = make_ws_layout();
struct Params {
  const float* in[N_INPUTS];
  float* out;
  char* ws;
  __device__ __forceinline__ int* aslot() const { return (int*)(ws + WS.aslot); }
  __device__ __forceinline__ float* xbuf() const { return (float*)(ws + WS.xbuf); }
  __device__ __forceinline__ bf16_t* hbf() const { return (bf16_t*)(ws + WS.hbf); }
  __device__ __forceinline__ bf16_t* zmix() const { return (bf16_t*)(ws + WS.zmix); }
  __device__ __forceinline__ float* rope() const { return (float*)(ws + WS.rope); }
  __device__ __forceinline__ float* hgo() const { return (float*)(ws + WS.hgo); }
  __device__ __forceinline__ float* rto() const { return (float*)(ws + WS.rto); }
  __device__ __forceinline__ float* s5o() const { return (float*)(ws + WS.s5o); }
  __device__ __forceinline__ bf16_t* br() const { return (bf16_t*)(ws + WS.br); }
  __device__ __forceinline__ bf16_t* s5g() const { return (bf16_t*)(ws + WS.s5g); }
  __device__ __forceinline__ float* mod() const { return (float*)(ws + WS.mod); }
  __device__ __forceinline__ float* modpart() const { return (float*)(ws + WS.modpart); }
  __device__ __forceinline__ float* lb() const { return (float*)(ws + WS.lb); }
  __device__ __forceinline__ float* s5a() const { return (float*)(ws + WS.s5a); }
  __device__ __forceinline__ float* s5b() const { return (float*)(ws + WS.s5b); }
  __device__ __forceinline__ float* hraw() const { return (float*)(ws + WS.hraw); }
  __device__ __forceinline__ float* hrawc() const { return (float*)(ws + WS.hrawc); }
  __device__ __forceinline__ float* hscale() const { return (float*)(ws + WS.hscale); }
  __device__ __forceinline__ float* hscalec() const { return (float*)(ws + WS.hscalec); }
  __device__ __forceinline__ float* twid() const { return (float*)(ws + WS.twid); }
  __device__ __forceinline__ float* hgU() const { return (float*)(ws + WS.hgU); }
  __device__ __forceinline__ float* hgD() const { return (float*)(ws + WS.hgD); }
  __device__ __forceinline__ float* rtU() const { return (float*)(ws + WS.rtU); }
  __device__ __forceinline__ bf16_t* s5u() const { return (bf16_t*)(ws + WS.s5u); }
  __device__ __forceinline__ float* sX() const { return (float*)(ws + WS.sX); }
  __device__ __forceinline__ bf16_t* sXS() const { return (bf16_t*)(ws + WS.sXS); }
  __device__ __forceinline__ bf16_t* s5Tz() const { return (bf16_t*)(ws + WS.s5Tz); }
  __device__ __forceinline__ bf16_t* s5Nn() const { return (bf16_t*)(ws + WS.s5Nn); }
  __device__ __forceinline__ bf16_t* s5Mm() const { return (bf16_t*)(ws + WS.s5Mm); }
  __device__ __forceinline__ bf16_t* WinT() const { return (bf16_t*)(ws + WS.WinT); }
  __device__ __forceinline__ bf16_t* WbrT() const { return (bf16_t*)(ws + WS.WbrT); }
  __device__ __forceinline__ bf16_t* WoutT() const { return (bf16_t*)(ws + WS.WoutT); }
  __device__ __forceinline__ bf16_t* GluT() const { return (bf16_t*)(ws + WS.GluT); }
  __device__ __forceinline__ unsigned* xbar() const { return (unsigned*)(ws + WS.xbar); }
  __device__ __forceinline__ int* cnt() const { return (int*)(ws + WS.cnt); }
  __device__ __forceinline__ int* alist() const { return (int*)(ws + WS.alist); }
  __device__ __forceinline__ float* rw() const { return (float*)(ws + WS.rw); }
  __device__ __forceinline__ float* rsel() const { return (float*)(ws + WS.rsel); }
  __device__ __forceinline__ bf16_t* merged() const { return (bf16_t*)(ws + WS.hbf + 0); }
  __device__ __forceinline__ float* hyT() const { return (float*)(ws + WS.hgo + 0); }
  __device__ __forceinline__ float* hspec() const { return (float*)(ws + WS.s5o + 0); }
  __device__ __forceinline__ bf16_t* W13T() const { return (bf16_t*)(ws + WS.hgo + 0); }
  __device__ __forceinline__ bf16_t* W2T() const { return (bf16_t*)(ws + WS.hgo + (size_t)32 * DM * DM * 2); }
  __device__ __forceinline__ bf16_t* gates() const { return (bf16_t*)(ws + WS.zmix + 0); }
  __device__ __forceinline__ bf16_t* hid() const { return (bf16_t*)(ws + WS.zmix + 0); }
  __device__ __forceinline__ bf16_t* ybuf() const { return (bf16_t*)(ws + WS.zmix + al256c((size_t)NTOK * 2 * 512 * 2)); }
};

extern __shared__ __attribute__((aligned(16))) unsigned char smem[];

typedef float f32x2 __attribute__((ext_vector_type(2)));
typedef __bf16 bf16x2_t __attribute__((ext_vector_type(2)));
__device__ __forceinline__ unsigned pk2(float a, float b) { const f32x2 v = {a, b}; return __builtin_bit_cast(unsigned, __builtin_convertvector(v, bf16x2_t)); }
__device__ __forceinline__ bf16_t f2bf(float f) { return (bf16_t)(pk2(f, 0.f) & 0xffffu); }
__device__ __forceinline__ float bflo(unsigned u) { return __uint_as_float(u << 16); }
__device__ __forceinline__ float bfhi(unsigned u) { return __uint_as_float(u & 0xffff0000u); }
__device__ __forceinline__ float bf2f(bf16_t b) { return __uint_as_float(((unsigned)b) << 16); }
__device__ __forceinline__ float sigmoidf_(float x) { return 1.0f / (1.0f + expf(-x)); }
__device__ __forceinline__ float siluf_(float x) { return x / (1.0f + expf(-x)); }
__device__ __forceinline__ float gelu_tanh(float x) {
  float u = 0.7978845608028654f * (x + 0.044715f * x * x * x);
  return 0.5f * x * (1.0f + tanhf(u));
}
__device__ __forceinline__ float wave_sum(float v) {
#pragma unroll
  for (int o = 1; o < 64; o <<= 1) v += __shfl_xor(v, o);
  return v;
}
__device__ __forceinline__ int tok_mod_row(int tok) { return tok < NCTX ? 2 : ((tok - NCTX) >> 13); }
__device__ __forceinline__ int scan_tok(int s, int dir, int b) {
  if (s < CTXL) return b * CTXL + (dir ? (CTXL - 1 - s) : s);
  int u = s - CTXL;
  return NCTX + b * SEQL + (dir ? (SEQL - 1 - u) : u);
}
__device__ __forceinline__ int otid() { int t = threadIdx.x; asm volatile("" : "+v"(t)); return t; }
#define LDS_FENCE() asm volatile("s_waitcnt lgkmcnt(0)" ::: "memory")


#define XB_TMO      128
#define XB_XCNT(j)  (256  + 64 * (j))
#define XB_XSUB(j)  (1280 + 64 * (j))
#define XB_XGEN(j)  (2304 + 64 * (j))
#define XB_TOP      3328
#define XB_TOPGEN   3392
#define XCD_BAR_WORDS 3456
#define XB_SPIN_CAP (1u << 20)
#define LAS __attribute__((address_space(3)))
__device__ __forceinline__ unsigned xb_ld(unsigned* p)              { return __hip_atomic_load(p, __ATOMIC_RELAXED, __HIP_MEMORY_SCOPE_AGENT); }
__device__ __forceinline__ unsigned xb_add(unsigned* p, unsigned v) { return __hip_atomic_fetch_add(p, v, __ATOMIC_RELAXED, __HIP_MEMORY_SCOPE_AGENT); }
__device__ __forceinline__ unsigned xb_xcc_id() { return (unsigned)__builtin_amdgcn_s_getreg((3 << 11) | 20) & 0xFu; }
#define XB_SPIN(cond, bar) do { unsigned _sp = 0; while (cond) { __builtin_amdgcn_s_sleep(1); \
    if ((++_sp & 255u) == 0u) { if (xb_ld(&(bar)[XB_TMO])) break; if (_sp > XB_SPIN_CAP) { atomicAdd(&(bar)[XB_TMO], 1u); break; } } } } while (0)
struct XcdBarrier { unsigned* bar; unsigned x; volatile LAS unsigned* st; };
__device__ __forceinline__ XcdBarrier xcd_barrier_post(unsigned* bar, volatile LAS unsigned* st) {
  XcdBarrier b; b.bar = bar; b.x = xb_xcc_id(); b.st = st;
  if (threadIdx.x == 0) (void)xb_add(&bar[XB_XCNT(b.x)], 1u);
  return b;
}
__device__ __forceinline__ void xcd_barrier_complete(unsigned* bar, unsigned x, unsigned& nloc, unsigned& nx) {
  const unsigned G = gridDim.x * gridDim.y * gridDim.z;
  unsigned sum, cnt, mine, sp = 0u;
  for (;;) {
    sum = 0u; cnt = 0u; mine = 0u;
#pragma unroll
    for (unsigned j = 0; j < 16; ++j) { const unsigned c = xb_ld(&bar[XB_XCNT(j)]); sum += c; cnt += (c > 0u) ? 1u : 0u; mine = (j == x) ? c : mine; }
    if (sum == G) break;
    __builtin_amdgcn_s_sleep(1);
    if ((++sp & 255u) == 0u) { if (xb_ld(&bar[XB_TMO])) break; if (sp > XB_SPIN_CAP) { atomicAdd(&bar[XB_TMO], 1u); break; } }
  }
  nloc = mine > 0u ? mine : 1u; nx = cnt > 0u ? cnt : 1u;
}
__device__ __forceinline__ void xcd_barrier(const XcdBarrier& b) {
  asm volatile("s_waitcnt vmcnt(0)" ::: "memory");
  __syncthreads();
  if (threadIdx.x == 0) {
    unsigned* bar = b.bar;
    __builtin_amdgcn_s_waitcnt(0);
    unsigned nloc = b.st[0], nx = b.st[1];
    if (nloc == 0u) { xcd_barrier_complete(bar, b.x, nloc, nx); b.st[0] = nloc; b.st[1] = nx; }
    const unsigned old = xb_add(&bar[XB_XSUB(b.x)], 1u);
    const unsigned gen = old / nloc;
    if (old + 1u == (gen + 1u) * nloc) {
      __builtin_amdgcn_fence(__ATOMIC_RELEASE, "agent");
      asm volatile("s_waitcnt vmcnt(0)" ::: "memory");
      const unsigned og = xb_add(&bar[XB_TOP], 1u);
      const unsigned tg = og / nx;
      if (og + 1u == (tg + 1u) * nx) xb_add(&bar[XB_TOPGEN], 1u);
      else XB_SPIN(xb_ld(&bar[XB_TOPGEN]) == tg, bar);
      __builtin_amdgcn_fence(__ATOMIC_ACQUIRE, "agent");
      xb_add(&bar[XB_XGEN(b.x)], 1u);
      asm volatile("s_waitcnt vmcnt(0)" ::: "memory");
    } else {
      XB_SPIN(xb_ld(&bar[XB_XGEN(b.x)]) == gen, bar);
      __builtin_amdgcn_fence(__ATOMIC_ACQUIRE, "agent");
      asm volatile("s_waitcnt vmcnt(0)" ::: "memory");
    }
  }
  __syncthreads();
}

__device__ __forceinline__ void ph_setup1(const Params& p) {
  const int TID = otid();
  const int tid = TID, lane = tid & 63, wave = tid >> 6;
  const int gtid = blockIdx.x * NTHREADS + tid;
  const int gw = blockIdx.x * NWAVES + wave, nw = gridDim.x * NWAVES;
  float* sc = (float*)smem;
  for (int i = tid; i < 3072; i += NTHREADS) {
    int r = i >> 10, k = i & 1023;
    float v = r < 2 ? p.in[I_C][r * 1024 + k] : p.in[I_CCTX][k];
    sc[i] = siluf_(v);
  }
  __syncthreads();
  if (gtid < 64) p.cnt()[gtid * 32] = 0;
  if (gtid < 1024) { const int pos = gtid >> 3, j = gtid & 7; double sn, cs; sincos((double)pos * pow(10000.0, -(double)j / 8.0), &sn, &cs); p.rope()[gtid * 2] = (float)cs; p.rope()[gtid * 2 + 1] = (float)sn; }
  if (gtid < FFT_N) { double sn, cs; sincos(-2.0 * 3.14159265358979323846 * (double)gtid / (double)FFT_N, &sn, &cs); p.twid()[gtid * 2] = (float)cs; p.twid()[gtid * 2 + 1] = (float)sn; }
  if (gtid < 1024) {
    int l = gtid >> 9, dc = gtid & 511;
    float v = 0.f;
    if (l == 1) { float l0 = p.in[I_HGLB][dc], l1 = p.in[I_HGLB][512 + dc]; v = 1.0f / (1.0f + expf(l0 - l1)); }
    p.lb()[gtid] = v;
  }
  if (gtid < 4096) {
    double lr = fmin((double)p.in[I_S5LRE][gtid], -1e-4), li = (double)p.in[I_S5LIM][gtid];
    double dt = exp((double)p.in[I_S5LDT][gtid >> 6]);
    double mag = exp(lr * dt), sn, cs;
    sincos(li * dt, &sn, &cs);
    double are = mag * cs, aim = mag * sn;
    double den = lr * lr + li * li;
    double cr = ((are - 1.0) * lr + aim * li) / den, ci = (aim * lr - (are - 1.0) * li) / den;
    p.s5a()[gtid * 2] = (float)are; p.s5a()[gtid * 2 + 1] = (float)aim;
    for (int c = 0; c < 16; ++c) {
      double br = p.in[I_S5BRE][gtid * 16 + c], bi = p.in[I_S5BIM][gtid * 16 + c];
      p.s5b()[(gtid * 16 + c) * 2] = (float)(cr * br - ci * bi);
      p.s5b()[(gtid * 16 + c) * 2 + 1] = (float)(cr * bi + ci * br);
    }
  }
  for (int t = gw; t < 2 * 96 * 8; t += nw) {
    const int kp = t & 7, cgp = (t >> 3) % 96, l = t / (8 * 96);
    const int col = cgp * 64 + lane;
    const float* w = p.in[I_WMOD] + ((size_t)l * 1024 + kp * 128) * 6144 + col;
    float a0 = 0.f, a1 = 0.f, a2 = 0.f;
#pragma unroll 8
    for (int k = 0; k < 128; ++k) {
      float wv = w[(size_t)k * 6144];
      a0 += sc[kp * 128 + k] * wv; a1 += sc[1024 + kp * 128 + k] * wv; a2 += sc[2048 + kp * 128 + k] * wv;
    }
    float* o = p.modpart() + ((size_t)(kp * 2 + l) * 3) * 6144 + col;
    o[0] = a0; o[6144] = a1; o[2 * 6144] = a2;
  }
  float* w3l = (float*)smem;
  for (int lyr = 0; lyr < 2; ++lyr) {
    __syncthreads();
    { const f32x4* src = (const f32x4*)(p.in[I_HYW3] + (size_t)lyr * 64 * 512);
      for (int i = tid; i < 64 * 512 / 4; i += NTHREADS) ((f32x4*)w3l)[i] = src[i]; }
    __syncthreads();
    const int ngroups = lyr == 0 ? (SEQL + CTXL) / 8 : SEQL / 8;
    for (int g2 = gw; g2 < ngroups * 2; g2 += nw) {
      const int g = g2 >> 1, mh = g2 & 1;
      const bool isctx = g >= SEQL / 8;
      const int L = isctx ? CTXL : SEQL, i0 = (isctx ? g - SEQL / 8 : g) * 8;
      float* outp = isctx ? p.hrawc() : p.hraw() + (size_t)lyr * 2 * 256 * SEQL;
      float z[8], tt[8];
#pragma unroll
      for (int q = 0; q < 8; ++q) {
        const int i = i0 + q;
        tt[q] = (float)i / (float)(L - 1);
        const float w = (6.283185307179586f / (float)L) * (float)i;
        z[q] = 0.f;
        if (lane == 0) z[q] = tt[q];
        else if (lane < 33) {
          const int j = (lane - 1) & 15;
          const float f = 1e-4f + (float)j * ((15.0f - 1e-4f) / 15.0f);
          z[q] = lane < 17 ? cosf(f * w) : -sinf(f * w);
        }
      }
      const float* w1 = p.in[I_HYW1] + lyr * 33 * 64;
      float a[8];
      { const float b1 = p.in[I_HYB1][lyr * 64 + lane];
#pragma unroll
        for (int q = 0; q < 8; ++q) a[q] = b1; }
      for (int k = 0; k < 33; ++k) {
        const float wv = w1[k * 64 + lane];
#pragma unroll
        for (int q = 0; q < 8; ++q) a[q] += __shfl(z[q], k) * wv;
      }
      float h1[8];
      { const float f1 = p.in[I_HYF1][lyr * 64 + lane];
#pragma unroll
        for (int q = 0; q < 8; ++q) h1[q] = sinf(f1 * a[q]); }
      const float* w2 = p.in[I_HYW2] + lyr * 64 * 64;
      { const float b2 = p.in[I_HYB2][lyr * 64 + lane];
#pragma unroll
        for (int q = 0; q < 8; ++q) a[q] = b2; }
      for (int k = 0; k < 64; ++k) {
        const float wv = w2[k * 64 + lane];
#pragma unroll
        for (int q = 0; q < 8; ++q) a[q] += __shfl(h1[q], k) * wv;
      }
      float h2[8];
      { const float f2 = p.in[I_HYF2][lyr * 64 + lane];
#pragma unroll
        for (int q = 0; q < 8; ++q) h2[q] = sinf(f2 * a[q]); }
      const float lo = -4.605170185988091f / 1.5f, hi = -4.605170185988091f / 0.3f;
      float o[4][8];
#pragma unroll
      for (int m = 0; m < 4; ++m)
#pragma unroll
        for (int q = 0; q < 8; ++q) o[m][q] = 0.f;
      for (int k = 0; k < 64; ++k) {
        float hv[8];
#pragma unroll
        for (int q = 0; q < 8; ++q) hv[q] = __shfl(h2[q], k);
#pragma unroll
        for (int m = 0; m < 4; ++m) {
          const float wv = w3l[k * 512 + (mh * 4 + m) * 64 + lane];
#pragma unroll
          for (int q = 0; q < 8; ++q) o[m][q] += hv[q] * wv;
        }
      }
#pragma unroll
      for (int m = 0; m < 4; ++m) {
        const int c = (mh * 4 + m) * 64 + lane, cc = c & 255;
        const float delta = fabsf(lo + (float)cc * ((hi - lo) / 255.0f));
#pragma unroll
        for (int q = 0; q < 8; ++q) o[m][q] *= expf(-tt[q] * delta);
        float* dst = outp + ((size_t)(c >> 8) * 256 + cc) * L + i0;
        *(f32x4*)dst = (f32x4){o[m][0], o[m][1], o[m][2], o[m][3]};
        *(f32x4*)(dst + 4) = (f32x4){o[m][4], o[m][5], o[m][6], o[m][7]};
      }
    }
  }
  __syncthreads();
}

__device__ __forceinline__ void ph_setup2(const Params& p) {
  const int TID = otid();
  const int tid = TID;
  const int gtid = blockIdx.x * NTHREADS + tid, nthr = gridDim.x * NTHREADS;
  for (int i = gtid; i < 2 * 3 * 6144; i += nthr) {
    const int l = i / (3 * 6144), j = i % 6144;
    float a = p.in[I_BMOD][l * 6144 + j];
#pragma unroll
    for (int kp = 0; kp < 8; ++kp) a += p.modpart()[(size_t)kp * (2 * 3 * 6144) + i];
    p.mod()[i] = a;
  }
  float* red = (float*)smem;
  for (int t = blockIdx.x; t < 768; t += gridDim.x) {
    const int set = t >> 8, c = t & 255;
    const int L = set < 2 ? SEQL : CTXL;
    const float* raw = set < 2 ? p.hraw() + (size_t)set * 2 * 256 * SEQL : p.hrawc();
    float s = 0.f;
    for (int i = tid; i < L; i += NTHREADS) {
      float a = raw[(size_t)c * L + i]; s += a * a;
      if (i >= 1) { float b = raw[((size_t)256 + c) * L + i]; s += b * b; }
    }
    s = wave_sum(s);
    __syncthreads();
    if ((tid & 63) == 0) red[tid >> 6] = s;
    __syncthreads();
    if (tid == 0) {
      float tot = 0.f;
      for (int w = 0; w < NWAVES; ++w) tot += red[w];
      float sc = 1.0f / sqrtf(tot + EPSF);
      if (set < 2) p.hscale()[set * 256 + c] = sc; else p.hscalec()[c] = sc;
    }
  }
}


__device__ __forceinline__ void ph_setup_s5(const Params& p) {
  const int tid = otid();
  float* apw = (float*)smem;
  float* Kc = apw + 4352;
  float* Bl = Kc + 8192;
  float* Cl = Bl + 4096;
  for (int item = blockIdx.x; item < 256; item += gridDim.x) {
    const int lg = item >> 3, part = item & 7;
    const int l = lg >> 4, g = lg & 15;
    __syncthreads();
    for (int e = tid; e < 2 * 64 * 17; e += NTHREADS) {
      const int dir = e / (64 * 17), rem = e % (64 * 17), pp = rem / 17, m = rem % 17;
      const int sidx = ((l * 2 + dir) * 16 + g) * 64 + pp;
      const double lr = fmin((double)p.in[I_S5LRE][sidx], -1e-4), li = (double)p.in[I_S5LIM][sidx], dt = exp((double)p.in[I_S5LDT][sidx >> 6]);
      const double mag = exp((double)m * lr * dt); double sn, cs;
      sincos((double)m * li * dt, &sn, &cs);
      apw[e * 2] = (float)(mag * cs); apw[e * 2 + 1] = (float)(mag * sn);
    }
    for (int e = tid; e < 4096; e += NTHREADS) {
      const int dir = e >> 11, r = e & 2047;
      Bl[e] = p.s5b()[(size_t)(((l * 2 + dir) * 16 + g) * 64) * 32 + r];
      const int c = (r >> 7), pp = (r >> 1) & 63, ri = r & 1;
      Cl[e] = (ri ? p.in[I_S5CIM] : p.in[I_S5CRE])[(((l * 2 + dir) * 16 + g) * 16 + c) * 64 + pp];
    }
    __syncthreads();
    for (int e = tid; e < 8192; e += NTHREADS) {
      const int dir = e >> 12, lag = (e >> 8) & 15, c = (e >> 4) & 15, cp = e & 15;
      float acc = 0.f;
      for (int pp = 0; pp < 64; ++pp) {
        const float ar = apw[((dir * 64 + pp) * 17 + lag) * 2], ai = apw[((dir * 64 + pp) * 17 + lag) * 2 + 1];
        const float br = Bl[((dir * 64 + pp) * 16 + cp) * 2], bi = Bl[((dir * 64 + pp) * 16 + cp) * 2 + 1];
        const float cre = Cl[((dir * 16 + c) * 64 + pp) * 2], cim = Cl[((dir * 16 + c) * 64 + pp) * 2 + 1];
        acc += cre * (ar * br - ai * bi) - cim * (ar * bi + ai * br);
      }
      Kc[e] = acc;
    }
    __syncthreads();
    bf16_t* Tz = p.s5Tz() + (size_t)lg * 65536;
    bf16_t* Nn = p.s5Nn() + (size_t)lg * 65536;
    bf16_t* Mm = p.s5Mm() + (size_t)lg * 65536;
    for (int e = part * 8192 + tid; e < (part + 1) * 8192; e += NTHREADS) {
      const int n = e >> 8, k = e & 255;
      {
        const int t = n >> 4, c = n & 15, tp = k >> 4, cp = k & 15;
        float v = 0.f;
        if (t >= tp) v += Kc[((0 * 16 + (t - tp)) * 16 + c) * 16 + cp];
        if (tp >= t) v += Kc[((1 * 16 + (tp - t)) * 16 + c) * 16 + cp];
        if (t == tp && c == cp) v += p.in[I_S5D][l * 256 + g * 16 + c];
        Tz[e] = f2bf(v);
      }
      {
        const int dir = n >> 7, pp = (n >> 1) & 63, ri = n & 1, tp = k >> 4, cp = k & 15;
        const int m = dir ? tp : 15 - tp;
        const float ar = apw[((dir * 64 + pp) * 17 + m) * 2], ai = apw[((dir * 64 + pp) * 17 + m) * 2 + 1];
        const float br = Bl[((dir * 64 + pp) * 16 + cp) * 2], bi = Bl[((dir * 64 + pp) * 16 + cp) * 2 + 1];
        Nn[e] = f2bf(ri ? (ar * bi + ai * br) : (ar * br - ai * bi));
      }
      {
        const int t = n >> 4, c = n & 15, dir = k >> 7, pp = (k >> 1) & 63, ri = k & 1;
        const int m = dir ? 16 - t : t + 1;
        const float ar = apw[((dir * 64 + pp) * 17 + m) * 2], ai = apw[((dir * 64 + pp) * 17 + m) * 2 + 1];
        const float cre = Cl[((dir * 16 + c) * 64 + pp) * 2], cim = Cl[((dir * 16 + c) * 64 + pp) * 2 + 1];
        Mm[e] = f2bf(ri ? -(cre * ai + cim * ar) : (cre * ar - cim * ai));
      }
    }
  }
}

__device__ __forceinline__ void ph_norm1(const Params& p, int l) {
  const int TID = otid();
  const int lane = TID & 63, wave = TID >> 6;
  for (int tok = blockIdx.x * NWAVES + wave; tok < NTOK; tok += gridDim.x * NWAVES) {
    const int r = tok_mod_row(tok);
    f32x4* xr = (f32x4*)(p.xbuf() + (size_t)tok * DM);
    const f32x4* src = l == 0 ? (tok < NCTX ? (const f32x4*)(p.in[I_CTX] + (size_t)tok * DM) : (const f32x4*)(p.in[I_X] + (size_t)(tok - NCTX) * DM))
                              : (const f32x4*)xr;
    f32x4 v[4];
    float ss = 0.f;
#pragma unroll
    for (int j = 0; j < 4; ++j) {
      v[j] = src[lane + 64 * j];
      if (l == 1) {
        const int c = (lane + 64 * j) * 4;
        f32x4 g = *(const f32x4*)(p.mod() + (size_t)(0 * 3 + r) * 6144 + 5 * 1024 + c);
        const uint2 y0b = *(const uint2*)(p.ybuf() + (size_t)p.aslot()[tok * 2] * DM + c), y1b = *(const uint2*)(p.ybuf() + (size_t)p.aslot()[tok * 2 + 1] * DM + c);
        const f32x4 y0 = {bflo(y0b.x), bfhi(y0b.x), bflo(y0b.y), bfhi(y0b.y)}, y1 = {bflo(y1b.x), bfhi(y1b.x), bflo(y1b.y), bfhi(y1b.y)};
        v[j] = v[j] + g * (y0 + y1);
      }
      if (l == 1) xr[lane + 64 * j] = v[j];
      ss += v[j].x * v[j].x + v[j].y * v[j].y + v[j].z * v[j].z + v[j].w * v[j].w;
    }
    ss = wave_sum(ss);
    const float rs = 1.0f / sqrtf(ss * (1.0f / DM) + EPSF);
    const float* gain = p.in[I_NORM1] + l * DM;
    const float* mrow = p.mod() + (size_t)(l * 3 + r) * 6144;
    uint2* ho = (uint2*)(p.hbf() + (size_t)tok * DM);
#pragma unroll
    for (int j = 0; j < 4; ++j) {
      const int c = (lane + 64 * j) * 4;
      f32x4 g = *(const f32x4*)(gain + c), sh = *(const f32x4*)(mrow + c), sc = *(const f32x4*)(mrow + 1024 + c);
      f32x4 h = v[j] * rs * g * (1.0f + sc) + sh;
      ho[lane + 64 * j] = make_uint2(pk2(h.x, h.y), pk2(h.z, h.w));
    }
  }
}

__device__ __forceinline__ void ph_reads(const Params& p, int l, int tok_lo) {
  const int TID = otid();
  const int lane = TID & 63, wave = TID >> 6;
  const int c = lane * 4;
  {
    bf16_t* tile = (bf16_t*)smem;
    for (int tt = blockIdx.x; tt < NLAT / 64; tt += gridDim.x) {
      __syncthreads();
      for (int i = TID; i < 256 * 8; i += NTHREADS) {
        const int ch = i >> 3, t8 = (i & 7) * 8;
        const uint4 v = *(const uint4*)((const bf16_t*)(p.hspec() + (size_t)ch * FFT_N * 2) + tt * 64 + t8);
        unsigned* d = (unsigned*)(tile + ch * 66 + t8);
        d[0] = v.x; d[1] = v.y; d[2] = v.z; d[3] = v.w;
      }
      __syncthreads();
#pragma unroll
      for (int k = 0; k < 8; ++k) {
        const int tk = wave * 8 + k;
        const unsigned lo = (unsigned)tile[(c + 0) * 66 + tk] | ((unsigned)tile[(c + 1) * 66 + tk] << 16);
        const unsigned hi = (unsigned)tile[(c + 2) * 66 + tk] | ((unsigned)tile[(c + 3) * 66 + tk] << 16);
        *(uint2*)(p.br() + (size_t)(NCTX + tt * 64 + tk) * DM + 256 + c) = make_uint2(lo, hi);
      }
    }
    __syncthreads();
  }
  for (int tok = tok_lo + blockIdx.x * NWAVES + wave; tok < NTOK; tok += gridDim.x * NWAVES) {
    const bf16_t* z = p.zmix() + (size_t)tok * NMIX;
    {
      f32x4 o = *(const f32x4*)(p.hgo() + (size_t)tok * 256 + c) + *(const f32x4*)(p.hgo() + ((size_t)NTOK + tok) * 256 + c);
      float ss = o.x * o.x + o.y * o.y + o.z * o.z + o.w * o.w;
#pragma unroll
      for (int m = 1; m < 16; m <<= 1) ss += __shfl_xor(ss, m);
      float rs = 1.0f / sqrtf(ss * (1.0f / 64.0f) + EPSF);
      f32x4 g = *(const f32x4*)(p.in[I_HGNORM] + l * 256 + c);
      const uint2 gtb = *(const uint2*)(z + C_HGG + c);
      const f32x4 gt = {bflo(gtb.x), bfhi(gtb.x), bflo(gtb.y), bfhi(gtb.y)};
      uint2 w = make_uint2(pk2(o.x * rs * g.x * siluf_(gt.x), o.y * rs * g.y * siluf_(gt.y)), pk2(o.z * rs * g.z * siluf_(gt.z), o.w * rs * g.w * siluf_(gt.w)));
      *(uint2*)(p.br() + (size_t)tok * DM + c) = w;
    }
    {
      f32x4 o = *(const f32x4*)(p.rto() + (size_t)tok * 256 + c) + *(const f32x4*)(p.rto() + ((size_t)NTOK + tok) * 256 + c);
      float sm_ = o.x + o.y + o.z + o.w;
#pragma unroll
      for (int m = 1; m < 16; m <<= 1) sm_ += __shfl_xor(sm_, m);
      float mean = sm_ * (1.0f / 64.0f);
      o = o - mean;
      float ss = o.x * o.x + o.y * o.y + o.z * o.z + o.w * o.w;
#pragma unroll
      for (int m = 1; m < 16; m <<= 1) ss += __shfl_xor(ss, m);
      float rs = 1.0f / sqrtf(ss * (1.0f / 64.0f) + EPSF);
      f32x4 g = *(const f32x4*)(p.in[I_RETNORM] + l * 256 + c);
      const uint2 gtb = *(const uint2*)(z + C_RG + c);
      const f32x4 gt = {bflo(gtb.x), bfhi(gtb.x), bflo(gtb.y), bfhi(gtb.y)};
      uint2 w = make_uint2(pk2(o.x * rs * g.x * siluf_(gt.x), o.y * rs * g.y * siluf_(gt.y)), pk2(o.z * rs * g.z * siluf_(gt.z), o.w * rs * g.w * siluf_(gt.w)));
      *(uint2*)(p.br() + (size_t)tok * DM + 512 + c) = w;
    }
  }
}

__device__ __forceinline__ void ph_router(const Params& p, int l, int tok_lo) {
  const int TID = otid();
  const int lane = TID & 63, wave = TID >> 6;
  const float* gain = p.in[I_NORM2] + l * DM;
  const float* wg = p.in[I_WGRP] + (size_t)l * DM * 4;
  float* wl = (float*)smem;
  int* lcnt = (int*)(smem + 131072);
  int* lbase = lcnt + 32;
  int* las_ex = lbase + 32;
  int* las_pos = las_ex + 160;
  int* las_id = las_pos + 160;
  __syncthreads();
  if (TID < 32) lcnt[TID] = 0;
  if (TID < 160) las_ex[TID] = -1;
  {
    const f32x4* src = (const f32x4*)(p.in[I_WEXP] + (size_t)l * DM * 32);
    for (int i = TID; i < DM * 32 / 4; i += NTHREADS) ((f32x4*)wl)[i] = src[i];
  }
  __syncthreads();
  const int rstride = gridDim.x * NWAVES;
  for (int tok0 = tok_lo + blockIdx.x * NWAVES + wave, kit = 0; tok0 < NTOK; tok0 += 2 * rstride, kit += 2) {
    int tk[2]; bool ok[2];
    tk[0] = tok0; ok[0] = true; tk[1] = tok0 + rstride; ok[1] = tk[1] < NTOK; if (!ok[1]) tk[1] = tok0;
    f32x4 h[2][4]; float ss[2];
#pragma unroll
    for (int u = 0; u < 2; ++u) {
      const f32x4* xr = (const f32x4*)(p.xbuf() + (size_t)tk[u] * DM);
      ss[u] = 0.f;
#pragma unroll
      for (int j = 0; j < 4; ++j) { h[u][j] = xr[lane + 64 * j]; ss[u] += h[u][j].x * h[u][j].x + h[u][j].y * h[u][j].y + h[u][j].z * h[u][j].z + h[u][j].w * h[u][j].w; }
    }
#pragma unroll
    for (int u = 0; u < 2; ++u) ss[u] = wave_sum(ss[u]);
    float lg[2][4];
#pragma unroll
    for (int u = 0; u < 2; ++u) {
      const float rs = 1.0f / sqrtf(ss[u] * (1.0f / DM) + EPSF);
      const float* mrow = p.mod() + (size_t)(l * 3 + tok_mod_row(tk[u])) * 6144 + 3 * 1024;
      uint2* ho = (uint2*)(p.hbf() + (size_t)tk[u] * DM);
#pragma unroll
      for (int i = 0; i < 4; ++i) lg[u][i] = 0.f;
#pragma unroll
      for (int j = 0; j < 4; ++j) {
        const int c = (lane + 64 * j) * 4;
        const f32x4 g = *(const f32x4*)(gain + c), sh = *(const f32x4*)(mrow + c), sc = *(const f32x4*)(mrow + 1024 + c);
        h[u][j] = h[u][j] * rs * g * (1.0f + sc) + sh;
        if (ok[u]) ho[lane + 64 * j] = make_uint2(pk2(h[u][j].x, h[u][j].y), pk2(h[u][j].z, h[u][j].w));
#pragma unroll
        for (int q = 0; q < 4; ++q) {
          const f32x4 wgv = *(const f32x4*)(wg + (size_t)(c + q) * 4);
#pragma unroll
          for (int i = 0; i < 4; ++i) lg[u][i] += h[u][j][q] * wgv[i];
        }
      }
    }
    int gi[2]; float grp_p[2];
#pragma unroll
    for (int u = 0; u < 2; ++u) {
      float gl[4];
#pragma unroll
      for (int i = 0; i < 4; ++i) gl[i] = wave_sum(lg[u][i]) + p.in[I_BGRP][l * 4 + i];
      int g_ = 0; float gm = gl[0];
#pragma unroll
      for (int i = 1; i < 4; ++i) if (gl[i] > gm) { gm = gl[i]; g_ = i; }
      float gs = 0.f;
#pragma unroll
      for (int i = 0; i < 4; ++i) gs += expf(gl[i] - gm);
      grp_p[u] = 1.0f / gs;
      gi[u] = __builtin_amdgcn_readfirstlane(g_);
    }
    float le[2][8];
#pragma unroll
    for (int u = 0; u < 2; ++u) {
#pragma unroll
      for (int i = 0; i < 8; ++i) le[u][i] = 0.f;
#pragma unroll
      for (int j = 0; j < 4; ++j) {
        const int c = (lane + 64 * j) * 4;
#pragma unroll
        for (int q = 0; q < 4; ++q) {
          const f32x4 w0 = *(const f32x4*)&wl[(c + q) * 32 + gi[u] * 8], w1 = *(const f32x4*)&wl[(c + q) * 32 + gi[u] * 8 + 4];
          const float hv = h[u][j][q];
          le[u][0] += hv * w0.x; le[u][1] += hv * w0.y; le[u][2] += hv * w0.z; le[u][3] += hv * w0.w;
          le[u][4] += hv * w1.x; le[u][5] += hv * w1.y; le[u][6] += hv * w1.z; le[u][7] += hv * w1.w;
        }
      }
    }
#pragma unroll
    for (int u = 0; u < 2; ++u) {
      float el[8];
#pragma unroll
      for (int i = 0; i < 8; ++i) el[i] = wave_sum(le[u][i]) + p.in[I_BEXP][l * 32 + gi[u] * 8 + i];
      int i1 = 0; float m1 = el[0];
#pragma unroll
      for (int i = 1; i < 8; ++i) if (el[i] > m1) { m1 = el[i]; i1 = i; }
      int i2 = i1 == 0 ? 1 : 0; float m2 = -3.0e38f;
#pragma unroll
      for (int i = 0; i < 8; ++i) if (i != i1 && el[i] > m2) { m2 = el[i]; i2 = i; }
      const float e2 = expf(m2 - m1);
      const float w1 = grp_p[u] / (1.0f + e2), w2 = grp_p[u] * e2 / (1.0f + e2);
      if (lane == 0 && ok[u]) {
        const int tok = tk[u];
        const int ex1 = gi[u] * 8 + i1, ex2 = gi[u] * 8 + i2;
        p.rw()[tok * 2] = w1; p.rw()[tok * 2 + 1] = w2;
        const int slot = ((kit + u) * NWAVES + wave) * 2;
        las_ex[slot] = ex1; las_pos[slot] = atomicAdd(&lcnt[ex1], 1); las_id[slot] = tok * 2;
        las_ex[slot + 1] = ex2; las_pos[slot + 1] = atomicAdd(&lcnt[ex2], 1); las_id[slot + 1] = tok * 2 + 1;
      }
    }
  }
  __syncthreads();
  if (TID < 32) lbase[TID] = lcnt[TID] > 0 ? atomicAdd(&p.cnt()[(l * 32 + TID) * 32], lcnt[TID]) : 0;
  __syncthreads();
  if (TID < 160 && las_ex[TID] >= 0) p.alist()[las_ex[TID] * NTOK + lbase[las_ex[TID]] + las_pos[TID]] = las_id[TID];
}

__device__ __forceinline__ void ph_final(const Params& p) {
  const int TID = otid();
  const int lane = TID & 63, wave = TID >> 6;
  const int rstride = gridDim.x * NWAVES;
  for (int tok0 = NCTX + blockIdx.x * NWAVES + wave; tok0 < NTOK; tok0 += 2 * rstride) {
    int tk[2]; bool ok[2];
    tk[0] = tok0; ok[0] = true; tk[1] = tok0 + rstride; ok[1] = tk[1] < NTOK; if (!ok[1]) tk[1] = tok0;
    int sl[2][2];
#pragma unroll
    for (int u = 0; u < 2; ++u) { sl[u][0] = p.aslot()[tk[u] * 2]; sl[u][1] = p.aslot()[tk[u] * 2 + 1]; }
    f32x4 v[2][4]; float ss[2];
#pragma unroll
    for (int u = 0; u < 2; ++u) {
      const f32x4* xr = (const f32x4*)(p.xbuf() + (size_t)tk[u] * DM);
      const float* grow = p.mod() + (size_t)(1 * 3 + tok_mod_row(tk[u])) * 6144 + 5 * 1024;
      ss[u] = 0.f;
#pragma unroll
      for (int j = 0; j < 4; ++j) {
        const int c = (lane + 64 * j) * 4;
        const f32x4 g = *(const f32x4*)(grow + c);
        const uint2 y0b = *(const uint2*)(p.ybuf() + (size_t)sl[u][0] * DM + c), y1b = *(const uint2*)(p.ybuf() + (size_t)sl[u][1] * DM + c);
        const f32x4 y0 = {bflo(y0b.x), bfhi(y0b.x), bflo(y0b.y), bfhi(y0b.y)}, y1 = {bflo(y1b.x), bfhi(y1b.x), bflo(y1b.y), bfhi(y1b.y)};
        v[u][j] = xr[lane + 64 * j] + g * (y0 + y1);
        ss[u] += v[u][j].x * v[u][j].x + v[u][j].y * v[u][j].y + v[u][j].z * v[u][j].z + v[u][j].w * v[u][j].w;
      }
    }
#pragma unroll
    for (int u = 0; u < 2; ++u) ss[u] = wave_sum(ss[u]);
#pragma unroll
    for (int u = 0; u < 2; ++u) {
      if (!ok[u]) continue;
      const float rs = 1.0f / sqrtf(ss[u] * (1.0f / DM) + EPSF);
      f32x4* o = (f32x4*)(p.out + (size_t)(tk[u] - NCTX) * DM);
#pragma unroll
      for (int j = 0; j < 4; ++j) {
        const int c = (lane + 64 * j) * 4;
        const f32x4 g = *(const f32x4*)(p.in[I_NORMF] + c);
        o[lane + 64 * j] = v[u][j] * rs * g;
      }
    }
  }
}

__device__ __forceinline__ void hyena_task(const Params& p, int l, int L, int tok0, int b, int c, const float* raw, const float* scale) {
  const int TID = otid();
  float* sm = (float*)smem;
  float* su = sm; float* sx0 = sm + L; float* shf = sm + 2 * L; float* shb = sm + 3 * L;
  const int tokb = tok0 + b * L;
  const float* cw = p.in[I_HYCW] + l * 3 * 768;
  const float* cb = p.in[I_HYCB] + l * 768;
  const float w00 = cw[c], w01 = cw[768 + c], w02 = cw[1536 + c], b0 = cb[c];
  const float w10 = cw[256 + c], w11 = cw[768 + 256 + c], w12 = cw[1536 + 256 + c], b1 = cb[256 + c];
  const float w20 = cw[512 + c], w21 = cw[768 + 512 + c], w22 = cw[1536 + 512 + c], b2 = cb[512 + c];
  __syncthreads();
  for (int t = TID; t < L; t += NTHREADS) {
    const bf16_t* zc = p.zmix() + (size_t)(tokb + t) * NMIX + C_HY + c;
    float x0m = 0.f, x1m = 0.f, vm = 0.f, x0p = 0.f, x1p = 0.f, vp = 0.f;
    if (t > 0) { x0m = bf2f(zc[-NMIX]); x1m = bf2f(zc[-NMIX + 256]); vm = bf2f(zc[-NMIX + 512]); }
    if (t < L - 1) { x0p = bf2f(zc[NMIX]); x1p = bf2f(zc[NMIX + 256]); vp = bf2f(zc[NMIX + 512]); }
    float x0 = x0m * w00 + bf2f(zc[0]) * w01 + x0p * w02 + b0;
    float x1 = x1m * w10 + bf2f(zc[256]) * w11 + x1p * w12 + b1;
    float v = vm * w20 + bf2f(zc[512]) * w21 + vp * w22 + b2;
    su[t] = v * x1; sx0[t] = x0;
    shf[t] = raw[(size_t)c * L + t];
    shb[t] = raw[((size_t)256 + c) * L + t];
  }
  __syncthreads();
  const float scl = scale[c], skip = p.in[I_HYSKIP][l * 256 + c];
  for (int t = TID; t < L; t += NTHREADS) {
    float a0 = 0.f, a1 = 0.f;
    for (int s = 0; s <= t; ++s) a0 += shf[t - s] * su[s];
    for (int s = t + 1; s < L; ++s) a1 += shb[s - t] * su[s];
    float y = (a0 + a1) * scl + su[t] * skip;
    p.br()[(size_t)(tokb + t) * DM + 256 + c] = f2bf(y * sx0[t]);
  }
}

struct __attribute__((aligned(8))) cf { float x, y; };
__device__ __forceinline__ cf cadd(cf a, cf b) { return {a.x + b.x, a.y + b.y}; }
__device__ __forceinline__ cf csub(cf a, cf b) { return {a.x - b.x, a.y - b.y}; }
__device__ __forceinline__ cf cmul(cf a, cf b) { return {a.x * b.x - a.y * b.y, a.x * b.y + a.y * b.x}; }
__device__ __forceinline__ cf cmulc(cf a, cf b) { return {a.x * b.x + a.y * b.y, a.y * b.x - a.x * b.y}; }
__device__ __forceinline__ int fphys(int i) { return i + ((i >> 6) << 2); }
#define FFT_PHYS_N (FFT_N + (FFT_N >> 6) * 4)

template <bool INV>
__device__ __forceinline__ void dft4(cf& a0, cf& a1, cf& a2, cf& a3) {
  const cf s02 = cadd(a0, a2), d02 = csub(a0, a2), s13 = cadd(a1, a3), d13 = csub(a1, a3);
  a0 = cadd(s02, s13); a2 = csub(s02, s13);
  if (!INV) { a1 = {d02.x + d13.y, d02.y - d13.x}; a3 = {d02.x - d13.y, d02.y + d13.x}; }
  else      { a1 = {d02.x - d13.y, d02.y + d13.x}; a3 = {d02.x + d13.y, d02.y - d13.x}; }
}
template <bool INV>
__device__ __forceinline__ void dft16(cf (&x)[16]) {
#pragma unroll
  for (int a0 = 0; a0 < 4; ++a0) dft4<INV>(x[a0], x[a0 + 4], x[a0 + 8], x[a0 + 12]);
  const float C1 = 0.92387953251128674f, S1 = 0.38268343236508977f, R2 = 0.70710678118654752f;
  const cf w1 = {C1, -S1}, w2 = {R2, -R2}, w3 = {S1, -C1}, w4 = {0.f, -1.f}, w6 = {-R2, -R2}, w9 = {-C1, S1};
#define TW(idx, w) x[idx] = INV ? cmulc(x[idx], w) : cmul(x[idx], w)
  TW(1 + 4 * 1, w1); TW(2 + 4 * 1, w2); TW(3 + 4 * 1, w3);
  TW(1 + 4 * 2, w2); TW(2 + 4 * 2, w4); TW(3 + 4 * 2, w6);
  TW(1 + 4 * 3, w3); TW(2 + 4 * 3, w6); TW(3 + 4 * 3, w9);
#undef TW
#pragma unroll
  for (int c0 = 0; c0 < 4; ++c0) dft4<INV>(x[4 * c0], x[4 * c0 + 1], x[4 * c0 + 2], x[4 * c0 + 3]);
}
#define RC16(c) (((c) >> 2) + 4 * ((c) & 3))

__device__ __forceinline__ void tw_powers(cf w1, cf (&w)[16]) {
  w[0] = {1.f, 0.f}; w[1] = w1;
  w[2] = cmul(w1, w1); w[3] = cmul(w[2], w1); w[4] = cmul(w[2], w[2]); w[5] = cmul(w[4], w1); w[6] = cmul(w[3], w[3]); w[7] = cmul(w[4], w[3]);
  w[8] = cmul(w[4], w[4]); w[9] = cmul(w[8], w1); w[10] = cmul(w[5], w[5]); w[11] = cmul(w[8], w[3]); w[12] = cmul(w[6], w[6]); w[13] = cmul(w[8], w[5]);
  w[14] = cmul(w[7], w[7]); w[15] = cmul(w[8], w[7]);
}

template <bool INV>
__device__ __forceinline__ void r16_group(cf* X, int base, int S, cf w1) {
  cf x[16], w[16];
  tw_powers(w1, w);
#pragma unroll
  for (int a = 0; a < 16; ++a) x[a] = X[fphys(base + S * a)];
  if (INV) {
#pragma unroll
    for (int c = 1; c < 16; ++c) x[c] = cmulc(x[c], w[c]);
  }
  dft16<INV>(x);
#pragma unroll
  for (int c = 0; c < 16; ++c) {
    cf v = x[RC16(c)];
    if (!INV && c > 0) v = cmul(v, w[c]);
    X[fphys(base + S * c)] = v;
  }
}
template <bool INV>
__device__ __forceinline__ void r4_group(cf* X, int base) {
  cf a0 = X[fphys(base)], a1 = X[fphys(base + 1)], a2 = X[fphys(base + 2)], a3 = X[fphys(base + 3)];
  dft4<INV>(a0, a1, a2, a3);
  X[fphys(base)] = a0; X[fphys(base + 1)] = a1; X[fphys(base + 2)] = a2; X[fphys(base + 3)] = a3;
}
template <bool INV>
__device__ __forceinline__ void fft_pass(cf* X, const cf* tw, int pass, int tid, int nthr) {
  if (pass == 1) {
    for (int g = tid; g < 1024; g += nthr) r16_group<INV>(X, g, 1024, tw[g]);
  } else if (pass == 2) {
    for (int g = tid; g < 1024; g += nthr) { const int c1 = g >> 6, b2 = g & 63; r16_group<INV>(X, c1 * 1024 + b2, 64, tw[16 * b2]); }
  } else if (pass == 3) {
    for (int g = tid; g < 1024; g += nthr) { const int blk = g >> 2, b3 = g & 3; r16_group<INV>(X, blk * 64 + b3, 4, tw[256 * b3]); }
  } else {
    for (int g = tid; g < 4096; g += nthr) r4_group<INV>(X, 4 * g);
  }
}

__device__ __forceinline__ void ph_hy_transpose(const Params& p) {
  const int tid = otid();
  float* tile = (float*)smem;
  for (int t = blockIdx.x; t < (NLAT / 64) * 12; t += gridDim.x) {
    const int tt = t / 12, ct = t % 12, tok0 = tt * 64, col0 = ct * 64;
    __syncthreads();
    {
      const int r = tid >> 3, c8 = (tid & 7) * 8;
      const bf16_t* src = p.zmix() + (size_t)(NCTX + tok0 + r) * NMIX + C_HY + col0 + c8;
      const uint4 raw = *(const uint4*)src;
      float* d = tile + r * 65 + c8;
      d[0] = bflo(raw.x); d[1] = bfhi(raw.x); d[2] = bflo(raw.y); d[3] = bfhi(raw.y); d[4] = bflo(raw.z); d[5] = bfhi(raw.z); d[6] = bflo(raw.w); d[7] = bfhi(raw.w);
    }
    __syncthreads();
    {
      const int cc = tid >> 3, r8 = (tid & 7) * 8;
      f32x4 a, b;
      a.x = tile[(r8 + 0) * 65 + cc]; a.y = tile[(r8 + 1) * 65 + cc]; a.z = tile[(r8 + 2) * 65 + cc]; a.w = tile[(r8 + 3) * 65 + cc];
      b.x = tile[(r8 + 4) * 65 + cc]; b.y = tile[(r8 + 5) * 65 + cc]; b.z = tile[(r8 + 6) * 65 + cc]; b.w = tile[(r8 + 7) * 65 + cc];
      float* dst = p.hyT() + (size_t)(col0 + cc) * NLAT + tok0 + r8;
      *(f32x4*)dst = a; *(f32x4*)(dst + 4) = b;
    }
  }
}
__device__ __forceinline__ void ph_s5_regroup(const Params& p) {
  const int gtid = blockIdx.x * NTHREADS + otid(), nthr = gridDim.x * NTHREADS;
  for (int idx = gtid; idx < NTOK * 16; idx += nthr) {
    const int tok = idx >> 4, g = idx & 15;
    const uint4* src = (const uint4*)(p.zmix() + (size_t)tok * NMIX + C_S5 + g * 16);
    uint4* dst = (uint4*)(p.s5u() + ((size_t)g * 1280 + (tok >> 4)) * 256 + (tok & 15) * 16);
    const uint4 a = src[0], b = src[1];
    dst[0] = a; dst[1] = b;
  }
}
__device__ __forceinline__ float conv3_at(const float* col, int t, float w0, float w1, float w2, float b) {
  const float m = t > 0 ? col[t - 1] : 0.f, pl = t < SEQL - 1 ? col[t + 1] : 0.f;
  return m * w0 + col[t] * w1 + pl * w2 + b;
}
__device__ __forceinline__ void hyena_fft_task(const Params& p, int l, int c) {
  const int tid = otid();
  cf* X = (cf*)smem;
  const cf* tw = (const cf*)p.twid();
  const float* hf = p.hraw() + ((size_t)l * 2 * 256 + c) * SEQL;
  const float* hb = p.hraw() + ((size_t)l * 2 * 256 + 256 + c) * SEQL;
  __syncthreads();
  for (int n = tid; n < FFT_N; n += NTHREADS) {
    const float v = n < SEQL ? hf[n] : (n == SEQL ? 0.f : hb[FFT_N - n]);
    X[fphys(n)] = cf{v, 0.f};
  }
  __syncthreads();
  for (int ps = 1; ps <= 4; ++ps) { fft_pass<false>(X, tw, ps, tid, NTHREADS); __syncthreads(); }
  cf* Kg = (cf*)p.hspec() + (size_t)c * FFT_N;
  for (int i = 0; i < 32; ++i) Kg[i * NTHREADS + tid] = X[fphys(i * NTHREADS + tid)];
  __syncthreads();
  const float* cw = p.in[I_HYCW] + l * 3 * 768;
  const float* cb = p.in[I_HYCB] + l * 768;
  const float w00 = cw[c], w01 = cw[768 + c], w02 = cw[1536 + c], b0 = cb[c];
  const float w10 = cw[256 + c], w11 = cw[768 + 256 + c], w12 = cw[1536 + 256 + c], b1 = cb[256 + c];
  const float w20 = cw[512 + c], w21 = cw[768 + 512 + c], w22 = cw[1536 + 512 + c], b2 = cb[512 + c];
  const float* x0c = p.hyT() + (size_t)c * NLAT;
  const float* x1c = p.hyT() + (size_t)(256 + c) * NLAT;
  const float* vc = p.hyT() + (size_t)(512 + c) * NLAT;
  for (int n = tid; n < FFT_N; n += NTHREADS) {
    cf z = {0.f, 0.f};
    if (n < SEQL) {
      z.x = conv3_at(vc, n, w20, w21, w22, b2) * conv3_at(x1c, n, w10, w11, w12, b1);
      z.y = conv3_at(vc + SEQL, n, w20, w21, w22, b2) * conv3_at(x1c + SEQL, n, w10, w11, w12, b1);
    }
    X[fphys(n)] = z;
  }
  __syncthreads();
  for (int ps = 1; ps <= 4; ++ps) { fft_pass<false>(X, tw, ps, tid, NTHREADS); __syncthreads(); }
#pragma unroll 4
  for (int i = 0; i < 32; ++i) { const int ph = fphys(i * NTHREADS + tid); X[ph] = cmul(X[ph], Kg[i * NTHREADS + tid]); }
  __syncthreads();
  for (int ps = 4; ps >= 1; --ps) { fft_pass<true>(X, tw, ps, tid, NTHREADS); __syncthreads(); }
  const float scl = p.hscale()[l * 256 + c] * (1.0f / (float)FFT_N), skip = p.in[I_HYSKIP][l * 256 + c];
  for (int t = tid; t < SEQL; t += NTHREADS) {
    const cf y = X[fphys(t)];
    const float u0 = conv3_at(vc, t, w20, w21, w22, b2) * conv3_at(x1c, t, w10, w11, w12, b1);
    const float u1 = conv3_at(vc + SEQL, t, w20, w21, w22, b2) * conv3_at(x1c + SEQL, t, w10, w11, w12, b1);
    const float x00 = conv3_at(x0c, t, w00, w01, w02, b0), x01 = conv3_at(x0c + SEQL, t, w00, w01, w02, b0);
    bf16_t* hyo = (bf16_t*)(p.hspec() + (size_t)c * FFT_N * 2);
    hyo[t] = f2bf((y.x * scl + u0 * skip) * x00);
    hyo[SEQL + t] = f2bf((y.y * scl + u1 * skip) * x01);
  }
}

__device__ __forceinline__ void unpack8(const uint4 r, float (&v)[8]) {
  v[0] = bflo(r.x); v[1] = bfhi(r.x); v[2] = bflo(r.y); v[3] = bfhi(r.y); v[4] = bflo(r.z); v[5] = bfhi(r.z); v[6] = bflo(r.w); v[7] = bfhi(r.w);
}
__device__ __forceinline__ float fsigmoid(float x) { return __builtin_amdgcn_rcpf(1.0f + __builtin_amdgcn_exp2f(-1.4426950408889634f * x)); }

template <bool PASSC>
__device__ __forceinline__ void hgrn_task(const Params& p, int l, int task, float* wl  ) {
  const int lane = otid() & 63;
  const int chunk = task % NCHUNK, r = task / NCHUNK, h = r & 3, dir = (r >> 2) & 1, b = r >> 3;
  float* lf = wl; float* lq = wl + 1024; float* lv = wl + 2048;
  f32x2 S[32];
  if (PASSC) {
#pragma unroll
    for (int d = 0; d < 32; ++d) { S[d].x = p.hgU()[((size_t)task * 64 + 2 * d) * 64 + lane]; S[d].y = p.hgU()[((size_t)task * 64 + 2 * d + 1) * 64 + lane]; }
  } else {
#pragma unroll
    for (int d = 0; d < 32; ++d) S[d] = (f32x2){0.f, 0.f};
  }
  const int d8 = (lane & 7) * 8;
  float lb8[8], dp[8];
#pragma unroll
  for (int j = 0; j < 8; ++j) { lb8[j] = p.lb()[(l * 2 + dir) * 256 + h * 64 + d8 + j]; dp[j] = 1.0f; }
  uint4 rf[2], rq[2], rv[2];
  auto gload = [&](int sub) {
#pragma unroll
    for (int k = 0; k < 2; ++k) {
      const int i = (lane >> 3) + 8 * k;
      const bf16_t* z = p.zmix() + (size_t)scan_tok(chunk * 64 + sub * 16 + i, dir, b) * NMIX + h * 64 + d8;
      rf[k] = *(const uint4*)(z + C_HGF + dir * 256);
      if (PASSC) rq[k] = *(const uint4*)(z + C_HGQ);
      rv[k] = *(const uint4*)(z + C_HGI);
    }
  };
  float* outp = p.hgo() + (size_t)dir * NTOK * 256;
  gload(0);
  for (int sub = 0; sub < 4; ++sub) {
    LDS_FENCE();
#pragma unroll
    for (int k = 0; k < 2; ++k) {
      const int i = (lane >> 3) + 8 * k;
      float t8[8];
      unpack8(rf[k], t8);
#pragma unroll
      for (int j = 0; j < 8; ++j) { t8[j] = lb8[j] + (1.0f - lb8[j]) * fsigmoid(t8[j]); dp[j] *= t8[j]; }
      *(f32x4*)&lf[i * 64 + d8] = (f32x4){t8[0], t8[1], t8[2], t8[3]}; *(f32x4*)&lf[i * 64 + d8 + 4] = (f32x4){t8[4], t8[5], t8[6], t8[7]};
      if (PASSC) { unpack8(rq[k], t8); *(f32x4*)&lq[i * 64 + d8] = (f32x4){t8[0], t8[1], t8[2], t8[3]}; *(f32x4*)&lq[i * 64 + d8 + 4] = (f32x4){t8[4], t8[5], t8[6], t8[7]}; }
      unpack8(rv[k], t8);
      *(f32x4*)&lv[i * 64 + d8] = (f32x4){t8[0], t8[1], t8[2], t8[3]}; *(f32x4*)&lv[i * 64 + d8 + 4] = (f32x4){t8[4], t8[5], t8[6], t8[7]};
    }
    LDS_FENCE();
    if (sub < 3) gload(sub + 1);
    const int s0 = chunk * 64 + sub * 16;
    for (int i = 0; i < 16; ++i) {
      const float v = lv[i * 64 + lane];
      const f32x2 v2 = {v, v};
      f32x2 o2 = {0.f, 0.f};
#pragma unroll
      for (int d4 = 0; d4 < 16; ++d4) {
        const f32x4 f4 = *(const f32x4*)&lf[i * 64 + d4 * 4];
        const f32x2 fa = {f4.x, f4.y}, fb = {f4.z, f4.w};
        S[2 * d4] = fa * (S[2 * d4] - v2) + v2;
        S[2 * d4 + 1] = fb * (S[2 * d4 + 1] - v2) + v2;
        if (PASSC) {
          const f32x4 q4 = *(const f32x4*)&lq[i * 64 + d4 * 4];
          o2 = S[2 * d4] * (f32x2){q4.x, q4.y} + o2;
          o2 = S[2 * d4 + 1] * (f32x2){q4.z, q4.w} + o2;
        }
      }
      if (PASSC) outp[(size_t)scan_tok(s0 + i, dir, b) * 256 + h * 64 + lane] = o2.x + o2.y;
    }
  }
  if (!PASSC) {
#pragma unroll
    for (int d = 0; d < 32; ++d) { p.hgU()[((size_t)task * 64 + 2 * d) * 64 + lane] = S[d].x; p.hgU()[((size_t)task * 64 + 2 * d + 1) * 64 + lane] = S[d].y; }
#pragma unroll
    for (int j = 0; j < 8; ++j) { dp[j] *= __shfl_xor(dp[j], 8); dp[j] *= __shfl_xor(dp[j], 16); dp[j] *= __shfl_xor(dp[j], 32); }
    if (lane < 8) {
#pragma unroll
      for (int j = 0; j < 8; ++j) p.hgD()[(size_t)task * 64 + d8 + j] = dp[j];
    }
  }
}

template <bool PASSC>
__device__ __forceinline__ void ret_task(const Params& p, int l, int task, float* wl) {
  const int lane = otid() & 63;
  const int chunk = task % NCHUNK, r = task / NCHUNK, h = r & 3, dir = (r >> 2) & 1, b = r >> 3;
  float* lq = wl; float* lk = wl + 512; float* lv = wl + 1024;
  const float gamma = sigmoidf_(p.in[I_RETDEC][(l * 2 + dir) * 4 + h]);
  const f32x2 g2 = {gamma, gamma};
  f32x2 S[16];
  if (PASSC) {
#pragma unroll
    for (int d = 0; d < 16; ++d) { S[d].x = p.rtU()[((size_t)task * 32 + 2 * d) * 64 + lane]; S[d].y = p.rtU()[((size_t)task * 32 + 2 * d + 1) * 64 + lane]; }
  } else {
#pragma unroll
    for (int d = 0; d < 16; ++d) S[d] = (f32x2){0.f, 0.f};
  }
  const int qi = lane >> 2, qd8 = (lane & 3) * 8;
  const int vd8 = (lane & 7) * 8;
  uint4 rq, rk, rv[2];
  auto gload = [&](int sub) {
    const bf16_t* z = p.zmix() + (size_t)scan_tok(chunk * 64 + sub * 16 + qi, dir, b) * NMIX + h * 32 + qd8;
    if (PASSC) rq = *(const uint4*)(z + C_RQ);
    rk = *(const uint4*)(z + C_RK);
#pragma unroll
    for (int k = 0; k < 2; ++k) {
      const int i = (lane >> 3) + 8 * k;
      rv[k] = *(const uint4*)(p.zmix() + (size_t)scan_tok(chunk * 64 + sub * 16 + i, dir, b) * NMIX + C_RV + h * 64 + vd8);
    }
  };
  float* outp = p.rto() + (size_t)dir * NTOK * 256;
  gload(0);
  for (int sub = 0; sub < 4; ++sub) {
    const int s0 = chunk * 64 + sub * 16;
    LDS_FENCE();
    {
      const int tok = scan_tok(s0 + qi, dir, b);
      float kq[8], kk[8];
      if (PASSC) unpack8(rq, kq);
      unpack8(rk, kk);
#pragma unroll
      for (int j = 0; j < 8; ++j) kk[j] *= 0.17677669529663687f;
      if (tok >= NCTX) {
        const int tt = (tok - NCTX) & (SEQL - 1);
        const int pos = (qd8 & 16) ? (tt & 63) : (tt >> 6);
        const float* cs = p.rope() + pos * 16;
        const bool second = qd8 & 8;
#pragma unroll
        for (int j = 0; j < 8; ++j) {
          const float c = cs[2 * j], s = cs[2 * j + 1];
          const float okk = __shfl_xor(kk[j], 1);
          kk[j] = second ? (okk * s + kk[j] * c) : (kk[j] * c - okk * s);
          if (PASSC) { const float oq = __shfl_xor(kq[j], 1); kq[j] = second ? (oq * s + kq[j] * c) : (kq[j] * c - oq * s); }
        }
      }
      if (PASSC) { *(f32x4*)&lq[qi * 32 + qd8] = (f32x4){kq[0], kq[1], kq[2], kq[3]}; *(f32x4*)&lq[qi * 32 + qd8 + 4] = (f32x4){kq[4], kq[5], kq[6], kq[7]}; }
      *(f32x4*)&lk[qi * 32 + qd8] = (f32x4){kk[0], kk[1], kk[2], kk[3]}; *(f32x4*)&lk[qi * 32 + qd8 + 4] = (f32x4){kk[4], kk[5], kk[6], kk[7]};
#pragma unroll
      for (int k = 0; k < 2; ++k) {
        const int i = (lane >> 3) + 8 * k;
        float t8[8];
        unpack8(rv[k], t8);
        *(f32x4*)&lv[i * 64 + vd8] = (f32x4){t8[0], t8[1], t8[2], t8[3]}; *(f32x4*)&lv[i * 64 + vd8 + 4] = (f32x4){t8[4], t8[5], t8[6], t8[7]};
      }
    }
    LDS_FENCE();
    if (sub < 3) gload(sub + 1);
    for (int i = 0; i < 16; ++i) {
      const float v = lv[i * 64 + lane];
      const f32x2 v2 = {v, v};
      f32x2 o2 = {0.f, 0.f};
#pragma unroll
      for (int d4 = 0; d4 < 8; ++d4) {
        const f32x4 k4 = *(const f32x4*)&lk[i * 32 + d4 * 4];
        S[2 * d4] = g2 * S[2 * d4] + (f32x2){k4.x, k4.y} * v2;
        S[2 * d4 + 1] = g2 * S[2 * d4 + 1] + (f32x2){k4.z, k4.w} * v2;
        if (PASSC) {
          const f32x4 q4 = *(const f32x4*)&lq[i * 32 + d4 * 4];
          o2 = S[2 * d4] * (f32x2){q4.x, q4.y} + o2;
          o2 = S[2 * d4 + 1] * (f32x2){q4.z, q4.w} + o2;
        }
      }
      if (PASSC) outp[(size_t)scan_tok(s0 + i, dir, b) * 256 + h * 64 + lane] = o2.x + o2.y;
    }
  }
  if (!PASSC) {
#pragma unroll
    for (int d = 0; d < 16; ++d) { p.rtU()[((size_t)task * 32 + 2 * d) * 64 + lane] = S[d].x; p.rtU()[((size_t)task * 32 + 2 * d + 1) * 64 + lane] = S[d].y; }
  }
}

__device__ __forceinline__ f32x4 mfma16(bf16x8 x, bf16x8 y, f32x4 c) { return __builtin_amdgcn_mfma_f32_16x16x32_bf16(x, y, c, 0, 0, 0); }
__device__ __forceinline__ float fexp(float x) { return __builtin_amdgcn_exp2f(1.4426950408889634f * x); }

template <int DK, bool PASSC, bool RET>
__device__ __forceinline__ void chunk_task(const Params& p, int l, int task, unsigned char* wlds  ) {
  const int lane = otid() & 63, fr = lane & 15, fq = lane >> 4;
  const int chunk = task % NCHUNK, r = task / NCHUNK, h = r & 3, dir = (r >> 2) & 1, b = r >> 3;
  constexpr int NDT = DK / 16, NKS = DK / 32;
  bf16_t* Qh = (bf16_t*)wlds;
  bf16_t* Kt = Qh + 1024;
  bf16_t* KtT = Kt + 1024;
  bf16_t* VT = KtT + 1024;
  bf16_t* Pm = VT + 1024;
  bf16_t* ST = Pm + 256;
  float* Dl = (float*)(ST + 4096);
  float* Ustate = RET ? p.rtU() : p.hgU();
  f32x4 S[NDT][4];
#pragma unroll
  for (int dt = 0; dt < NDT; ++dt)
#pragma unroll
    for (int et = 0; et < 4; ++et) {
      if (PASSC) {
#pragma unroll
        for (int j = 0; j < 4; ++j) S[dt][et][j] = Ustate[((size_t)task * DK + 16 * dt + 4 * fq + j) * 64 + 16 * et + fr];
      } else S[dt][et] = (f32x4){0.f, 0.f, 0.f, 0.f};
    }
  float lbv = 0.f, gam = 1.f;
  if (RET) gam = sigmoidf_(p.in[I_RETDEC][(l * 2 + dir) * 4 + h]);
  else if (lane < DK) lbv = p.lb()[(l * 2 + dir) * 256 + h * 64 + lane];
  float btot = 1.f;
  const int colF = RET ? (C_RK + h * 32) : (C_HGF + dir * 256 + h * 64);
  const int colQ = RET ? (C_RQ + h * 32) : (C_HGQ + h * 64);
  const int colV = RET ? (C_RV + h * 64) : (C_HGI + h * 64);
  const int lq = lane < DK ? lane : 0;
  unsigned rf[16], rq[16], rv[16];
  auto gload = [&](int sub) {
#pragma unroll
    for (int t = 0; t < 16; ++t) {
      const bf16_t* z = p.zmix() + (size_t)scan_tok(chunk * 64 + sub * 16 + t, dir, b) * NMIX;
      rf[t] = z[colF + lq];
      if (PASSC) rq[t] = z[colQ + lq];
      rv[t] = z[colV + lane];
    }
  };
  float* outp = (RET ? p.rto() : p.hgo()) + (size_t)dir * NTOK * 256;
  gload(0);
  for (int sub = 0; sub < 4; ++sub) {
    const int s0 = chunk * 64 + sub * 16;
    LDS_FENCE();
    {
      float kk[16], qq[16];
#pragma unroll
      for (int t = 0; t < 16; ++t) { kk[t] = __uint_as_float(rf[t] << 16); qq[t] = PASSC ? __uint_as_float(rq[t] << 16) : 0.f; }
      unsigned vpk[8];
#pragma unroll
      for (int t = 0; t < 8; ++t) vpk[t] = (rv[2 * t] & 0xffffu) | (rv[2 * t + 1] << 16);
      *(uint4*)&VT[lane * 16] = make_uint4(vpk[0], vpk[1], vpk[2], vpk[3]);
      *(uint4*)&VT[lane * 16 + 8] = make_uint4(vpk[4], vpk[5], vpk[6], vpk[7]);
      if (sub < 3) gload(sub + 1);
      if (RET) {
        const bool lat = scan_tok(s0, dir, b) >= NCTX;
        f32x2 cs[16];
#pragma unroll
        for (int t = 0; t < 16; ++t) {
          const int tt = (scan_tok(s0 + t, dir, b) - NCTX) & (SEQL - 1);
          const int pos = lat ? ((lane & 16) ? (tt & 63) : (tt >> 6)) : 0;
          cs[t] = *(const f32x2*)&p.rope()[pos * 16 + 2 * (lane & 7)];
        }
        const bool second = lane & 8;
#pragma unroll
        for (int t = 0; t < 16; ++t) {
          kk[t] *= 0.17677669529663687f;
          const float ok = __shfl_xor(kk[t], 8), oq = __shfl_xor(qq[t], 8);
          const float c = cs[t].x, sn = cs[t].y;
          kk[t] = second ? (ok * sn + kk[t] * c) : (kk[t] * c - ok * sn);
          qq[t] = second ? (oq * sn + qq[t] * c) : (qq[t] * c - oq * sn);
        }
      }
      float cprod = 1.0f;
      unsigned kpk[8];
      float ktv[16];
#pragma unroll
      for (int t = 0; t < 16; ++t) {
        float f, kv;
        if (RET) { f = gam; kv = kk[t]; }
        else { f = lbv + (1.0f - lbv) * fsigmoid(kk[t]); kv = 1.0f - f; }
        cprod *= f;
        const float e1 = fmaxf(cprod, 1e-30f), e2 = __builtin_amdgcn_rcpf(e1);
        ktv[t] = kv * e2;
        if (PASSC) {
          const unsigned qk = pk2(qq[t] * e1, ktv[t]);
          if (lane < DK) { Qh[t * DK + lane] = (bf16_t)(qk & 0xffffu); Kt[t * DK + lane] = (bf16_t)(qk >> 16); }
        }
      }
#pragma unroll
      for (int t = 0; t < 8; ++t) kpk[t] = pk2(ktv[2 * t], ktv[2 * t + 1]);
      if (lane < DK) {
        *(uint4*)&KtT[lane * 16] = make_uint4(kpk[0], kpk[1], kpk[2], kpk[3]);
        *(uint4*)&KtT[lane * 16 + 8] = make_uint4(kpk[4], kpk[5], kpk[6], kpk[7]);
        Dl[lane] = cprod;
      }
      btot *= cprod;
    }
    const bf16x8 zero8 = {0, 0, 0, 0, 0, 0, 0, 0};
    if (PASSC) {
#pragma unroll
      for (int dt = 0; dt < NDT; ++dt)
#pragma unroll
        for (int et = 0; et < 4; ++et)
          *(uint2*)&ST[(16 * et + fr) * DK + 16 * dt + 4 * fq] = make_uint2(pk2(S[dt][et][0], S[dt][et][1]), pk2(S[dt][et][2], S[dt][et][3]));
      LDS_FENCE();
      f32x4 P = {0.f, 0.f, 0.f, 0.f};
#pragma unroll
      for (int ks = 0; ks < NKS; ++ks) {
        const bf16x8 X = *(const bf16x8*)&Kt[fr * DK + 32 * ks + 8 * fq];
        const bf16x8 Y = *(const bf16x8*)&Qh[fr * DK + 32 * ks + 8 * fq];
        P = mfma16(X, Y, P);
      }
#pragma unroll
      for (int j = 0; j < 4; ++j) if (4 * fq + j > fr) P[j] = 0.f;
      *(uint2*)&Pm[fr * 16 + 4 * fq] = make_uint2(pk2(P[0], P[1]), pk2(P[2], P[3]));
      LDS_FENCE();
      const bf16x8 Yp = fq < 2 ? *(const bf16x8*)&Pm[fr * 16 + 8 * fq] : zero8;
      bf16x8 Yq[NKS];
#pragma unroll
      for (int ks = 0; ks < NKS; ++ks) Yq[ks] = *(const bf16x8*)&Qh[fr * DK + 32 * ks + 8 * fq];
      const size_t orow = (size_t)scan_tok(s0 + fr, dir, b) * 256 + h * 64 + 4 * fq;
#pragma unroll
      for (int et = 0; et < 4; ++et) {
        f32x4 O = {0.f, 0.f, 0.f, 0.f};
        const bf16x8 Xv = fq < 2 ? *(const bf16x8*)&VT[(16 * et + fr) * 16 + 8 * fq] : zero8;
        O = mfma16(Xv, Yp, O);
#pragma unroll
        for (int ks = 0; ks < NKS; ++ks) {
          const bf16x8 Xs = *(const bf16x8*)&ST[(16 * et + fr) * DK + 32 * ks + 8 * fq];
          O = mfma16(Xs, Yq[ks], O);
        }
        *(f32x4*)(outp + orow + 16 * et) = O;
      }
    } else {
      LDS_FENCE();
    }
    {
      bf16x8 Yv[4];
#pragma unroll
      for (int et = 0; et < 4; ++et) Yv[et] = fq < 2 ? *(const bf16x8*)&VT[(16 * et + fr) * 16 + 8 * fq] : zero8;
#pragma unroll
      for (int dt = 0; dt < NDT; ++dt) {
        const bf16x8 Xk = fq < 2 ? *(const bf16x8*)&KtT[(16 * dt + fr) * 16 + 8 * fq] : zero8;
        const f32x4 D4 = *(const f32x4*)&Dl[16 * dt + 4 * fq];
#pragma unroll
        for (int et = 0; et < 4; ++et) { S[dt][et] = mfma16(Xk, Yv[et], S[dt][et]); S[dt][et] = S[dt][et] * D4; }
      }
    }
  }
  if (!PASSC) {
#pragma unroll
    for (int dt = 0; dt < NDT; ++dt)
#pragma unroll
      for (int et = 0; et < 4; ++et)
#pragma unroll
        for (int j = 0; j < 4; ++j) Ustate[((size_t)task * DK + 16 * dt + 4 * fq + j) * 64 + 16 * et + fr] = S[dt][et][j];
    if (!RET && lane < DK) p.hgD()[(size_t)task * 64 + lane] = btot;
  }
}

template <bool PASSC>
__device__ __forceinline__ void ph_mix_tasks(const Params& p, int l) {
  const int TID = otid();
  const int wave = TID >> 6;
  unsigned char* wl = smem + wave * 17152;
  const int gw = blockIdx.x * NWAVES + wave, nw = gridDim.x * NWAVES;
  if (PASSC && l == 1) {
    for (int t = gw; t < 16 * 128; t += nw) chunk_task<64, PASSC, false>(p, l, (t >> 7) * NCHUNK + 4 + (t & 127), wl);
    for (int t = gw; t < 16 * 128; t += nw) chunk_task<32, PASSC, true>(p, l, (t >> 7) * NCHUNK + 4 + (t & 127), wl);
  } else {
    for (int t = gw; t < 16 * NCHUNK; t += nw) chunk_task<64, PASSC, false>(p, l, t, wl);
    for (int t = gw >= 64 ? gw - 64 : gw + nw - 64; t < 16 * NCHUNK; t += nw) chunk_task<32, PASSC, true>(p, l, t, wl);
  }
}

__device__ __forceinline__ void ph_scan(const Params& p, int l) {
  const int TID = otid();
  const int gtid = blockIdx.x * NTHREADS + TID, nthr = gridDim.x * NTHREADS;
  for (int idx = gtid; idx < 16 * 4096 + 16 * 2048; idx += nthr) {
    if (idx < 16 * 4096) {
      const int r = idx >> 12, de = idx & 4095, d = de >> 6;
      float s = 0.f;
      float* U = p.hgU() + (size_t)r * NCHUNK * 4096 + de;
      const float* D = p.hgD() + (size_t)r * NCHUNK * 64 + d;
      for (int j0 = 0; j0 < NCHUNK; j0 += 12) {
        float u[12], dd[12];
#pragma unroll
        for (int j = 0; j < 12; ++j) { u[j] = U[(size_t)(j0 + j) * 4096]; dd[j] = D[(j0 + j) * 64]; }
#pragma unroll
        for (int j = 0; j < 12; ++j) { U[(size_t)(j0 + j) * 4096] = s; s = fmaf(dd[j], s, u[j]); }
      }
    } else {
      const int i2 = idx - 16 * 4096;
      const int r = i2 >> 11, de = i2 & 2047, h = r & 3, dir = (r >> 2) & 1;
      const float gamma = sigmoidf_(p.in[I_RETDEC][(l * 2 + dir) * 4 + h]);
      const float g64 = powf(gamma, 64.0f);
      float s = 0.f;
      float* U = p.rtU() + (size_t)r * NCHUNK * 2048 + de;
      for (int j0 = 0; j0 < NCHUNK; j0 += 12) {
        float u[12];
#pragma unroll
        for (int j = 0; j < 12; ++j) u[j] = U[(size_t)(j0 + j) * 2048];
#pragma unroll
        for (int j = 0; j < 12; ++j) { U[(size_t)(j0 + j) * 2048] = s; s = fmaf(g64, s, u[j]); }
      }
    }
  }
}


__device__ __forceinline__ void ph_s5_scan(const Params& p, int l) {
  const int tid = otid();
  f32x2* xl = (f32x2*)smem;
  float* Tl = (float*)smem + 33 * 512 * 2;
  if (blockIdx.x < 128) {
    const int blk = blockIdx.x;
    const int phalf = blk & 1, dir = (blk >> 1) & 1, g = (blk >> 2) & 15, b = blk >> 6;
    const int pl = tid & 31, seg = tid >> 5, pp = phalf * 32 + pl;
    const int sidx = ((l * 2 + dir) * 16 + g) * 64 + pp;
    float ar = p.s5a()[sidx * 2], ai = p.s5a()[sidx * 2 + 1];
#pragma unroll
    for (int k = 0; k < 4; ++k) { const float nr = ar * ar - ai * ai, ni = 2.0f * ar * ai; ar = nr; ai = ni; }
    const unsigned colo = (unsigned)(dir * 128 + pp * 2);
    const char* xbase = (const char*)(p.sX() + (size_t)g * 1280 * 256);
    char* sbase = (char*)(p.sXS() + (size_t)g * 1280 * 256);
    const int sgn = dir ? -1 : 1, offC = b * 16 + (dir ? 15 : 0), offL = b * 512 + (dir ? 559 : 16);
    for (int i0 = 0; i0 < 33; i0 += 11) {
      f32x2 t[11];
#pragma unroll
      for (int k = 0; k < 11; ++k) {
        const int jj = seg * 33 + i0 + k;
        const int row = (jj < 16 ? offC : offL) + sgn * jj;
        t[k] = *(const f32x2*)(xbase + ((unsigned)row * 256u + colo) * 4u);
      }
#pragma unroll
      for (int k = 0; k < 11; ++k) xl[(i0 + k) * 512 + tid] = t[k];
    }
    float sr = 0.f, si = 0.f;
#pragma unroll 3
    for (int i = 0; i < 33; ++i) { const f32x2 t = xl[i * 512 + tid]; xl[i * 512 + tid] = (f32x2){sr, si}; const float nr = ar * sr - ai * si + t.x, ni = ar * si + ai * sr + t.y; sr = nr; si = ni; }
    Tl[tid * 2] = sr; Tl[tid * 2 + 1] = si;
    __syncthreads();
    float br = ar, bi = ai;
#pragma unroll
    for (int k = 0; k < 5; ++k) { const float nr = br * br - bi * bi, ni = 2.0f * br * bi; br = nr; bi = ni; }
    { const float nr = br * ar - bi * ai, ni = br * ai + bi * ar; br = nr; bi = ni; }
    float cr = 0.f, ci = 0.f;
    for (int s2 = 0; s2 < seg; ++s2) { const float tr = Tl[(s2 * 32 + pl) * 2], ti = Tl[(s2 * 32 + pl) * 2 + 1]; const float nr = br * cr - bi * ci + tr, ni = br * ci + bi * cr + ti; cr = nr; ci = ni; }
    float pr = 1.f, pi = 0.f;
#pragma unroll 3
    for (int i = 0; i < 33; ++i) {
      const int jj = seg * 33 + i;
      const int row = (jj < 16 ? offC : offL) + sgn * jj;
      const f32x2 x = xl[i * 512 + tid];
      const float vr = x.x + pr * cr - pi * ci, vi = x.y + pr * ci + pi * cr;
      *(unsigned*)(sbase + ((unsigned)row * 256u + colo) * 2u) = pk2(vr, vi);
      const float nr = pr * ar - pi * ai, ni = pr * ai + pi * ar; pr = nr; pi = ni;
    }
  }
}

__device__ __forceinline__ void cvt_item(const float* W, int ldw, bf16_t* WT, int ldt, int k0, int n0, int ilv, float* scr, int lane) {
  f32x4 v[8];
#pragma unroll
  for (int i = 0; i < 8; ++i) { const int pc = lane + 64 * i; v[i] = *(const f32x4*)(W + (size_t)(k0 + (pc >> 3)) * ldw + n0 + (pc & 7) * 4); }
#pragma unroll
  for (int i = 0; i < 8; ++i) { const int pc = lane + 64 * i; float* d = scr + (pc >> 3) * 33 + (pc & 7) * 4; d[0] = v[i].x; d[1] = v[i].y; d[2] = v[i].z; d[3] = v[i].w; }
  LDS_FENCE();
  const int c = lane & 7;
#pragma unroll
  for (int j = 0; j < 4; ++j) {
    const int n = (lane >> 3) + 8 * j;
    const float* s = scr + (8 * c) * 33 + n;
    uint4 o;
    o.x = pk2(s[0 * 33], s[1 * 33]); o.y = pk2(s[2 * 33], s[3 * 33]); o.z = pk2(s[4 * 33], s[5 * 33]); o.w = pk2(s[6 * 33], s[7 * 33]);
    const int nn = n0 + n;
    const int ilvm = ilv & 255;
    const int drow = ilvm == 0 ? nn : ilvm == 3 ? (nn < NMIX ? nn : NMIX + ((nn - NMIX) & 1023) * 4 + ((nn - NMIX) >> 10)) : ((nn >> 4) * 32 + (ilvm - 1) * 16 + (nn & 15));
    const int drow2 = (ilv & 256) && !((ilv & 255) == 3 && nn >= NMIX) ? ((drow & ~31) | (16 * ((drow >> 2) & 1) + 4 * ((drow >> 3) & 3) + (drow & 3))) : drow;
    *(uint4*)(WT + (size_t)drow2 * ldt + k0 + 8 * c) = o;
  }
  LDS_FENCE();
}
__device__ __forceinline__ void ph_cvt_static(const Params& p) {
  const int tid = otid(), lane = tid & 63, wave = tid >> 6;
  float* scr = (float*)smem + 4096 + wave * 2112;
  constexpr int I_IN = 16 * 224, I_BR = 4 * 4 * 32, I_OUT = 16 * 32, I_GLU = 2 * 4 * 8, I_L = I_IN + I_BR + I_OUT + I_GLU;
  for (int it = blockIdx.x * NWAVES + wave; it < 2 * I_L; it += gridDim.x * NWAVES) {
    const int l = it / I_L; int r = it % I_L;
    if (r < I_IN) { const int kb = r / 224, nb = r % 224; cvt_item(p.in[I_WIN] + (size_t)l * DM * NIN, NIN, p.WinT() + (size_t)l * NIN * DM, DM, kb * 64, nb * 32, 3 | 256, scr, lane); continue; }
    r -= I_IN;
    if (r < I_BR) { const int n = r / 128, q = r % 128, kb = q / 32, nb = q % 32;
      cvt_item(p.in[I_WBR] + (size_t)(l * 4 + n) * 256 * DM, DM, p.WbrT() + (size_t)(l * 4 + n) * DM * 256, 256, kb * 64, nb * 32, 256, scr, lane); continue; }
    r -= I_BR;
    if (r < I_OUT) { const int kb = r / 32, nb = r % 32; cvt_item(p.in[I_WOUT] + (size_t)l * DM * DM, DM, p.WoutT() + (size_t)l * DM * DM, DM, kb * 64, nb * 32, 0, scr, lane); continue; }
    r -= I_OUT;
    { const int which = r / 32, q = r % 32, kb = q / 8, nb = q % 8;
      cvt_item(p.in[which ? I_GLU2 : I_GLU1] + (size_t)l * 256 * 256, 256, p.GluT() + (size_t)l * 512 * 256, 256, kb * 64, nb * 32, 1 + which, scr, lane); }
  }
}
__device__ __forceinline__ void ph_cvt_moe(const Params& p, int l) {
  const int tid = otid(), lane = tid & 63, wave = tid >> 6;
  float* scr = (float*)smem + wave * 2112;
  for (int it = blockIdx.x * NWAVES + wave; it < 32 * 768; it += gridDim.x * NWAVES) {
    const int e = it / 768; int r = it % 768;
    if (r < 512) { const int which = r >> 8, q = r & 255, kb = q / 16, nb = q % 16;
      cvt_item(p.in[which ? I_MW3 : I_MW1] + (size_t)(l * 32 + e) * DM * 512, 512, p.W13T() + (size_t)e * DM * DM, DM, kb * 64, nb * 32, 1 + which, scr, lane); }
    else { r -= 512; const int kb = r / 32, nb = r % 32;
      cvt_item(p.in[I_MW2] + (size_t)(l * 32 + e) * 512 * DM, DM, p.W2T() + (size_t)e * DM * 512, 512, kb * 64, nb * 32, 256, scr, lane); }
  }
}

namespace g8 {
constexpr int BM = 256, BK = 64, HALF = 128, HTB = HALF * BK * 2, STAGE_BYTES = 8 * HTB, NXCD = 8, WGM = 8;
__device__ __forceinline__ int lds_byte(int r, int c) { const int st = (r >> 4) * 2 + (c >> 5), rr = r & 15, cc = c & 31, ob = rr * 64 + cc * 2; return st * 1024 + (ob ^ (((ob >> 9) & 1) << 5)); }
__device__ __forceinline__ void stage_rc(int b, int& R, int& C) { const int st = b / 1024, sb = b % 1024, swz = sb ^ (((sb >> 9) & 1) << 5); R = (st >> 1) * 16 + swz / 64; C = (st & 1) * 32 + (swz % 64) / 2; }

struct Unit { const char* A; const char* B; int pm, pn, aux, keep, info; };
typedef f32x4 Acc[2][2][4][2];

__device__ __forceinline__ bool static_tile(int L, int nM, int nN, int& pm, int& pn) {
  const int nwg = nM * nN;
  if (L >= nwg) return false;
  int wgid = L; { const int q = nwg / NXCD, r = nwg % NXCD, xcd = wgid % NXCD, off = wgid / NXCD; wgid = (xcd < r ? xcd * (q + 1) : r * (q + 1) + (xcd - r) * q) + off; }
  const int nig = WGM * nN, gid = wgid / nig, fm = gid * WGM, gsz = (nM - fm) < WGM ? (nM - fm) : WGM;
  pm = fm + ((wgid % nig) % gsz); pn = (wgid % nig) / gsz;
  return true;
}

template <class Src, class Epi>
__device__ __forceinline__ void gemm_stream(LAS unsigned char* lds, const Src& S, const Epi& E, const int K, const int ldb) {
  const int tid = otid(), wid = __builtin_amdgcn_readfirstlane(tid >> 6), lane = tid & 63, wr = wid >> 2, wc = wid & 3, fr = lane & 15, fq = lane >> 4;
  const int nt = K / BK;
  int Rs[2], Cs[2]; unsigned voffB[2];
#pragma unroll
  for (int i = 0; i < 2; ++i) { stage_rc(tid * 16 + i * 8192, Rs[i], Cs[i]); voffB[i] = (unsigned)(Rs[i] * ldb + Cs[i]) * 2u; }
  const size_t kstep = (size_t)(BK * 2);
  const size_t hstepB = (size_t)HALF * ldb * 2;
  const unsigned ldsw = (unsigned)wid * 1024u;
  const int aoff = lds_byte(wr * 64 + fr, fq * 8), boff = lds_byte(wc * 32 + fr, fq * 8);
#define G8_SA(b, h) (((b) * 2 + (h)) * HTB)
#define G8_SB(b, h) ((4 + (b) * 2 + (h)) * HTB)
#define G8_STAGE(bufoff, gbase, voff) do { _Pragma("unroll") for (int _i = 0; _i < 2; ++_i) \
        __builtin_amdgcn_global_load_lds((const unsigned*)((const char*)(gbase) + (voff)[_i]), (LAS unsigned*)(lds + (bufoff) + ldsw + _i * 8192), 16, 0, 0); } while (0)
#define G8_LDA(dst, b, h) do { _Pragma("unroll") for (int m = 0; m < 4; ++m) _Pragma("unroll") for (int k = 0; k < 2; ++k) dst[m][k] = *(const LAS bf16x8*)(lds + G8_SA(b, h) + aoff + m * 2048 + k * 1024); } while (0)
#define G8_LDB(dst, b, h) do { _Pragma("unroll") for (int n = 0; n < 2; ++n) _Pragma("unroll") for (int k = 0; k < 2; ++k) dst[n][k] = *(const LAS bf16x8*)(lds + G8_SB(b, h) + boff + n * 2048 + k * 1024); } while (0)
#define G8_MMA(ai, bj, At, Bt) do { __builtin_amdgcn_s_setprio(1); _Pragma("unroll") for (int m = 0; m < 4; ++m) _Pragma("unroll") for (int n = 0; n < 2; ++n) _Pragma("unroll") for (int k = 0; k < 2; ++k) \
        acc[ai][bj][m][n] = __builtin_amdgcn_mfma_f32_16x16x32_bf16(Bt[n][k], At[m][k], acc[ai][bj][m][n], 0, 0, 0); __builtin_amdgcn_s_setprio(0); } while (0)
#define G8_WAIT_V(n) asm volatile("s_waitcnt vmcnt(" #n ")" ::: "memory")
#define G8_WAIT_L(n) asm volatile("s_waitcnt lgkmcnt(" #n ")" ::: "memory")
#define G8_BAR __builtin_amdgcn_s_barrier()
#define G8_SCHED __builtin_amdgcn_sched_barrier(0)
  Unit cur, nxt; int ui = 0;
  if (!S.next(0, cur)) return;
  unsigned vAc[2][2], vAn[2][2];
  S.voff(cur, Rs, Cs, vAc);
  Acc acc;
#pragma unroll
  for (int a = 0; a < 2; ++a)
#pragma unroll
    for (int b = 0; b < 2; ++b)
#pragma unroll
      for (int m = 0; m < 4; ++m)
#pragma unroll
        for (int n = 0; n < 2; ++n) acc[a][b][m][n] = (f32x4){0.f, 0.f, 0.f, 0.f};
  bf16x8 At[4][2], B0[2][2], B1[2][2];
  const char* cA = cur.A; const char* cB = cur.B;
  G8_STAGE(G8_SB(0, 0), cB, voffB); G8_STAGE(G8_SA(0, 0), cA, vAc[0]); G8_STAGE(G8_SB(0, 1), cB + hstepB, voffB); G8_STAGE(G8_SA(0, 1), cA, vAc[1]);
  if (wr == 1) G8_BAR;
  G8_WAIT_V(4); G8_BAR;
  G8_STAGE(G8_SB(1, 0), cB + kstep, voffB); G8_STAGE(G8_SA(1, 0), cA + kstep, vAc[0]); G8_STAGE(G8_SB(1, 1), cB + hstepB + kstep, voffB);
  G8_WAIT_V(6); G8_BAR;
  for (;;) {
    const bool has_next = S.next(ui + 1, nxt);
    if (has_next) S.voff(nxt, Rs, Cs, vAn);
    else { vAn[0][0] = vAc[0][0]; vAn[0][1] = vAc[0][1]; vAn[1][0] = vAc[1][0]; vAn[1][1] = vAc[1][1]; }
    const char* nA = has_next ? nxt.A : cA; const char* nB = has_next ? nxt.B : cB;
    for (int t = 0; t < nt; t += 2) {
      const bool last = (t == nt - 2);
      const char* a1 = cA + (size_t)(t + 1) * kstep;
      const char* a2 = last ? nA : cA + (size_t)(t + 2) * kstep; const char* b2 = last ? nB : cB + (size_t)(t + 2) * kstep;
      const char* a3 = a2 + kstep; const char* b3 = b2 + kstep;
      unsigned va2[2][2];
      va2[0][0] = last ? vAn[0][0] : vAc[0][0]; va2[0][1] = last ? vAn[0][1] : vAc[0][1]; va2[1][0] = last ? vAn[1][0] : vAc[1][0]; va2[1][1] = last ? vAn[1][1] : vAc[1][1];
      G8_LDB(B0, 0, 0); G8_SCHED; G8_LDA(At, 0, 0); G8_STAGE(G8_SA(1, 1), a1, vAc[1]);
      G8_WAIT_L(8); G8_BAR; G8_WAIT_L(0); G8_MMA(0, 0, At, B0); G8_BAR; G8_SCHED;
      G8_LDB(B1, 0, 1); G8_STAGE(G8_SB(0, 0), b2, voffB);
      G8_BAR; G8_WAIT_L(0); G8_MMA(0, 1, At, B1); G8_BAR;
      G8_LDA(At, 0, 1); G8_STAGE(G8_SA(0, 0), a2, va2[0]);
      G8_BAR; G8_WAIT_L(0); G8_MMA(1, 0, At, B0); G8_BAR; G8_SCHED;
      G8_STAGE(G8_SB(0, 1), b2 + hstepB, voffB);
      G8_WAIT_V(6); G8_BAR; G8_MMA(1, 1, At, B1); G8_BAR;
      G8_LDB(B0, 1, 0); G8_SCHED; G8_LDA(At, 1, 0); G8_STAGE(G8_SA(0, 1), a2, va2[1]);
      G8_WAIT_L(8); G8_BAR; G8_WAIT_L(0); G8_MMA(0, 0, At, B0); G8_BAR; G8_SCHED;
      G8_LDB(B1, 1, 1); G8_STAGE(G8_SB(1, 0), b3, voffB);
      G8_BAR; G8_WAIT_L(0); G8_MMA(0, 1, At, B1); G8_BAR;
      G8_LDA(At, 1, 1); G8_STAGE(G8_SA(1, 0), a3, va2[0]);
      G8_BAR; G8_WAIT_L(0); G8_MMA(1, 0, At, B0); G8_BAR; G8_SCHED;
      G8_STAGE(G8_SB(1, 1), b3 + hstepB, voffB);
      G8_WAIT_V(6); G8_BAR; G8_MMA(1, 1, At, B1); G8_BAR;
    }
    E(acc, cur, wr, wc, fr, fq);
    if (!has_next) break;
    if (!cur.keep) {
#pragma unroll
      for (int a = 0; a < 2; ++a)
#pragma unroll
        for (int b = 0; b < 2; ++b)
#pragma unroll
          for (int m = 0; m < 4; ++m)
#pragma unroll
            for (int n = 0; n < 2; ++n) acc[a][b][m][n] = (f32x4){0.f, 0.f, 0.f, 0.f};
    }
    cur = nxt; cA = nA; cB = nB; ++ui;
    vAc[0][0] = vAn[0][0]; vAc[0][1] = vAn[0][1]; vAc[1][0] = vAn[1][0]; vAc[1][1] = vAn[1][1];
  }
  G8_WAIT_V(0);
  if (wr == 0) G8_BAR;
  G8_BAR;
#undef G8_SA
#undef G8_SB
#undef G8_STAGE
#undef G8_LDA
#undef G8_LDB
#undef G8_MMA
#undef G8_WAIT_V
#undef G8_WAIT_L
#undef G8_BAR
#undef G8_SCHED
}

struct DenseSrc {
  const bf16_t* A; const bf16_t* B; int lda, ldb, nM, nN, G, c;
  __device__ __forceinline__ bool next(int i, Unit& u) const {
    int pm, pn;
    if (!static_tile(i * G + c, nM, nN, pm, pn)) return false;
    u.A = (const char*)(A + (size_t)pm * 256 * lda); u.B = (const char*)(B + (size_t)pn * 256 * ldb); u.pm = pm; u.pn = pn; u.aux = 0; u.keep = 0; u.info = 0;
    return true;
  }
  __device__ __forceinline__ void voff(const Unit&, const int (&R)[2], const int (&C)[2], unsigned (&v)[2][2]) const {
#pragma unroll
    for (int h = 0; h < 2; ++h)
#pragma unroll
      for (int i = 0; i < 2; ++i) v[h][i] = (unsigned)((h * 128 + R[i]) * lda + C[i]) * 2u;
  }
};
struct MergeSrc {
  const bf16_t* A; const bf16_t* B; int nM, G, c;
  __device__ __forceinline__ bool next(int i, Unit& u) const {
    int pm, pn;
    if (!static_tile((i >> 2) * G + c, nM, 4, pm, pn)) return false;
    const int n = i & 3;
    u.A = (const char*)(A + (size_t)pm * 256 * DM + n * 256); u.B = (const char*)(B + ((size_t)n * DM + pn * 256) * 256); u.pm = pm; u.pn = pn; u.aux = n; u.keep = n < 3; u.info = 0;
    return true;
  }
  __device__ __forceinline__ void voff(const Unit&, const int (&R)[2], const int (&C)[2], unsigned (&v)[2][2]) const {
#pragma unroll
    for (int h = 0; h < 2; ++h)
#pragma unroll
      for (int i = 0; i < 2; ++i) v[h][i] = (unsigned)((h * 128 + R[i]) * DM + C[i]) * 2u;
  }
};
__device__ __forceinline__ void moe_build_table(const int* cnt) {
  const int TID = otid();
  int* tb = (int*)(smem + 131072);
  __syncthreads();
  if (TID < 32) tb[TID * 4 + 2] = cnt[TID * 32];
  __syncthreads();
  if (TID < 64) {
    const int lane = TID;
    const int ce = lane < 32 ? tb[lane * 4 + 2] : 0;
    int pre = ce;
#pragma unroll
    for (int o = 1; o < 32; o <<= 1) { const int t = __shfl_up(pre, o); if ((lane & 31) >= o) pre += t; }
    if (lane < 32) tb[lane * 4 + 1] = pre - ce;
    bool asg = lane >= 32 || ce <= 0;
    int gcount = 0, gload = 0;
    for (int it = 0; it < 32; ++it) {
      int key = asg ? -1 : (ce * 64 + (63 - lane));
#pragma unroll
      for (int o = 1; o < 64; o <<= 1) key = max(key, __shfl_xor(key, o));
      if (key < 0) break;
      const int be = 63 - (key & 63), bc = key >> 6;
      int gk = lane < 8 ? (gload * 8 + lane) : 0x7fffffff;
#pragma unroll
      for (int o = 1; o < 8; o <<= 1) gk = min(gk, __shfl_xor(gk, o));
      const int bx = __shfl(gk, 0) & 7;
      if (lane == bx) { int* g = tb + 256 + bx * 80; g[2 + gcount] = be; g[40 + gcount] = gload; gcount += 1; gload += (bc + 255) >> 8; }
      if (lane == be) asg = true;
    }
    if (lane < 8) { tb[256 + lane * 80] = gcount; tb[256 + lane * 80 + 1] = gload; }
  }
  __syncthreads();
}
template <bool GATHER>
struct MoeSrc {
  const int* alist; const bf16_t* A; const bf16_t* B; int lda, ldb, G, c; size_t bexp;
  __device__ __forceinline__ bool next(int i, Unit& u) const {
    const int* tb = (const int*)(smem + 131072);
    const int x = c & 7, j = c >> 3, q = i * (G >> 3) + j, tq = q >> 2, pn = q & 3;
    const int* g = tb + 256 + x * 80;
    if (tq >= __builtin_amdgcn_readfirstlane(g[1])) return false;
    const int ng = __builtin_amdgcn_readfirstlane(g[0]);
    int k = 0;
    for (int kk = 1; kk < ng; ++kk) if (__builtin_amdgcn_readfirstlane(g[40 + kk]) <= tq) k = kk;
    const int e = __builtin_amdgcn_readfirstlane(g[2 + k]), t0 = __builtin_amdgcn_readfirstlane(g[40 + k]);
    const int s0 = __builtin_amdgcn_readfirstlane(tb[e * 4 + 1]), ce = __builtin_amdgcn_readfirstlane(tb[e * 4 + 2]);
    const int r0 = (tq - t0) * 256;
    u.aux = s0 + r0; u.pm = min(256, ce - r0); u.pn = pn; u.keep = 0; u.info = (e << 16) | r0;
    u.A = (const char*)A; u.B = (const char*)(B + (size_t)e * bexp + (size_t)pn * 256 * ldb);
    return true;
  }
  __device__ __forceinline__ void voff(const Unit& u, const int (&R)[2], const int (&C)[2], unsigned (&v)[2][2]) const {
    const int e = u.info >> 16, r0 = u.info & 0xffff;
#pragma unroll
    for (int h = 0; h < 2; ++h)
#pragma unroll
      for (int i = 0; i < 2; ++i) {
        const int r = min(h * 128 + R[i], u.pm - 1);
        const int row = GATHER ? (alist[e * NTOK + r0 + r] >> 1) : (u.aux + r);
        v[h][i] = (unsigned)(row * lda + C[i]) * 2u;
      }
  }
};
#define G8_FOREACH(...)                                                                                           \
  _Pragma("unroll") for (int ai = 0; ai < 2; ++ai) _Pragma("unroll") for (int m = 0; m < 4; ++m) {                  \
    const int trow = ai * 128 + wr * 64 + m * 16 + fr;                                                            \
    _Pragma("unroll") for (int bj = 0; bj < 2; ++bj) _Pragma("unroll") for (int n = 0; n < 2; ++n) {                \
      const int tcol = bj * 128 + wc * 32 + n * 16 + fq * 4;                                                      \
      const f32x4 v = acc[ai][bj][m][n];                                                                          \
      __VA_ARGS__                                                                                                     \
    }                                                                                                             \
  }
#define G8_FOREACH_P(...)                                                                                         \
  _Pragma("unroll") for (int ai = 0; ai < 2; ++ai) _Pragma("unroll") for (int m = 0; m < 4; ++m) {                  \
    const int trow = ai * 128 + wr * 64 + m * 16 + fr;                                                            \
    _Pragma("unroll") for (int bj = 0; bj < 2; ++bj) {                                                              \
      const int tcol8 = bj * 128 + wc * 32 + fq * 8;                                                              \
      const f32x4 v0 = acc[ai][bj][m][0], v1 = acc[ai][bj][m][1];                                                 \
      __VA_ARGS__                                                                                                 \
    }                                                                                                             \
  }
struct EpiF32 {
  float* C; int ldc;
  __device__ __forceinline__ void operator()(Acc& acc, const Unit& u, int wr, int wc, int fr, int fq) const {
    G8_FOREACH({ *(f32x4*)(C + (size_t)(u.pm * 256 + trow) * ldc + u.pn * 256 + tcol) = v; })
  }
};
struct EpiBf16 {
  bf16_t* O; int ldc;
  __device__ __forceinline__ void operator()(Acc& acc, const Unit& u, int wr, int wc, int fr, int fq) const {
    G8_FOREACH({ *(uint2*)(O + (size_t)(u.pm * 256 + trow) * ldc + u.pn * 256 + tcol) = make_uint2(pk2(v.x, v.y), pk2(v.z, v.w)); })
  }
};
struct EpiZmix {
  bf16_t* Z; float* hyT; bf16_t* s5u;
  __device__ __forceinline__ void operator()(Acc& acc, const Unit& u, int wr, int wc, int fr, int fq) const {
    if (u.pn == 11) {
      G8_FOREACH_P({
        const int tok = u.pm * 256 + trow;
        *(uint4*)(s5u + ((size_t)(tcol8 >> 4) * 1280 + (tok >> 4)) * 256 + (tok & 15) * 16 + (tcol8 & 15)) = make_uint4(pk2(v0.x, v0.y), pk2(v0.z, v0.w), pk2(v1.x, v1.y), pk2(v1.z, v1.w));
      })
    } else if (u.pn >= 5 && u.pn <= 7 && u.pm >= 2) {
      G8_FOREACH_P({
        float* d = hyT + (size_t)((u.pn - 5) * 256 + tcol8) * NLAT + (u.pm * 256 + trow - NCTX);
        d[0] = v0.x; d[NLAT] = v0.y; d[2 * NLAT] = v0.z; d[3 * NLAT] = v0.w;
        d[4 * NLAT] = v1.x; d[5 * NLAT] = v1.y; d[6 * NLAT] = v1.z; d[7 * NLAT] = v1.w;
      })
    } else {
      G8_FOREACH_P({ *(uint4*)(Z + (size_t)(u.pm * 256 + trow) * NMIX + u.pn * 256 + tcol8) = make_uint4(pk2(v0.x, v0.y), pk2(v0.z, v0.w), pk2(v1.x, v1.y), pk2(v1.z, v1.w)); })
    }
  }
};
struct EpiGlu {
  bf16_t* O;
  __device__ __forceinline__ void operator()(Acc& acc, const Unit& u, int wr, int wc, int fr, int fq) const {
#pragma unroll
    for (int ai = 0; ai < 2; ++ai)
#pragma unroll
      for (int m = 0; m < 4; ++m) {
        const int trow = ai * 128 + wr * 64 + m * 16 + fr;
#pragma unroll
        for (int bj = 0; bj < 2; ++bj) {
          const f32x4 a = acc[ai][bj][m][0], b = acc[ai][bj][m][1];
          const int oc = (u.pn * 256 + bj * 128 + wc * 32) / 2 + fq * 4;
          *(uint2*)(O + (size_t)(u.pm * 256 + trow) * DM + 768 + oc) =
              make_uint2(pk2(a.x * sigmoidf_(b.x), a.y * sigmoidf_(b.y)), pk2(a.z * sigmoidf_(b.z), a.w * sigmoidf_(b.w)));
        }
      }
  }
};
struct EpiGates {
  bf16_t* gf;
  int tok_lo;
  __device__ __forceinline__ void operator()(Acc& acc, const Unit& u, int wr, int wc, int fr, int fq) const {
    const bool b0 = fq & 1, b1 = fq & 2;
    bf16_t* base = gf + ((size_t)fq * NTOK + tok_lo + u.pm * 256 + wr * 64 + fr) * 1024 + ((u.pn * 256 + wc * 32) >> 2);
#pragma unroll
    for (int ai = 0; ai < 2; ++ai)
#pragma unroll
      for (int m = 0; m < 4; ++m) {
        bf16_t* rowp = base + (size_t)(ai * 128 + m * 16) * 1024;
        asm volatile("" : "+v"(rowp));
#pragma unroll
        for (int bj = 0; bj < 2; ++bj)
#pragma unroll
          for (int n = 0; n < 2; ++n) {
            const f32x4 v = acc[ai][bj][m][n];
            const float e0 = __builtin_amdgcn_exp2f(-1.4426950408889634f * v.x), e1 = __builtin_amdgcn_exp2f(-1.4426950408889634f * v.y);
            const float e2 = __builtin_amdgcn_exp2f(-1.4426950408889634f * v.z), e3 = __builtin_amdgcn_exp2f(-1.4426950408889634f * v.w);
            float F[4];
            F[0] = (1.0f + e1) * __builtin_amdgcn_rcpf(1.0f + e0); F[1] = (1.0f + e2) * __builtin_amdgcn_rcpf(1.0f + e1);
            F[2] = (1.0f + e3) * __builtin_amdgcn_rcpf(1.0f + e2); F[3] = __builtin_amdgcn_rcpf(1.0f + e3);
            const float sa0 = b0 ? F[0] : F[1], sa1 = b0 ? F[2] : F[3];
            const float ra0 = __shfl_xor(sa0, 16), ra1 = __shfl_xor(sa1, 16);
            const float x00 = b0 ? ra0 : F[0], x01 = b0 ? F[1] : ra0, x10 = b0 ? ra1 : F[2], x11 = b0 ? F[3] : ra1;
            const float sb0 = b1 ? x00 : x10, sb1 = b1 ? x01 : x11;
            const float rb0 = __shfl_xor(sb0, 32), rb1 = __shfl_xor(sb1, 32);
            const float y00 = b1 ? rb0 : x00, y01 = b1 ? rb1 : x01, y10 = b1 ? x10 : rb0, y11 = b1 ? x11 : rb1;
            *(uint2*)(rowp + bj * 32 + n * 4) = make_uint2(pk2(y00, y01), pk2(y10, y11));
          }
      }
  }
};
struct EpiMerge {
  const bf16_t* gf;
  bf16_t* O;
  int tok_lo;
  __device__ __forceinline__ void operator()(Acc& acc, const Unit& u, int wr, int wc, int fr, int fq) const {
    const int n = u.aux;
    const bf16_t* gp = gf + ((size_t)n * NTOK + tok_lo + u.pm * 256 + wr * 64 + fr) * 1024 + u.pn * 256 + wc * 32 + fq * 8;
    bf16_t* op = O + (size_t)(u.pm * 256 + wr * 64 + fr) * DM + u.pn * 256 + wc * 32 + fq * 8;
#pragma unroll
    for (int ai = 0; ai < 2; ++ai) {
      const bf16_t* gpa = gp + (size_t)ai * 128 * 1024;
      bf16_t* opa = op + (size_t)ai * 128 * DM;
      asm volatile("" : "+v"(gpa), "+v"(opa));
      uint4 g[4][2];
#pragma unroll
      for (int m = 0; m < 4; ++m)
#pragma unroll
        for (int bj = 0; bj < 2; ++bj) g[m][bj] = *(const uint4*)(gpa + m * 16 * 1024 + bj * 128);
#pragma unroll
      for (int m = 0; m < 4; ++m)
#pragma unroll
        for (int bj = 0; bj < 2; ++bj) {
          const uint4 a = g[m][bj];
          f32x4 v0 = acc[ai][bj][m][0], v1 = acc[ai][bj][m][1];
          v0.x *= __uint_as_float(a.x << 16); v0.y *= __uint_as_float(a.x & 0xffff0000u); v0.z *= __uint_as_float(a.y << 16); v0.w *= __uint_as_float(a.y & 0xffff0000u);
          v1.x *= __uint_as_float(a.z << 16); v1.y *= __uint_as_float(a.z & 0xffff0000u); v1.z *= __uint_as_float(a.w << 16); v1.w *= __uint_as_float(a.w & 0xffff0000u);
          if (n < 3) { acc[ai][bj][m][0] = v0; acc[ai][bj][m][1] = v1; }
          else *(uint4*)(opa + m * 16 * DM + bj * 128) = make_uint4(pk2(v0.x, v0.y), pk2(v0.z, v0.w), pk2(v1.x, v1.y), pk2(v1.z, v1.w));
        }
    }
  }
};
struct EpiWout {
  float* X; const float* mod_l; int tok_lo; const float* Rc; const float* Rx;
  __device__ __forceinline__ void operator()(Acc& acc, const Unit& u, int wr, int wc, int fr, int fq) const {
    const float* grow = mod_l + (size_t)tok_mod_row(tok_lo + u.pm * 256) * 6144 + 2 * 1024 + u.pn * 256 + wc * 32 + fq * 4;
    f32x4 g[2][2];
#pragma unroll
    for (int bj = 0; bj < 2; ++bj)
#pragma unroll
      for (int n = 0; n < 2; ++n) g[bj][n] = *(const f32x4*)(grow + bj * 128 + n * 16);
#pragma unroll
    for (int ai = 0; ai < 2; ++ai)
#pragma unroll
      for (int mh = 0; mh < 2; ++mh) {
        f32x4 xv[2][2][2];
#pragma unroll
        for (int m2 = 0; m2 < 2; ++m2)
#pragma unroll
          for (int bj = 0; bj < 2; ++bj)
#pragma unroll
            for (int n = 0; n < 2; ++n)
              xv[m2][bj][n] = *(const f32x4*)(((tok_lo + u.pm * 256) < NCTX ? Rc : Rx) + (size_t)(u.pm * 256 + ai * 128 + wr * 64 + (mh * 2 + m2) * 16 + fr) * DM + u.pn * 256 + bj * 128 + wc * 32 + n * 16 + fq * 4);
#pragma unroll
        for (int m2 = 0; m2 < 2; ++m2)
#pragma unroll
          for (int bj = 0; bj < 2; ++bj)
#pragma unroll
            for (int n = 0; n < 2; ++n)
              *(f32x4*)(X + (size_t)(u.pm * 256 + ai * 128 + wr * 64 + (mh * 2 + m2) * 16 + fr) * DM + u.pn * 256 + bj * 128 + wc * 32 + n * 16 + fq * 4) =
                  xv[m2][bj][n] + g[bj][n] * acc[ai][bj][mh * 2 + m2][n];
      }
  }
};
struct EpiMoe1 {
  bf16_t* hid;
  __device__ __forceinline__ void operator()(Acc& acc, const Unit& u, int wr, int wc, int fr, int fq) const {
#pragma unroll
    for (int ai = 0; ai < 2; ++ai)
#pragma unroll
      for (int m = 0; m < 4; ++m) {
        const int trow = ai * 128 + wr * 64 + m * 16 + fr;
        if (trow < u.pm) {
#pragma unroll
          for (int bj = 0; bj < 2; ++bj) {
            const f32x4 a = acc[ai][bj][m][0], b = acc[ai][bj][m][1];
            const int oc = (u.pn * 256 + bj * 128 + wc * 32) / 2 + fq * 4;
            *(uint2*)(hid + (size_t)(u.aux + trow) * 512 + oc) = make_uint2(pk2(siluf_(a.x) * b.x, siluf_(a.y) * b.y), pk2(siluf_(a.z) * b.z, siluf_(a.w) * b.w));
          }
        }
      }
  }
};
struct EpiMoe2 {
  bf16_t* ybuf; const float* rw; const int* alist; int* aslot;
  __device__ __forceinline__ void operator()(Acc& acc, const Unit& u, int wr, int wc, int fr, int fq) const {
    const int e = u.info >> 16, r0 = u.info & 0xffff;
    int as[2][4]; float ws[2][4];
#pragma unroll
    for (int ai = 0; ai < 2; ++ai)
#pragma unroll
      for (int m = 0; m < 4; ++m) { const int trow = ai * 128 + wr * 64 + m * 16 + fr; as[ai][m] = alist[e * NTOK + r0 + min(trow, u.pm - 1)]; }
#pragma unroll
    for (int ai = 0; ai < 2; ++ai)
#pragma unroll
      for (int m = 0; m < 4; ++m) ws[ai][m] = rw[as[ai][m]];
#pragma unroll
    for (int ai = 0; ai < 2; ++ai)
#pragma unroll
      for (int m = 0; m < 4; ++m) {
        const int trow = ai * 128 + wr * 64 + m * 16 + fr;
        if (trow < u.pm) {
          if (u.pn == 0 && wc == 0 && fq == 0) aslot[as[ai][m]] = u.aux + trow;
          bf16_t* yrow = ybuf + (size_t)(u.aux + trow) * DM + u.pn * 256 + wc * 32 + fq * 8;
#pragma unroll
          for (int bj = 0; bj < 2; ++bj) {
            const f32x4 v0 = acc[ai][bj][m][0] * ws[ai][m], v1 = acc[ai][bj][m][1] * ws[ai][m];
            *(uint4*)(yrow + bj * 128) = make_uint4(pk2(v0.x, v0.y), pk2(v0.z, v0.w), pk2(v1.x, v1.y), pk2(v1.z, v1.w));
          }
        }
      }
  }
};
struct S5Src {
  const bf16_t* U; const bf16_t* XS; const bf16_t* M1; const bf16_t* M2; int two, G, c;
  __device__ __forceinline__ bool next(int i, Unit& u) const {
    const int L = (two ? (i >> 1) : i) * G + c;
    if (L >= 80) return false;
    const int g = L / 5, rt = L % 5, sub = two ? (i & 1) : 0;
    u.A = (const char*)((sub ? XS : U) + ((size_t)g * 1280 + rt * 256) * 256);
    u.B = (const char*)((sub ? M2 : M1) + (size_t)g * 65536);
    u.pm = rt; u.pn = 0; u.aux = g; u.keep = two && sub == 0; u.info = sub;
    return true;
  }
  __device__ __forceinline__ void voff(const Unit&, const int (&R)[2], const int (&C)[2], unsigned (&v)[2][2]) const {
#pragma unroll
    for (int h = 0; h < 2; ++h)
#pragma unroll
      for (int i = 0; i < 2; ++i) v[h][i] = (unsigned)((h * 128 + R[i]) * 256 + C[i]) * 2u;
  }
};
struct EpiS5X {
  float* X;
  __device__ __forceinline__ void operator()(Acc& acc, const Unit& u, int wr, int wc, int fr, int fq) const {
    G8_FOREACH({ *(f32x4*)(X + ((size_t)u.aux * 1280 + u.pm * 256 + trow) * 256 + tcol) = v; })
  }
};
struct EpiS5Y {
  bf16_t* s5g;
  __device__ __forceinline__ void operator()(Acc& acc, const Unit& u, int wr, int wc, int fr, int fq) const {
    if (u.info == 0) return;
    G8_FOREACH({
      const int row = u.pm * 256 + trow;
      if (row < NTOK / 16) {
        const int tok = row * 16 + (tcol >> 4);
        *(uint2*)(s5g + (size_t)tok * 256 + u.aux * 16 + (tcol & 15)) = make_uint2(pk2(gelu_tanh(v.x), gelu_tanh(v.y)), pk2(gelu_tanh(v.z), gelu_tanh(v.w)));
      }
    })
  }
};
}

__device__ __forceinline__ void ph_gemm_s5_pass1(const Params& p, int l) {
  g8::S5Src S{p.s5u(), p.sXS(), p.s5Nn() + (size_t)l * 16 * 65536, p.s5Nn(), 0, (int)gridDim.x, (int)blockIdx.x};
  g8::EpiS5X E{p.sX()};
  g8::gemm_stream((LAS unsigned char*)smem, S, E, 256, 256);
}
__device__ __forceinline__ void ph_gemm_s5_pass2(const Params& p, int l) {
  g8::S5Src S{p.s5u(), p.sXS(), p.s5Tz() + (size_t)l * 16 * 65536, p.s5Mm() + (size_t)l * 16 * 65536, 1, (int)gridDim.x, (int)blockIdx.x};
  g8::EpiS5Y E{p.s5g()};
  g8::gemm_stream((LAS unsigned char*)smem, S, E, 256, 256);
}
__device__ __forceinline__ void ph_gemm_zmix(const Params& p, int l) {
  g8::DenseSrc S{p.hbf(), p.WinT() + (size_t)l * NIN * DM, DM, DM, NTOK / 256, NMIX / 256, (int)gridDim.x, (int)blockIdx.x};
  g8::EpiZmix E{p.zmix(), p.hyT(), p.s5u()};
  g8::gemm_stream((LAS unsigned char*)smem, S, E, DM, DM);
}
__device__ __forceinline__ void ph_gemm_gates_glu(const Params& p, int l, int tok_lo) {
  const int nM = (NTOK - tok_lo) / 256;
  {
    g8::DenseSrc S{p.hbf() + (size_t)tok_lo * DM, p.WinT() + ((size_t)l * NIN + NMIX) * DM, DM, DM, nM, 16, (int)gridDim.x, (int)blockIdx.x};
    g8::EpiGates E{p.gates(), tok_lo};
    g8::gemm_stream((LAS unsigned char*)smem, S, E, DM, DM);
  }
  {
    g8::DenseSrc S{p.s5g() + (size_t)tok_lo * 256, p.GluT() + (size_t)l * 512 * 256, 256, 256, nM, 2, (int)gridDim.x, (int)blockIdx.x};
    g8::EpiGlu E{p.br() + (size_t)tok_lo * DM};
    g8::gemm_stream((LAS unsigned char*)smem, S, E, 256, 256);
  }
}
__device__ __forceinline__ void ph_gemm_merge(const Params& p, int l, int tok_lo) {
  g8::MergeSrc S{p.br() + (size_t)tok_lo * DM, p.WbrT() + (size_t)l * 4 * DM * 256, (NTOK - tok_lo) / 256, (int)gridDim.x, (int)blockIdx.x};
  g8::EpiMerge E{p.gates(), p.merged() + (size_t)tok_lo * DM, tok_lo};
  g8::gemm_stream((LAS unsigned char*)smem, S, E, 256, 256);
}
__device__ __forceinline__ void ph_gemm_wout(const Params& p, int l, int tok_lo) {
  g8::DenseSrc S{p.merged() + (size_t)tok_lo * DM, p.WoutT() + (size_t)l * DM * DM, DM, DM, (NTOK - tok_lo) / 256, 4, (int)gridDim.x, (int)blockIdx.x};
  g8::EpiWout E{p.xbuf() + (size_t)tok_lo * DM, p.mod() + (size_t)l * 3 * 6144, tok_lo,
                l == 0 ? p.in[I_CTX] : p.xbuf() + (size_t)tok_lo * DM, l == 0 ? p.in[I_X] - (size_t)NCTX * DM : p.xbuf() + (size_t)tok_lo * DM};
  g8::gemm_stream((LAS unsigned char*)smem, S, E, DM, DM);
}
__device__ __forceinline__ void ph_gemm_moe1(const Params& p, int l) {
  g8::moe_build_table(p.cnt() + l * 32 * 32);
  g8::MoeSrc<true> S{p.alist(), p.hbf(), p.W13T(), DM, DM, (int)gridDim.x, (int)blockIdx.x, (size_t)DM * DM};
  g8::EpiMoe1 E{p.hid()};
  g8::gemm_stream((LAS unsigned char*)smem, S, E, DM, DM);
}
__device__ __forceinline__ void ph_gemm_moe2(const Params& p, int l) {
  g8::moe_build_table(p.cnt() + l * 32 * 32);
  g8::MoeSrc<false> S{p.alist(), p.hid(), p.W2T(), 512, 512, (int)gridDim.x, (int)blockIdx.x, (size_t)DM * 512};
  g8::EpiMoe2 E{p.ybuf(), p.rw(), p.alist(), p.aslot()};
  g8::gemm_stream((LAS unsigned char*)smem, S, E, 512, 512);
}

template <int l>
__device__ __forceinline__ void layer_body(const Params& p, const XcdBarrier& xb) {
    const int lo = (l == 1) ? NCTX : 0;
    ph_norm1(p, l);
    xcd_barrier(xb);
    ph_gemm_zmix(p, l);
    xcd_barrier(xb);
    for (int t = blockIdx.x; t < 256; t += gridDim.x) hyena_fft_task(p, l, t);
    if (l == 0) for (int t = blockIdx.x; t < 512; t += gridDim.x) hyena_task(p, l, CTXL, 0, t >> 8, t & 255, p.hrawc(), p.hscalec());
    __syncthreads();
    ph_mix_tasks<false>(p, l);
    __syncthreads();
    ph_gemm_s5_pass1(p, l);
    xcd_barrier(xb);
    ph_scan(p, l);
    ph_s5_scan(p, l);
    xcd_barrier(xb);
    ph_mix_tasks<true>(p, l);
    __syncthreads();
    ph_gemm_s5_pass2(p, l);
    xcd_barrier(xb);
    ph_reads(p, l, lo);
    xcd_barrier(xb);
    ph_cvt_moe(p, l);
    __syncthreads();
    ph_gemm_gates_glu(p, l, lo);
    xcd_barrier(xb);
    ph_gemm_merge(p, l, lo);
    xcd_barrier(xb);
    ph_gemm_wout(p, l, lo);
    xcd_barrier(xb);
    ph_router(p, l, lo);
    xcd_barrier(xb);
    ph_gemm_moe1(p, l);
    xcd_barrier(xb);
    ph_gemm_moe2(p, l);
    xcd_barrier(xb);
}

__global__ void __launch_bounds__(NTHREADS) mega(Params p) {
  cg::grid_group grid = cg::this_grid();
  volatile LAS unsigned* st = (volatile LAS unsigned*)((LAS unsigned char*)smem + LDS_FFT_BYTES);
  if (threadIdx.x == 0) { st[0] = 0u; st[1] = 0u; st[2] = 0u; st[3] = 0u; }
  __syncthreads();
  const XcdBarrier xb = xcd_barrier_post(p.xbar(), st);
  ph_setup1(p);
  ph_cvt_static(p);
  grid.sync();
  ph_setup2(p);
  __syncthreads();
  ph_setup_s5(p);
  xcd_barrier(xb);
  layer_body<0>(p, xb);
  layer_body<1>(p, xb);
  ph_final(p);
}

static inline size_t al256(size_t x) { return (x + 255) & ~(size_t)255; }

extern "C" void kernel_launch(void* const* d_in, const int* in_sizes, int n_in, void* d_out, int out_size, void* d_ws, size_t ws_size,
                              hipStream_t stream) {
  static int grid_blocks = 0;
  if (grid_blocks == 0) {
    int dev = 0, cus = 0, per_cu = 0;
    (void)hipGetDevice(&dev);
    (void)hipDeviceGetAttribute(&cus, hipDeviceAttributeMultiprocessorCount, dev);
    (void)hipFuncSetAttribute((const void*)mega, hipFuncAttributeMaxDynamicSharedMemorySize, LDS_BYTES);
    (void)hipOccupancyMaxActiveBlocksPerMultiprocessor(&per_cu, (const void*)mega, NTHREADS, LDS_BYTES);
    if (per_cu < 1) { fprintf(stderr, "kernel_launch: occupancy query says %d blocks/CU\n", per_cu); per_cu = 1; }
    if (per_cu > 1) per_cu = 1;
    grid_blocks = cus * per_cu;
  }
  Params p{};
  for (int i = 0; i < N_INPUTS; ++i) p.in[i] = (const float*)d_in[i];
  p.out = (float*)d_out;
  p.ws = (char*)d_ws;
  if (WS.total > ws_size) { fprintf(stderr, "kernel_launch: workspace too small: need %zu have %zu\n", (size_t)WS.total, ws_size); return; }
  (void)hipMemsetAsync(p.ws + WS.xbar, 0, XCD_BAR_WORDS * 4, stream);
  void* args[] = {&p};
  hipError_t e = hipLaunchCooperativeKernel((const void*)mega, dim3(grid_blocks), dim3(NTHREADS), args, LDS_BYTES, stream);
  if (e != hipSuccess) fprintf(stderr, "kernel_launch: cooperative launch failed: %s (grid %d)\n", hipGetErrorString(e), grid_blocks);
}
```

```cpp
#include <hip/hip_runtime.h>
#include <hip/hip_cooperative_groups.h>
#include <stdint.h>
#include <stdio.h>
namespace cg = cooperative_groups;

typedef unsigned short bf16_t;
typedef short bf16x8 __attribute__((ext_vector_type(8)));
typedef float f32x4 __attribute__((ext_vector_type(4)));
typedef unsigned u32x4 __attribute__((ext_vector_type(4)));
typedef float f32x16 __attribute__((ext_vector_type(16)));

#define DM 1024
#define NTOK 16896
#define NCTX 512
#define NLAT 16384
#define SEQL 8192
#define CTXL 256
#define NIN 7168
#define NMIX 3072
#define NSTEP 8448
#define EPSF 1e-6f
#define NCHUNK 132
#define FFT_N 16384
#define NTHREADS 512
#define NWAVES 8
#define LDS_FFT_BYTES 139264
#define LDS_BYTES (LDS_FFT_BYTES + 16)

#define C_HGQ 0
#define C_HGF 256
#define C_HGI 768
#define C_HGG 1024
#define C_HY 1280
#define C_RQ 2048
#define C_RK 2176
#define C_RV 2304
#define C_RG 2560
#define C_S5 2816

enum { I_X = 0, I_C, I_CTX, I_CCTX, I_WMOD, I_BMOD, I_NORM1, I_NORM2, I_WIN, I_HGLB, I_HGNORM, I_HYCW, I_HYCB, I_HYW1, I_HYB1, I_HYF1,
       I_HYW2, I_HYB2, I_HYF2, I_HYW3, I_HYSKIP, I_RETDEC, I_RETNORM, I_S5LRE, I_S5LIM, I_S5LDT, I_S5BRE, I_S5BIM, I_S5CRE, I_S5CIM,
       I_S5D, I_GLU1, I_GLU2, I_WBR, I_WOUT, I_WGRP, I_BGRP, I_WEXP, I_BEXP, I_MW1, I_MW3, I_MW2, I_NORMF, N_INPUTS };

constexpr size_t al256c(size_t x) { return (x + 255) & ~(size_t)255; }
struct WsLayout { size_t aslot, xbuf, hbf, zmix, rope, hgo, rto, s5o, br, s5g, mod, modpart, lb, s5a, s5b, hraw, hrawc, hscale, hscalec, twid, hgU, hgD, rtU, s5u, sX, sXS, s5Tz, s5Nn, s5Mm, WinT, WbrT, WoutT, GluT, xbar, cnt, mflag, alist, rw, rsel, total; };
constexpr WsLayout make_ws_layout() {
  WsLayout L{}; size_t off = 0;
  L.aslot = off; off = al256c(off + (size_t)NTOK * 2 * 4);
  L.xbuf = off; off = al256c(off + (size_t)NTOK * DM * 4);
  L.hbf = off; off = al256c(off + (size_t)NTOK * DM * 2);
  L.zmix = off; off = al256c(off + (size_t)NTOK * 4096 * 2);
  L.rope = off; off = al256c(off + 128 * 8 * 2 * 4);
  L.hgo = off; off = al256c(off + (size_t)2 * NTOK * 256 * 4);
  L.rto = off; off = al256c(off + (size_t)2 * NTOK * 256 * 4);
  L.s5o = off; off = al256c(off + (size_t)2 * NTOK * 256 * 4);
  L.br = off; off = al256c(off + (size_t)NTOK * DM * 2);
  L.s5g = off; off = al256c(off + (size_t)NTOK * 256 * 2);
  L.mod = off; off = al256c(off + (size_t)2 * 3 * 6144 * 4);
  L.modpart = off; off = al256c(off + (size_t)8 * 2 * 3 * 6144 * 4);
  L.lb = off; off = al256c(off + 1024 * 4);
  L.s5a = off; off = al256c(off + 4096 * 2 * 4);
  L.s5b = off; off = al256c(off + 4096 * 16 * 2 * 4);
  L.hraw = off; off = al256c(off + (size_t)2 * 2 * 256 * SEQL * 4);
  L.hrawc = off; off = al256c(off + (size_t)2 * 256 * CTXL * 4);
  L.hscale = off; off = al256c(off + 512 * 4);
  L.hscalec = off; off = al256c(off + 256 * 4);
  L.twid = off; off = al256c(off + (size_t)FFT_N * 2 * 4);
  L.hgU = off; off = al256c(off + (size_t)16 * NCHUNK * 4096 * 4);
  L.hgD = off; off = al256c(off + (size_t)16 * NCHUNK * 64 * 4);
  L.rtU = off; off = al256c(off + (size_t)16 * NCHUNK * 2048 * 4);
  L.s5u = off; off = al256c(off + (size_t)16 * 1280 * 256 * 2);
  L.sX = off; off = al256c(off + (size_t)16 * 1280 * 256 * 4);
  L.sXS = off; off = al256c(off + (size_t)16 * 1280 * 256 * 2);
  L.s5Tz = off; off = al256c(off + (size_t)32 * 65536 * 2);
  L.s5Nn = off; off = al256c(off + (size_t)32 * 65536 * 2);
  L.s5Mm = off; off = al256c(off + (size_t)32 * 65536 * 2);
  L.WinT = off; off = al256c(off + (size_t)2 * NIN * DM * 2);
  L.WbrT = off; off = al256c(off + (size_t)2 * 4 * DM * 256 * 2);
  L.WoutT = off; off = al256c(off + (size_t)2 * DM * DM * 2);
  L.GluT = off; off = al256c(off + (size_t)2 * 512 * 256 * 2);
  L.xbar = off; off = al256c(off + 3456 * 4);
  L.cnt = off; off = al256c(off + 64 * 32 * 4);
  L.mflag = off; off = al256c(off + (2 * 2048 + 256) * 4);
  L.alist = off; off = al256c(off + (size_t)32 * NTOK * 4);
  L.rw = off; off = al256c(off + (size_t)NTOK * 2 * 4);
  L.rsel = off; off = al256c(off + (size_t)NTOK * 4 * 4);
  L.total = off; return L;
}
constexpr WsLayout WS = make_ws_layout();
struct Params {
  const float* in[N_INPUTS];
  float* out;
  char* ws;
  __device__ __forceinline__ int* aslot() const { return (int*)(ws + WS.aslot); }
  __device__ __forceinline__ int* mflag() const { return (int*)(ws + WS.mflag); }
  __device__ __forceinline__ float* xbuf() const { return (float*)(ws + WS.xbuf); }
  __device__ __forceinline__ bf16_t* hbf() const { return (bf16_t*)(ws + WS.hbf); }
  __device__ __forceinline__ bf16_t* zmix() const { return (bf16_t*)(ws + WS.zmix); }
  __device__ __forceinline__ float* rope() const { return (float*)(ws + WS.rope); }
  __device__ __forceinline__ float* hgo() const { return (float*)(ws + WS.hgo); }
  __device__ __forceinline__ float* rto() const { return (float*)(ws + WS.rto); }
  __device__ __forceinline__ float* s5o() const { return (float*)(ws + WS.s5o); }
  __device__ __forceinline__ bf16_t* br() const { return (bf16_t*)(ws + WS.br); }
  __device__ __forceinline__ bf16_t* s5g() const { return (bf16_t*)(ws + WS.s5g); }
  __device__ __forceinline__ float* mod() const { return (float*)(ws + WS.mod); }
  __device__ __forceinline__ float* modpart() const { return (float*)(ws + WS.modpart); }
  __device__ __forceinline__ float* lb() const { return (float*)(ws + WS.lb); }
  __device__ __forceinline__ float* s5a() const { return (float*)(ws + WS.s5a); }
  __device__ __forceinline__ float* s5b() const { return (float*)(ws + WS.s5b); }
  __device__ __forceinline__ float* hraw() const { return (float*)(ws + WS.hraw); }
  __device__ __forceinline__ float* hrawc() const { return (float*)(ws + WS.hrawc); }
  __device__ __forceinline__ float* hscale() const { return (float*)(ws + WS.hscale); }
  __device__ __forceinline__ float* hscalec() const { return (float*)(ws + WS.hscalec); }
  __device__ __forceinline__ float* twid() const { return (float*)(ws + WS.twid); }
  __device__ __forceinline__ float* hgU() const { return (float*)(ws + WS.hgU); }
  __device__ __forceinline__ float* hgD() const { return (float*)(ws + WS.hgD); }
  __device__ __forceinline__ float* rtU() const { return (float*)(ws + WS.rtU); }
  __device__ __forceinline__ bf16_t* s5u() const { return (bf16_t*)(ws + WS.s5u); }
  __device__ __forceinline__ float* sX() const { return (float*)(ws + WS.sX); }
  __device__ __forceinline__ bf16_t* sXS() const { return (bf16_t*)(ws + WS.sXS); }
  __device__ __forceinline__ bf16_t* s5Tz() const { return (bf16_t*)(ws + WS.s5Tz); }
  __device__ __forceinline__ bf16_t* s5Nn() const { return (bf16_t*)(ws + WS.s5Nn); }
  __device__ __forceinline__ bf16_t* s5Mm() const { return (bf16_t*)(ws + WS.s5Mm); }
  __device__ __forceinline__ bf16_t* WinT() const { return (bf16_t*)(ws + WS.WinT); }
  __device__ __forceinline__ bf16_t* WbrT() const { return (bf16_t*)(ws + WS.WbrT); }
  __device__ __forceinline__ bf16_t* WoutT() const { return (bf16_t*)(ws + WS.WoutT); }
  __device__ __forceinline__ bf16_t* GluT() const { return (bf16_t*)(ws + WS.GluT); }
  __device__ __forceinline__ unsigned* xbar() const { return (unsigned*)(ws + WS.xbar); }
  __device__ __forceinline__ int* cnt() const { return (int*)(ws + WS.cnt); }
  __device__ __forceinline__ int* alist() const { return (int*)(ws + WS.alist); }
  __device__ __forceinline__ float* rw() const { return (float*)(ws + WS.rw); }
  __device__ __forceinline__ float* rsel() const { return (float*)(ws + WS.rsel); }
  __device__ __forceinline__ bf16_t* merged() const { return (bf16_t*)(ws + WS.hbf + 0); }
  __device__ __forceinline__ float* hyT() const { return (float*)(ws + WS.hgo + 0); }
  __device__ __forceinline__ float* hspec() const { return (float*)(ws + WS.s5o + 0); }
  __device__ __forceinline__ bf16_t* W13T() const { return (bf16_t*)(ws + WS.hgo + 0); }
  __device__ __forceinline__ bf16_t* W2T() const { return (bf16_t*)(ws + WS.hgo + (size_t)32 * DM * DM * 2); }
  __device__ __forceinline__ bf16_t* gates() const { return (bf16_t*)(ws + WS.zmix + 0); }
  __device__ __forceinline__ bf16_t* hid() const { return (bf16_t*)(ws + WS.zmix + 0); }
  __device__ __forceinline__ bf16_t* ybuf() const { return (bf16_t*)(ws + WS.zmix + al256c((size_t)NTOK * 2 * 512 * 2)); }
};

extern __shared__ __attribute__((aligned(16))) unsigned char smem[];

typedef float f32x2 __attribute__((ext_vector_type(2)));
typedef __bf16 bf16x2_t __attribute__((ext_vector_type(2)));
__device__ __forceinline__ unsigned pk2(float a, float b) { const f32x2 v = {a, b}; return __builtin_bit_cast(unsigned, __builtin_convertvector(v, bf16x2_t)); }
__device__ __forceinline__ bf16_t f2bf(float f) { return (bf16_t)(pk2(f, 0.f) & 0xffffu); }
__device__ __forceinline__ float bflo(unsigned u) { return __uint_as_float(u << 16); }
__device__ __forceinline__ float bfhi(unsigned u) { return __uint_as_float(u & 0xffff0000u); }
__device__ __forceinline__ float bf2f(bf16_t b) { return __uint_as_float(((unsigned)b) << 16); }
__device__ __forceinline__ float sigmoidf_(float x) { return 1.0f / (1.0f + expf(-x)); }
__device__ __forceinline__ float siluf_(float x) { return x / (1.0f + expf(-x)); }
__device__ __forceinline__ float gelu_tanh(float x) {
  float u = 0.7978845608028654f * (x + 0.044715f * x * x * x);
  return 0.5f * x * (1.0f + tanhf(u));
}
__device__ __forceinline__ float wave_sum(float v) {
#pragma unroll
  for (int o = 1; o < 64; o <<= 1) v += __shfl_xor(v, o);
  return v;
}
__device__ __forceinline__ int tok_mod_row(int tok) { return tok < NCTX ? 2 : ((tok - NCTX) >> 13); }
__device__ __forceinline__ int scan_tok(int s, int dir, int b) {
  if (s < CTXL) return b * CTXL + (dir ? (CTXL - 1 - s) : s);
  int u = s - CTXL;
  return NCTX + b * SEQL + (dir ? (SEQL - 1 - u) : u);
}
__device__ __forceinline__ int otid() { int t = threadIdx.x; asm volatile("" : "+v"(t)); return t; }
#define LDS_FENCE() asm volatile("s_waitcnt lgkmcnt(0)" ::: "memory")


#define XB_TMO      128
#define XB_XCNT(j)  (256  + 64 * (j))
#define XB_XSUB(j)  (1280 + 64 * (j))
#define XB_XGEN(j)  (2304 + 64 * (j))
#define XB_TOP      3328
#define XB_TOPGEN   3392
#define XCD_BAR_WORDS 3456
#define XB_SPIN_CAP (1u << 20)
#define LAS __attribute__((address_space(3)))
__device__ __forceinline__ unsigned xb_ld(unsigned* p)              { return __hip_atomic_load(p, __ATOMIC_RELAXED, __HIP_MEMORY_SCOPE_AGENT); }
__device__ __forceinline__ unsigned xb_add(unsigned* p, unsigned v) { return __hip_atomic_fetch_add(p, v, __ATOMIC_RELAXED, __HIP_MEMORY_SCOPE_AGENT); }
__device__ __forceinline__ unsigned xb_xcc_id() { return (unsigned)__builtin_amdgcn_s_getreg((3 << 11) | 20) & 0xFu; }
#define XB_SPIN(cond, bar) do { unsigned _sp = 0; while (cond) { __builtin_amdgcn_s_sleep(1); \
    if ((++_sp & 255u) == 0u) { if (xb_ld(&(bar)[XB_TMO])) break; if (_sp > XB_SPIN_CAP) { atomicAdd(&(bar)[XB_TMO], 1u); break; } } } } while (0)
struct XcdBarrier { unsigned* bar; unsigned x; volatile LAS unsigned* st; };
__device__ __forceinline__ XcdBarrier xcd_barrier_post(unsigned* bar, volatile LAS unsigned* st) {
  XcdBarrier b; b.bar = bar; b.x = xb_xcc_id(); b.st = st;
  if (threadIdx.x == 0) (void)xb_add(&bar[XB_XCNT(b.x)], 1u);
  return b;
}
__device__ __forceinline__ void xcd_barrier_complete(unsigned* bar, unsigned x, unsigned& nloc, unsigned& nx) {
  const unsigned G = gridDim.x * gridDim.y * gridDim.z;
  unsigned sum, cnt, mine, sp = 0u;
  for (;;) {
    sum = 0u; cnt = 0u; mine = 0u;
#pragma unroll
    for (unsigned j = 0; j < 16; ++j) { const unsigned c = xb_ld(&bar[XB_XCNT(j)]); sum += c; cnt += (c > 0u) ? 1u : 0u; mine = (j == x) ? c : mine; }
    if (sum == G) break;
    __builtin_amdgcn_s_sleep(1);
    if ((++sp & 255u) == 0u) { if (xb_ld(&bar[XB_TMO])) break; if (sp > XB_SPIN_CAP) { atomicAdd(&bar[XB_TMO], 1u); break; } }
  }
  nloc = mine > 0u ? mine : 1u; nx = cnt > 0u ? cnt : 1u;
}
__device__ __forceinline__ void xcd_barrier(const XcdBarrier& b) {
  asm volatile("s_waitcnt vmcnt(0)" ::: "memory");
  __syncthreads();
  if (threadIdx.x == 0) {
    unsigned* bar = b.bar;
    __builtin_amdgcn_s_waitcnt(0);
    unsigned nloc = b.st[0], nx = b.st[1];
    if (nloc == 0u) { xcd_barrier_complete(bar, b.x, nloc, nx); b.st[0] = nloc; b.st[1] = nx; }
    const unsigned old = xb_add(&bar[XB_XSUB(b.x)], 1u);
    const unsigned gen = old / nloc;
    if (old + 1u == (gen + 1u) * nloc) {
      __builtin_amdgcn_fence(__ATOMIC_RELEASE, "agent");
      asm volatile("s_waitcnt vmcnt(0)" ::: "memory");
      const unsigned og = xb_add(&bar[XB_TOP], 1u);
      const unsigned tg = og / nx;
      if (og + 1u == (tg + 1u) * nx) xb_add(&bar[XB_TOPGEN], 1u);
      else XB_SPIN(xb_ld(&bar[XB_TOPGEN]) == tg, bar);
      __builtin_amdgcn_fence(__ATOMIC_ACQUIRE, "agent");
      xb_add(&bar[XB_XGEN(b.x)], 1u);
      asm volatile("s_waitcnt vmcnt(0)" ::: "memory");
    } else {
      XB_SPIN(xb_ld(&bar[XB_XGEN(b.x)]) == gen, bar);
      __builtin_amdgcn_fence(__ATOMIC_ACQUIRE, "agent");
      asm volatile("s_waitcnt vmcnt(0)" ::: "memory");
    }
  }
  __syncthreads();
}

__device__ __forceinline__ void ph_setup1(const Params& p) {
  const int TID = otid();
  const int tid = TID, lane = tid & 63, wave = tid >> 6;
  const int gtid = blockIdx.x * NTHREADS + tid;
  const int gw = blockIdx.x * NWAVES + wave, nw = gridDim.x * NWAVES;
  float* sc = (float*)smem;
  for (int i = tid; i < 3072; i += NTHREADS) {
    int r = i >> 10, k = i & 1023;
    float v = r < 2 ? p.in[I_C][r * 1024 + k] : p.in[I_CCTX][k];
    sc[i] = siluf_(v);
  }
  __syncthreads();
  if (gtid < 64) p.cnt()[gtid * 32] = 0;
  if (gtid < 4352) p.mflag()[gtid] = 0;
  if (gtid < 1024) { const int pos = gtid >> 3, j = gtid & 7; double sn, cs; sincos((double)pos * pow(10000.0, -(double)j / 8.0), &sn, &cs); p.rope()[gtid * 2] = (float)cs; p.rope()[gtid * 2 + 1] = (float)sn; }
  if (gtid < FFT_N) { float sn, cs; sincospif(-(float)gtid * (2.0f / (float)FFT_N), &sn, &cs); p.twid()[gtid * 2] = cs; p.twid()[gtid * 2 + 1] = sn; }
  if (gtid < 1024) {
    int l = gtid >> 9, dc = gtid & 511;
    float v = 0.f;
    if (l == 1) { float l0 = p.in[I_HGLB][dc], l1 = p.in[I_HGLB][512 + dc]; v = 1.0f / (1.0f + expf(l0 - l1)); }
    p.lb()[gtid] = v;
  }
  if (gtid < 4096) {
    double lr = fmin((double)p.in[I_S5LRE][gtid], -1e-4), li = (double)p.in[I_S5LIM][gtid];
    double dt = exp((double)p.in[I_S5LDT][gtid >> 6]);
    double mag = exp(lr * dt), sn, cs;
    sincos(li * dt, &sn, &cs);
    double are = mag * cs, aim = mag * sn;
    double den = lr * lr + li * li;
    double cr = ((are - 1.0) * lr + aim * li) / den, ci = (aim * lr - (are - 1.0) * li) / den;
    p.s5a()[gtid * 2] = (float)are; p.s5a()[gtid * 2 + 1] = (float)aim;
    for (int c = 0; c < 16; ++c) {
      double br = p.in[I_S5BRE][gtid * 16 + c], bi = p.in[I_S5BIM][gtid * 16 + c];
      p.s5b()[(gtid * 16 + c) * 2] = (float)(cr * br - ci * bi);
      p.s5b()[(gtid * 16 + c) * 2 + 1] = (float)(cr * bi + ci * br);
    }
  }
  for (int t = gw; t < 2 * 96 * 8; t += nw) {
    const int kp = t & 7, cgp = (t >> 3) % 96, l = t / (8 * 96);
    const int col = cgp * 64 + lane;
    const float* w = p.in[I_WMOD] + ((size_t)l * 1024 + kp * 128) * 6144 + col;
    float a0 = 0.f, a1 = 0.f, a2 = 0.f;
#pragma unroll 8
    for (int k = 0; k < 128; ++k) {
      float wv = w[(size_t)k * 6144];
      a0 += sc[kp * 128 + k] * wv; a1 += sc[1024 + kp * 128 + k] * wv; a2 += sc[2048 + kp * 128 + k] * wv;
    }
    float* o = p.modpart() + ((size_t)(kp * 2 + l) * 3) * 6144 + col;
    o[0] = a0; o[6144] = a1; o[2 * 6144] = a2;
  }
  float* w3l = (float*)smem;
  for (int lyr = 0; lyr < 2; ++lyr) {
    __syncthreads();
    { const f32x4* src = (const f32x4*)(p.in[I_HYW3] + (size_t)lyr * 64 * 512);
      for (int i = tid; i < 64 * 512 / 4; i += NTHREADS) ((f32x4*)w3l)[i] = src[i]; }
    __syncthreads();
    const int ngroups = lyr == 0 ? (SEQL + CTXL) / 8 : SEQL / 8;
    for (int g2 = gw; g2 < ngroups * 2; g2 += nw) {
      const int g = g2 >> 1, mh = g2 & 1;
      const bool isctx = g >= SEQL / 8;
      const int L = isctx ? CTXL : SEQL, i0 = (isctx ? g - SEQL / 8 : g) * 8;
      float* outp = isctx ? p.hrawc() : p.hraw() + (size_t)lyr * 2 * 256 * SEQL;
      float z[8], tt[8];
#pragma unroll
      for (int q = 0; q < 8; ++q) {
        const int i = i0 + q;
        tt[q] = (float)i / (float)(L - 1);
        const float w = (6.283185307179586f / (float)L) * (float)i;
        z[q] = 0.f;
        if (lane == 0) z[q] = tt[q];
        else if (lane < 33) {
          const int j = (lane - 1) & 15;
          const float f = 1e-4f + (float)j * ((15.0f - 1e-4f) / 15.0f);
          z[q] = lane < 17 ? cosf(f * w) : -sinf(f * w);
        }
      }
      const float* w1 = p.in[I_HYW1] + lyr * 33 * 64;
      float a[8];
      { const float b1 = p.in[I_HYB1][lyr * 64 + lane];
#pragma unroll
        for (int q = 0; q < 8; ++q) a[q] = b1; }
      for (int k = 0; k < 33; ++k) {
        const float wv = w1[k * 64 + lane];
#pragma unroll
        for (int q = 0; q < 8; ++q) a[q] += __shfl(z[q], k) * wv;
      }
      float h1[8];
      { const float f1 = p.in[I_HYF1][lyr * 64 + lane];
#pragma unroll
        for (int q = 0; q < 8; ++q) h1[q] = sinf(f1 * a[q]); }
      const float* w2 = p.in[I_HYW2] + lyr * 64 * 64;
      { const float b2 = p.in[I_HYB2][lyr * 64 + lane];
#pragma unroll
        for (int q = 0; q < 8; ++q) a[q] = b2; }
      for (int k = 0; k < 64; ++k) {
        const float wv = w2[k * 64 + lane];
#pragma unroll
        for (int q = 0; q < 8; ++q) a[q] += __shfl(h1[q], k) * wv;
      }
      float h2[8];
      { const float f2 = p.in[I_HYF2][lyr * 64 + lane];
#pragma unroll
        for (int q = 0; q < 8; ++q) h2[q] = sinf(f2 * a[q]); }
      const float lo = -4.605170185988091f / 1.5f, hi = -4.605170185988091f / 0.3f;
      float o[4][8];
#pragma unroll
      for (int m = 0; m < 4; ++m)
#pragma unroll
        for (int q = 0; q < 8; ++q) o[m][q] = 0.f;
      for (int k = 0; k < 64; ++k) {
        float hv[8];
#pragma unroll
        for (int q = 0; q < 8; ++q) hv[q] = __shfl(h2[q], k);
#pragma unroll
        for (int m = 0; m < 4; ++m) {
          const float wv = w3l[k * 512 + (mh * 4 + m) * 64 + lane];
#pragma unroll
          for (int q = 0; q < 8; ++q) o[m][q] += hv[q] * wv;
        }
      }
#pragma unroll
      for (int m = 0; m < 4; ++m) {
        const int c = (mh * 4 + m) * 64 + lane, cc = c & 255;
        const float delta = fabsf(lo + (float)cc * ((hi - lo) / 255.0f));
#pragma unroll
        for (int q = 0; q < 8; ++q) o[m][q] *= expf(-tt[q] * delta);
        float* dst = outp + ((size_t)(c >> 8) * 256 + cc) * L + i0;
        *(f32x4*)dst = (f32x4){o[m][0], o[m][1], o[m][2], o[m][3]};
        *(f32x4*)(dst + 4) = (f32x4){o[m][4], o[m][5], o[m][6], o[m][7]};
      }
    }
  }
  __syncthreads();
}

__device__ __forceinline__ void ph_setup2(const Params& p) {
  const int TID = otid();
  const int tid = TID;
  const int gtid = blockIdx.x * NTHREADS + tid, nthr = gridDim.x * NTHREADS;
  for (int i = gtid; i < 2 * 3 * 6144; i += nthr) {
    const int l = i / (3 * 6144), j = i % 6144;
    float a = p.in[I_BMOD][l * 6144 + j];
#pragma unroll
    for (int kp = 0; kp < 8; ++kp) a += p.modpart()[(size_t)kp * (2 * 3 * 6144) + i];
    p.mod()[i] = a;
  }
  float* red = (float*)smem;
  for (int t = blockIdx.x; t < 768; t += gridDim.x) {
    const int set = t >> 8, c = t & 255;
    const int L = set < 2 ? SEQL : CTXL;
    const float* raw = set < 2 ? p.hraw() + (size_t)set * 2 * 256 * SEQL : p.hrawc();
    float s = 0.f;
    for (int i = tid; i < L; i += NTHREADS) {
      float a = raw[(size_t)c * L + i]; s += a * a;
      if (i >= 1) { float b = raw[((size_t)256 + c) * L + i]; s += b * b; }
    }
    s = wave_sum(s);
    __syncthreads();
    if ((tid & 63) == 0) red[tid >> 6] = s;
    __syncthreads();
    if (tid == 0) {
      float tot = 0.f;
      for (int w = 0; w < NWAVES; ++w) tot += red[w];
      float sc = 1.0f / sqrtf(tot + EPSF);
      if (set < 2) p.hscale()[set * 256 + c] = sc; else p.hscalec()[c] = sc;
    }
  }
}


__device__ __forceinline__ void ph_setup_s5(const Params& p) {
  const int tid = otid();
  float* apw = (float*)smem;
  float* Kc = apw + 4352;
  float* Bl = Kc + 8192;
  float* Cl = Bl + 4096;
  for (int item = blockIdx.x; item < 256; item += gridDim.x) {
    const int lg = item >> 3, part = item & 7;
    const int l = lg >> 4, g = lg & 15;
    __syncthreads();
    if (tid < 128) {
      const int dir = tid >> 6, pp = tid & 63;
      const int sidx = ((l * 2 + dir) * 16 + g) * 64 + pp;
      const double lr = fmin((double)p.in[I_S5LRE][sidx], -1e-4), li = (double)p.in[I_S5LIM][sidx], dt = exp((double)p.in[I_S5LDT][sidx >> 6]);
      const double mag = exp(lr * dt); double sn, cs;
      sincos(li * dt, &sn, &cs);
      const double ar = mag * cs, ai = mag * sn;
      double pr = 1.0, pi = 0.0;
      for (int m = 0; m < 17; ++m) {
        apw[((dir * 64 + pp) * 17 + m) * 2] = (float)pr; apw[((dir * 64 + pp) * 17 + m) * 2 + 1] = (float)pi;
        const double nr = pr * ar - pi * ai, ni = pr * ai + pi * ar; pr = nr; pi = ni;
      }
    }
    for (int e = tid; e < 4096; e += NTHREADS) {
      const int dir = e >> 11, r = e & 2047;
      Bl[e] = p.s5b()[(size_t)(((l * 2 + dir) * 16 + g) * 64) * 32 + r];
      const int c = (r >> 7), pp = (r >> 1) & 63, ri = r & 1;
      Cl[e] = (ri ? p.in[I_S5CIM] : p.in[I_S5CRE])[(((l * 2 + dir) * 16 + g) * 16 + c) * 64 + pp];
    }
    __syncthreads();
    for (int e = tid; e < 8192; e += NTHREADS) {
      const int dir = e >> 12, lag = (e >> 8) & 15, c = (e >> 4) & 15, cp = e & 15;
      float acc = 0.f;
      for (int pp = 0; pp < 64; ++pp) {
        const float ar = apw[((dir * 64 + pp) * 17 + lag) * 2], ai = apw[((dir * 64 + pp) * 17 + lag) * 2 + 1];
        const float br = Bl[((dir * 64 + pp) * 16 + cp) * 2], bi = Bl[((dir * 64 + pp) * 16 + cp) * 2 + 1];
        const float cre = Cl[((dir * 16 + c) * 64 + pp) * 2], cim = Cl[((dir * 16 + c) * 64 + pp) * 2 + 1];
        acc += cre * (ar * br - ai * bi) - cim * (ar * bi + ai * br);
      }
      Kc[e] = acc;
    }
    __syncthreads();
    bf16_t* Tz = p.s5Tz() + (size_t)lg * 65536;
    bf16_t* Nn = p.s5Nn() + (size_t)lg * 65536;
    bf16_t* Mm = p.s5Mm() + (size_t)lg * 65536;
    for (int e = part * 8192 + tid; e < (part + 1) * 8192; e += NTHREADS) {
      const int n = e >> 8, k = e & 255;
      {
        const int t = n >> 4, c = n & 15, tp = k >> 4, cp = k & 15;
        float v = 0.f;
        if (t >= tp) v += Kc[((0 * 16 + (t - tp)) * 16 + c) * 16 + cp];
        if (tp >= t) v += Kc[((1 * 16 + (tp - t)) * 16 + c) * 16 + cp];
        if (t == tp && c == cp) v += p.in[I_S5D][l * 256 + g * 16 + c];
        Tz[e] = f2bf(v);
      }
      {
        const int dir = n >> 7, pp = (n >> 1) & 63, ri = n & 1, tp = k >> 4, cp = k & 15;
        const int m = dir ? tp : 15 - tp;
        const float ar = apw[((dir * 64 + pp) * 17 + m) * 2], ai = apw[((dir * 64 + pp) * 17 + m) * 2 + 1];
        const float br = Bl[((dir * 64 + pp) * 16 + cp) * 2], bi = Bl[((dir * 64 + pp) * 16 + cp) * 2 + 1];
        Nn[e] = f2bf(ri ? (ar * bi + ai * br) : (ar * br - ai * bi));
      }
      {
        const int t = n >> 4, c = n & 15, dir = k >> 7, pp = (k >> 1) & 63, ri = k & 1;
        const int m = dir ? 16 - t : t + 1;
        const float ar = apw[((dir * 64 + pp) * 17 + m) * 2], ai = apw[((dir * 64 + pp) * 17 + m) * 2 + 1];
        const float cre = Cl[((dir * 16 + c) * 64 + pp) * 2], cim = Cl[((dir * 16 + c) * 64 + pp) * 2 + 1];
        Mm[e] = f2bf(ri ? -(cre * ai + cim * ar) : (cre * ar - cim * ai));
      }
    }
  }
}

__device__ __forceinline__ void ph_norm1(const Params& p, int l) {
  const int TID = otid();
  const int lane = TID & 63, wave = TID >> 6;
  for (int tok = blockIdx.x * NWAVES + wave; tok < NTOK; tok += gridDim.x * NWAVES) {
    const int r = tok_mod_row(tok);
    f32x4* xr = (f32x4*)(p.xbuf() + (size_t)tok * DM);
    const f32x4* src = l == 0 ? (tok < NCTX ? (const f32x4*)(p.in[I_CTX] + (size_t)tok * DM) : (const f32x4*)(p.in[I_X] + (size_t)(tok - NCTX) * DM))
                              : (const f32x4*)xr;
    f32x4 v[4];
    float ss = 0.f;
#pragma unroll
    for (int j = 0; j < 4; ++j) {
      v[j] = src[lane + 64 * j];
      if (l == 1) {
        const int c = (lane + 64 * j) * 4;
        f32x4 g = *(const f32x4*)(p.mod() + (size_t)(0 * 3 + r) * 6144 + 5 * 1024 + c);
        const uint2 y0b = *(const uint2*)(p.ybuf() + (size_t)p.aslot()[tok * 2] * DM + c), y1b = *(const uint2*)(p.ybuf() + (size_t)p.aslot()[tok * 2 + 1] * DM + c);
        const f32x4 y0 = {bflo(y0b.x), bfhi(y0b.x), bflo(y0b.y), bfhi(y0b.y)}, y1 = {bflo(y1b.x), bfhi(y1b.x), bflo(y1b.y), bfhi(y1b.y)};
        v[j] = v[j] + g * (y0 + y1);
      }
      if (l == 1) xr[lane + 64 * j] = v[j];
      ss += v[j].x * v[j].x + v[j].y * v[j].y + v[j].z * v[j].z + v[j].w * v[j].w;
    }
    ss = wave_sum(ss);
    const float rs = 1.0f / sqrtf(ss * (1.0f / DM) + EPSF);
    const float* gain = p.in[I_NORM1] + l * DM;
    const float* mrow = p.mod() + (size_t)(l * 3 + r) * 6144;
    uint2* ho = (uint2*)(p.hbf() + (size_t)tok * DM);
#pragma unroll
    for (int j = 0; j < 4; ++j) {
      const int c = (lane + 64 * j) * 4;
      f32x4 g = *(const f32x4*)(gain + c), sh = *(const f32x4*)(mrow + c), sc = *(const f32x4*)(mrow + 1024 + c);
      f32x4 h = v[j] * rs * g * (1.0f + sc) + sh;
      ho[lane + 64 * j] = make_uint2(pk2(h.x, h.y), pk2(h.z, h.w));
    }
  }
}

__device__ __forceinline__ void ph_reads(const Params& p, int l, int tok_lo) {
  const int TID = otid();
  const int lane = TID & 63, wave = TID >> 6;
  const int c = lane * 4;
  {
    bf16_t* tile = (bf16_t*)smem;
    for (int tt = blockIdx.x; tt < NLAT / 64; tt += gridDim.x) {
      __syncthreads();
      for (int i = TID; i < 256 * 8; i += NTHREADS) {
        const int ch = i >> 3, t8 = (i & 7) * 8;
        const uint4 v = *(const uint4*)((const bf16_t*)(p.hspec() + (size_t)ch * FFT_N * 2) + tt * 64 + t8);
        unsigned* d = (unsigned*)(tile + ch * 66 + t8);
        d[0] = v.x; d[1] = v.y; d[2] = v.z; d[3] = v.w;
      }
      __syncthreads();
#pragma unroll
      for (int k = 0; k < 8; ++k) {
        const int tk = wave * 8 + k;
        const unsigned lo = (unsigned)tile[(c + 0) * 66 + tk] | ((unsigned)tile[(c + 1) * 66 + tk] << 16);
        const unsigned hi = (unsigned)tile[(c + 2) * 66 + tk] | ((unsigned)tile[(c + 3) * 66 + tk] << 16);
        *(uint2*)(p.br() + (size_t)(NCTX + tt * 64 + tk) * DM + 256 + c) = make_uint2(lo, hi);
      }
    }
    __syncthreads();
  }
  for (int tok = tok_lo + blockIdx.x * NWAVES + wave; tok < NTOK; tok += gridDim.x * NWAVES) {
    const bf16_t* z = p.zmix() + (size_t)tok * NMIX;
    {
      f32x4 o = *(const f32x4*)(p.hgo() + (size_t)tok * 256 + c) + *(const f32x4*)(p.hgo() + ((size_t)NTOK + tok) * 256 + c);
      float ss = o.x * o.x + o.y * o.y + o.z * o.z + o.w * o.w;
#pragma unroll
      for (int m = 1; m < 16; m <<= 1) ss += __shfl_xor(ss, m);
      float rs = 1.0f / sqrtf(ss * (1.0f / 64.0f) + EPSF);
      f32x4 g = *(const f32x4*)(p.in[I_HGNORM] + l * 256 + c);
      const uint2 gtb = *(const uint2*)(z + C_HGG + c);
      const f32x4 gt = {bflo(gtb.x), bfhi(gtb.x), bflo(gtb.y), bfhi(gtb.y)};
      uint2 w = make_uint2(pk2(o.x * rs * g.x * siluf_(gt.x), o.y * rs * g.y * siluf_(gt.y)), pk2(o.z * rs * g.z * siluf_(gt.z), o.w * rs * g.w * siluf_(gt.w)));
      *(uint2*)(p.br() + (size_t)tok * DM + c) = w;
    }
    {
      f32x4 o = *(const f32x4*)(p.rto() + (size_t)tok * 256 + c) + *(const f32x4*)(p.rto() + ((size_t)NTOK + tok) * 256 + c);
      float sm_ = o.x + o.y + o.z + o.w;
#pragma unroll
      for (int m = 1; m < 16; m <<= 1) sm_ += __shfl_xor(sm_, m);
      float mean = sm_ * (1.0f / 64.0f);
      o = o - mean;
      float ss = o.x * o.x + o.y * o.y + o.z * o.z + o.w * o.w;
#pragma unroll
      for (int m = 1; m < 16; m <<= 1) ss += __shfl_xor(ss, m);
      float rs = 1.0f / sqrtf(ss * (1.0f / 64.0f) + EPSF);
      f32x4 g = *(const f32x4*)(p.in[I_RETNORM] + l * 256 + c);
      const uint2 gtb = *(const uint2*)(z + C_RG + c);
      const f32x4 gt = {bflo(gtb.x), bfhi(gtb.x), bflo(gtb.y), bfhi(gtb.y)};
      uint2 w = make_uint2(pk2(o.x * rs * g.x * siluf_(gt.x), o.y * rs * g.y * siluf_(gt.y)), pk2(o.z * rs * g.z * siluf_(gt.z), o.w * rs * g.w * siluf_(gt.w)));
      *(uint2*)(p.br() + (size_t)tok * DM + 512 + c) = w;
    }
  }
}

__device__ __forceinline__ void ph_router(const Params& p, int l, int tok_lo) {
  const int TID = otid();
  const int lane = TID & 63, wave = TID >> 6;
  const float* gain = p.in[I_NORM2] + l * DM;
  const float* wg = p.in[I_WGRP] + (size_t)l * DM * 4;
  float* wl = (float*)smem;
  int* lcnt = (int*)(smem + 131072);
  int* lbase = lcnt + 32;
  int* las_ex = lbase + 32;
  int* las_pos = las_ex + 160;
  int* las_id = las_pos + 160;
  __syncthreads();
  if (TID < 32) lcnt[TID] = 0;
  if (TID < 160) las_ex[TID] = -1;
  {
    const f32x4* src = (const f32x4*)(p.in[I_WEXP] + (size_t)l * DM * 32);
    for (int i = TID; i < DM * 32 / 4; i += NTHREADS) ((f32x4*)wl)[i] = src[i];
  }
  __syncthreads();
  const int rstride = gridDim.x * NWAVES;
  for (int tok0 = tok_lo + blockIdx.x * NWAVES + wave, kit = 0; tok0 < NTOK; tok0 += 2 * rstride, kit += 2) {
    int tk[2]; bool ok[2];
    tk[0] = tok0; ok[0] = true; tk[1] = tok0 + rstride; ok[1] = tk[1] < NTOK; if (!ok[1]) tk[1] = tok0;
    f32x4 h[2][4]; float ss[2];
#pragma unroll
    for (int u = 0; u < 2; ++u) {
      const f32x4* xr = (const f32x4*)(p.xbuf() + (size_t)tk[u] * DM);
      ss[u] = 0.f;
#pragma unroll
      for (int j = 0; j < 4; ++j) { h[u][j] = xr[lane + 64 * j]; ss[u] += h[u][j].x * h[u][j].x + h[u][j].y * h[u][j].y + h[u][j].z * h[u][j].z + h[u][j].w * h[u][j].w; }
    }
#pragma unroll
    for (int u = 0; u < 2; ++u) ss[u] = wave_sum(ss[u]);
    float lg[2][4];
#pragma unroll
    for (int u = 0; u < 2; ++u) {
      const float rs = 1.0f / sqrtf(ss[u] * (1.0f / DM) + EPSF);
      const float* mrow = p.mod() + (size_t)(l * 3 + tok_mod_row(tk[u])) * 6144 + 3 * 1024;
      uint2* ho = (uint2*)(p.hbf() + (size_t)tk[u] * DM);
#pragma unroll
      for (int i = 0; i < 4; ++i) lg[u][i] = 0.f;
#pragma unroll
      for (int j = 0; j < 4; ++j) {
        const int c = (lane + 64 * j) * 4;
        const f32x4 g = *(const f32x4*)(gain + c), sh = *(const f32x4*)(mrow + c), sc = *(const f32x4*)(mrow + 1024 + c);
        h[u][j] = h[u][j] * rs * g * (1.0f + sc) + sh;
        if (ok[u]) ho[lane + 64 * j] = make_uint2(pk2(h[u][j].x, h[u][j].y), pk2(h[u][j].z, h[u][j].w));
#pragma unroll
        for (int q = 0; q < 4; ++q) {
          const f32x4 wgv = *(const f32x4*)(wg + (size_t)(c + q) * 4);
#pragma unroll
          for (int i = 0; i < 4; ++i) lg[u][i] += h[u][j][q] * wgv[i];
        }
      }
    }
    int gi[2]; float grp_p[2];
#pragma unroll
    for (int u = 0; u < 2; ++u) {
      float gl[4];
#pragma unroll
      for (int i = 0; i < 4; ++i) gl[i] = wave_sum(lg[u][i]) + p.in[I_BGRP][l * 4 + i];
      int g_ = 0; float gm = gl[0];
#pragma unroll
      for (int i = 1; i < 4; ++i) if (gl[i] > gm) { gm = gl[i]; g_ = i; }
      float gs = 0.f;
#pragma unroll
      for (int i = 0; i < 4; ++i) gs += expf(gl[i] - gm);
      grp_p[u] = 1.0f / gs;
      gi[u] = __builtin_amdgcn_readfirstlane(g_);
    }
    float le[2][8];
#pragma unroll
    for (int u = 0; u < 2; ++u) {
#pragma unroll
      for (int i = 0; i < 8; ++i) le[u][i] = 0.f;
#pragma unroll
      for (int j = 0; j < 4; ++j) {
        const int c = (lane + 64 * j) * 4;
#pragma unroll
        for (int q = 0; q < 4; ++q) {
          const f32x4 w0 = *(const f32x4*)&wl[(c + q) * 32 + gi[u] * 8], w1 = *(const f32x4*)&wl[(c + q) * 32 + gi[u] * 8 + 4];
          const float hv = h[u][j][q];
          le[u][0] += hv * w0.x; le[u][1] += hv * w0.y; le[u][2] += hv * w0.z; le[u][3] += hv * w0.w;
          le[u][4] += hv * w1.x; le[u][5] += hv * w1.y; le[u][6] += hv * w1.z; le[u][7] += hv * w1.w;
        }
      }
    }
#pragma unroll
    for (int u = 0; u < 2; ++u) {
      float el[8];
#pragma unroll
      for (int i = 0; i < 8; ++i) el[i] = wave_sum(le[u][i]) + p.in[I_BEXP][l * 32 + gi[u] * 8 + i];
      int i1 = 0; float m1 = el[0];
#pragma unroll
      for (int i = 1; i < 8; ++i) if (el[i] > m1) { m1 = el[i]; i1 = i; }
      int i2 = i1 == 0 ? 1 : 0; float m2 = -3.0e38f;
#pragma unroll
      for (int i = 0; i < 8; ++i) if (i != i1 && el[i] > m2) { m2 = el[i]; i2 = i; }
      const float e2 = expf(m2 - m1);
      const float w1 = grp_p[u] / (1.0f + e2), w2 = grp_p[u] * e2 / (1.0f + e2);
      if (lane == 0 && ok[u]) {
        const int tok = tk[u];
        const int ex1 = gi[u] * 8 + i1, ex2 = gi[u] * 8 + i2;
        p.rw()[tok * 2] = w1; p.rw()[tok * 2 + 1] = w2;
        const int slot = ((kit + u) * NWAVES + wave) * 2;
        las_ex[slot] = ex1; las_pos[slot] = atomicAdd(&lcnt[ex1], 1); las_id[slot] = tok * 2;
        las_ex[slot + 1] = ex2; las_pos[slot + 1] = atomicAdd(&lcnt[ex2], 1); las_id[slot + 1] = tok * 2 + 1;
      }
    }
  }
  __syncthreads();
  if (TID < 32) lbase[TID] = lcnt[TID] > 0 ? atomicAdd(&p.cnt()[(l * 32 + TID) * 32], lcnt[TID]) : 0;
  __syncthreads();
  if (TID < 160 && las_ex[TID] >= 0) p.alist()[las_ex[TID] * NTOK + lbase[las_ex[TID]] + las_pos[TID]] = las_id[TID];
}

__device__ __forceinline__ void ph_final(const Params& p) {
  const int TID = otid();
  const int lane = TID & 63, wave = TID >> 6;
  const int rstride = gridDim.x * NWAVES;
  for (int tok0 = NCTX + blockIdx.x * NWAVES + wave; tok0 < NTOK; tok0 += 2 * rstride) {
    int tk[2]; bool ok[2];
    tk[0] = tok0; ok[0] = true; tk[1] = tok0 + rstride; ok[1] = tk[1] < NTOK; if (!ok[1]) tk[1] = tok0;
    int sl[2][2];
#pragma unroll
    for (int u = 0; u < 2; ++u) { sl[u][0] = p.aslot()[tk[u] * 2]; sl[u][1] = p.aslot()[tk[u] * 2 + 1]; }
    f32x4 v[2][4]; float ss[2];
#pragma unroll
    for (int u = 0; u < 2; ++u) {
      const f32x4* xr = (const f32x4*)(p.xbuf() + (size_t)tk[u] * DM);
      const float* grow = p.mod() + (size_t)(1 * 3 + tok_mod_row(tk[u])) * 6144 + 5 * 1024;
      ss[u] = 0.f;
#pragma unroll
      for (int j = 0; j < 4; ++j) {
        const int c = (lane + 64 * j) * 4;
        const f32x4 g = *(const f32x4*)(grow + c);
        const uint2 y0b = *(const uint2*)(p.ybuf() + (size_t)sl[u][0] * DM + c), y1b = *(const uint2*)(p.ybuf() + (size_t)sl[u][1] * DM + c);
        const f32x4 y0 = {bflo(y0b.x), bfhi(y0b.x), bflo(y0b.y), bfhi(y0b.y)}, y1 = {bflo(y1b.x), bfhi(y1b.x), bflo(y1b.y), bfhi(y1b.y)};
        v[u][j] = xr[lane + 64 * j] + g * (y0 + y1);
        ss[u] += v[u][j].x * v[u][j].x + v[u][j].y * v[u][j].y + v[u][j].z * v[u][j].z + v[u][j].w * v[u][j].w;
      }
    }
#pragma unroll
    for (int u = 0; u < 2; ++u) ss[u] = wave_sum(ss[u]);
#pragma unroll
    for (int u = 0; u < 2; ++u) {
      if (!ok[u]) continue;
      const float rs = 1.0f / sqrtf(ss[u] * (1.0f / DM) + EPSF);
      f32x4* o = (f32x4*)(p.out + (size_t)(tk[u] - NCTX) * DM);
#pragma unroll
      for (int j = 0; j < 4; ++j) {
        const int c = (lane + 64 * j) * 4;
        const f32x4 g = *(const f32x4*)(p.in[I_NORMF] + c);
        o[lane + 64 * j] = v[u][j] * rs * g;
      }
    }
  }
}

__device__ __forceinline__ void hyena_task(const Params& p, int l, int L, int tok0, int b, int c, const float* raw, const float* scale) {
  const int TID = otid();
  float* sm = (float*)smem;
  float* su = sm; float* sx0 = sm + L; float* shf = sm + 2 * L; float* shb = sm + 3 * L;
  const int tokb = tok0 + b * L;
  const float* cw = p.in[I_HYCW] + l * 3 * 768;
  const float* cb = p.in[I_HYCB] + l * 768;
  const float w00 = cw[c], w01 = cw[768 + c], w02 = cw[1536 + c], b0 = cb[c];
  const float w10 = cw[256 + c], w11 = cw[768 + 256 + c], w12 = cw[1536 + 256 + c], b1 = cb[256 + c];
  const float w20 = cw[512 + c], w21 = cw[768 + 512 + c], w22 = cw[1536 + 512 + c], b2 = cb[512 + c];
  __syncthreads();
  for (int t = TID; t < L; t += NTHREADS) {
    const bf16_t* zc = p.zmix() + (size_t)(tokb + t) * NMIX + C_HY + c;
    float x0m = 0.f, x1m = 0.f, vm = 0.f, x0p = 0.f, x1p = 0.f, vp = 0.f;
    if (t > 0) { x0m = bf2f(zc[-NMIX]); x1m = bf2f(zc[-NMIX + 256]); vm = bf2f(zc[-NMIX + 512]); }
    if (t < L - 1) { x0p = bf2f(zc[NMIX]); x1p = bf2f(zc[NMIX + 256]); vp = bf2f(zc[NMIX + 512]); }
    float x0 = x0m * w00 + bf2f(zc[0]) * w01 + x0p * w02 + b0;
    float x1 = x1m * w10 + bf2f(zc[256]) * w11 + x1p * w12 + b1;
    float v = vm * w20 + bf2f(zc[512]) * w21 + vp * w22 + b2;
    su[t] = v * x1; sx0[t] = x0;
    shf[t] = raw[(size_t)c * L + t];
    shb[t] = raw[((size_t)256 + c) * L + t];
  }
  __syncthreads();
  const float scl = scale[c], skip = p.in[I_HYSKIP][l * 256 + c];
  for (int t = TID; t < L; t += NTHREADS) {
    float a0 = 0.f, a1 = 0.f;
    for (int s = 0; s <= t; ++s) a0 += shf[t - s] * su[s];
    for (int s = t + 1; s < L; ++s) a1 += shb[s - t] * su[s];
    float y = (a0 + a1) * scl + su[t] * skip;
    p.br()[(size_t)(tokb + t) * DM + 256 + c] = f2bf(y * sx0[t]);
  }
}

struct __attribute__((aligned(8))) cf { float x, y; };
__device__ __forceinline__ cf cadd(cf a, cf b) { return {a.x + b.x, a.y + b.y}; }
__device__ __forceinline__ cf csub(cf a, cf b) { return {a.x - b.x, a.y - b.y}; }
__device__ __forceinline__ cf cmul(cf a, cf b) { return {a.x * b.x - a.y * b.y, a.x * b.y + a.y * b.x}; }
__device__ __forceinline__ cf cmulc(cf a, cf b) { return {a.x * b.x + a.y * b.y, a.y * b.x - a.x * b.y}; }
__device__ __forceinline__ int fphys(int i) { return i + ((i >> 6) << 2); }
#define FFT_PHYS_N (FFT_N + (FFT_N >> 6) * 4)

template <bool INV>
__device__ __forceinline__ void dft4(cf& a0, cf& a1, cf& a2, cf& a3) {
  const cf s02 = cadd(a0, a2), d02 = csub(a0, a2), s13 = cadd(a1, a3), d13 = csub(a1, a3);
  a0 = cadd(s02, s13); a2 = csub(s02, s13);
  if (!INV) { a1 = {d02.x + d13.y, d02.y - d13.x}; a3 = {d02.x - d13.y, d02.y + d13.x}; }
  else      { a1 = {d02.x - d13.y, d02.y + d13.x}; a3 = {d02.x + d13.y, d02.y - d13.x}; }
}
template <bool INV>
__device__ __forceinline__ void dft16(cf (&x)[16]) {
#pragma unroll
  for (int a0 = 0; a0 < 4; ++a0) dft4<INV>(x[a0], x[a0 + 4], x[a0 + 8], x[a0 + 12]);
  const float C1 = 0.92387953251128674f, S1 = 0.38268343236508977f, R2 = 0.70710678118654752f;
  const cf w1 = {C1, -S1}, w2 = {R2, -R2}, w3 = {S1, -C1}, w4 = {0.f, -1.f}, w6 = {-R2, -R2}, w9 = {-C1, S1};
#define TW(idx, w) x[idx] = INV ? cmulc(x[idx], w) : cmul(x[idx], w)
  TW(1 + 4 * 1, w1); TW(2 + 4 * 1, w2); TW(3 + 4 * 1, w3);
  TW(1 + 4 * 2, w2); TW(2 + 4 * 2, w4); TW(3 + 4 * 2, w6);
  TW(1 + 4 * 3, w3); TW(2 + 4 * 3, w6); TW(3 + 4 * 3, w9);
#undef TW
#pragma unroll
  for (int c0 = 0; c0 < 4; ++c0) dft4<INV>(x[4 * c0], x[4 * c0 + 1], x[4 * c0 + 2], x[4 * c0 + 3]);
}
#define RC16(c) (((c) >> 2) + 4 * ((c) & 3))

__device__ __forceinline__ void tw_powers(cf w1, cf (&w)[16]) {
  w[0] = {1.f, 0.f}; w[1] = w1;
  w[2] = cmul(w1, w1); w[3] = cmul(w[2], w1); w[4] = cmul(w[2], w[2]); w[5] = cmul(w[4], w1); w[6] = cmul(w[3], w[3]); w[7] = cmul(w[4], w[3]);
  w[8] = cmul(w[4], w[4]); w[9] = cmul(w[8], w1); w[10] = cmul(w[5], w[5]); w[11] = cmul(w[8], w[3]); w[12] = cmul(w[6], w[6]); w[13] = cmul(w[8], w[5]);
  w[14] = cmul(w[7], w[7]); w[15] = cmul(w[8], w[7]);
}

template <bool INV>
__device__ __forceinline__ void r16_group(cf* X, int base, int S, cf w1) {
  cf x[16], w[16];
  tw_powers(w1, w);
#pragma unroll
  for (int a = 0; a < 16; ++a) x[a] = X[fphys(base + S * a)];
  if (INV) {
#pragma unroll
    for (int c = 1; c < 16; ++c) x[c] = cmulc(x[c], w[c]);
  }
  dft16<INV>(x);
#pragma unroll
  for (int c = 0; c < 16; ++c) {
    cf v = x[RC16(c)];
    if (!INV && c > 0) v = cmul(v, w[c]);
    X[fphys(base + S * c)] = v;
  }
}
template <bool INV>
__device__ __forceinline__ void r4_group(cf* X, int base) {
  cf a0 = X[fphys(base)], a1 = X[fphys(base + 1)], a2 = X[fphys(base + 2)], a3 = X[fphys(base + 3)];
  dft4<INV>(a0, a1, a2, a3);
  X[fphys(base)] = a0; X[fphys(base + 1)] = a1; X[fphys(base + 2)] = a2; X[fphys(base + 3)] = a3;
}
template <bool INV>
__device__ __forceinline__ void fft_pass(cf* X, const cf* tw, int pass, int tid, int nthr) {
  if (pass == 1) {
    for (int g = tid; g < 1024; g += nthr) r16_group<INV>(X, g, 1024, tw[g]);
  } else if (pass == 2) {
    for (int g = tid; g < 1024; g += nthr) { const int c1 = g >> 6, b2 = g & 63; r16_group<INV>(X, c1 * 1024 + b2, 64, tw[16 * b2]); }
  } else if (pass == 3) {
    for (int g = tid; g < 1024; g += nthr) { const int blk = g >> 2, b3 = g & 3; r16_group<INV>(X, blk * 64 + b3, 4, tw[256 * b3]); }
  } else {
    for (int g = tid; g < 4096; g += nthr) r4_group<INV>(X, 4 * g);
  }
}

__device__ __forceinline__ void ph_hy_transpose(const Params& p) {
  const int tid = otid();
  float* tile = (float*)smem;
  for (int t = blockIdx.x; t < (NLAT / 64) * 12; t += gridDim.x) {
    const int tt = t / 12, ct = t % 12, tok0 = tt * 64, col0 = ct * 64;
    __syncthreads();
    {
      const int r = tid >> 3, c8 = (tid & 7) * 8;
      const bf16_t* src = p.zmix() + (size_t)(NCTX + tok0 + r) * NMIX + C_HY + col0 + c8;
      const uint4 raw = *(const uint4*)src;
      float* d = tile + r * 65 + c8;
      d[0] = bflo(raw.x); d[1] = bfhi(raw.x); d[2] = bflo(raw.y); d[3] = bfhi(raw.y); d[4] = bflo(raw.z); d[5] = bfhi(raw.z); d[6] = bflo(raw.w); d[7] = bfhi(raw.w);
    }
    __syncthreads();
    {
      const int cc = tid >> 3, r8 = (tid & 7) * 8;
      f32x4 a, b;
      a.x = tile[(r8 + 0) * 65 + cc]; a.y = tile[(r8 + 1) * 65 + cc]; a.z = tile[(r8 + 2) * 65 + cc]; a.w = tile[(r8 + 3) * 65 + cc];
      b.x = tile[(r8 + 4) * 65 + cc]; b.y = tile[(r8 + 5) * 65 + cc]; b.z = tile[(r8 + 6) * 65 + cc]; b.w = tile[(r8 + 7) * 65 + cc];
      float* dst = p.hyT() + (size_t)(col0 + cc) * NLAT + tok0 + r8;
      *(f32x4*)dst = a; *(f32x4*)(dst + 4) = b;
    }
  }
}
__device__ __forceinline__ void ph_s5_regroup(const Params& p) {
  const int gtid = blockIdx.x * NTHREADS + otid(), nthr = gridDim.x * NTHREADS;
  for (int idx = gtid; idx < NTOK * 16; idx += nthr) {
    const int tok = idx >> 4, g = idx & 15;
    const uint4* src = (const uint4*)(p.zmix() + (size_t)tok * NMIX + C_S5 + g * 16);
    uint4* dst = (uint4*)(p.s5u() + ((size_t)g * 1280 + (tok >> 4)) * 256 + (tok & 15) * 16);
    const uint4 a = src[0], b = src[1];
    dst[0] = a; dst[1] = b;
  }
}
__device__ __forceinline__ float conv3_at(const float* col, int t, float w0, float w1, float w2, float b) {
  const float m = t > 0 ? col[t - 1] : 0.f, pl = t < SEQL - 1 ? col[t + 1] : 0.f;
  return m * w0 + col[t] * w1 + pl * w2 + b;
}
__device__ __forceinline__ void hyena_fft_task(const Params& p, int l, int c) {
  const int tid = otid();
  cf* X = (cf*)smem;
  const cf* tw = (const cf*)p.twid();
  const float* hf = p.hraw() + ((size_t)l * 2 * 256 + c) * SEQL;
  const float* hb = p.hraw() + ((size_t)l * 2 * 256 + 256 + c) * SEQL;
  __syncthreads();
  for (int n = tid; n < FFT_N; n += NTHREADS) {
    const float v = n < SEQL ? hf[n] : (n == SEQL ? 0.f : hb[FFT_N - n]);
    X[fphys(n)] = cf{v, 0.f};
  }
  __syncthreads();
  for (int ps = 1; ps <= 4; ++ps) { fft_pass<false>(X, tw, ps, tid, NTHREADS); __syncthreads(); }
  cf* Kg = (cf*)p.hspec() + (size_t)c * FFT_N;
  for (int i = 0; i < 32; ++i) Kg[i * NTHREADS + tid] = X[fphys(i * NTHREADS + tid)];
  __syncthreads();
  const float* cw = p.in[I_HYCW] + l * 3 * 768;
  const float* cb = p.in[I_HYCB] + l * 768;
  const float w00 = cw[c], w01 = cw[768 + c], w02 = cw[1536 + c], b0 = cb[c];
  const float w10 = cw[256 + c], w11 = cw[768 + 256 + c], w12 = cw[1536 + 256 + c], b1 = cb[256 + c];
  const float w20 = cw[512 + c], w21 = cw[768 + 512 + c], w22 = cw[1536 + 512 + c], b2 = cb[512 + c];
  const float* x0c = p.hyT() + (size_t)c * NLAT;
  const float* x1c = p.hyT() + (size_t)(256 + c) * NLAT;
  const float* vc = p.hyT() + (size_t)(512 + c) * NLAT;
  for (int n = tid; n < FFT_N; n += NTHREADS) {
    cf z = {0.f, 0.f};
    if (n < SEQL) {
      z.x = conv3_at(vc, n, w20, w21, w22, b2) * conv3_at(x1c, n, w10, w11, w12, b1);
      z.y = conv3_at(vc + SEQL, n, w20, w21, w22, b2) * conv3_at(x1c + SEQL, n, w10, w11, w12, b1);
    }
    X[fphys(n)] = z;
  }
  __syncthreads();
  for (int ps = 1; ps <= 4; ++ps) { fft_pass<false>(X, tw, ps, tid, NTHREADS); __syncthreads(); }
#pragma unroll 4
  for (int i = 0; i < 32; ++i) { const int ph = fphys(i * NTHREADS + tid); X[ph] = cmul(X[ph], Kg[i * NTHREADS + tid]); }
  __syncthreads();
  for (int ps = 4; ps >= 1; --ps) { fft_pass<true>(X, tw, ps, tid, NTHREADS); __syncthreads(); }
  const float scl = p.hscale()[l * 256 + c] * (1.0f / (float)FFT_N), skip = p.in[I_HYSKIP][l * 256 + c];
  for (int t = tid; t < SEQL; t += NTHREADS) {
    const cf y = X[fphys(t)];
    const float u0 = conv3_at(vc, t, w20, w21, w22, b2) * conv3_at(x1c, t, w10, w11, w12, b1);
    const float u1 = conv3_at(vc + SEQL, t, w20, w21, w22, b2) * conv3_at(x1c + SEQL, t, w10, w11, w12, b1);
    const float x00 = conv3_at(x0c, t, w00, w01, w02, b0), x01 = conv3_at(x0c + SEQL, t, w00, w01, w02, b0);
    bf16_t* hyo = (bf16_t*)(p.hspec() + (size_t)c * FFT_N * 2);
    hyo[t] = f2bf((y.x * scl + u0 * skip) * x00);
    hyo[SEQL + t] = f2bf((y.y * scl + u1 * skip) * x01);
  }
}

__device__ __forceinline__ void unpack8(const uint4 r, float (&v)[8]) {
  v[0] = bflo(r.x); v[1] = bfhi(r.x); v[2] = bflo(r.y); v[3] = bfhi(r.y); v[4] = bflo(r.z); v[5] = bfhi(r.z); v[6] = bflo(r.w); v[7] = bfhi(r.w);
}
__device__ __forceinline__ float fsigmoid(float x) { return __builtin_amdgcn_rcpf(1.0f + __builtin_amdgcn_exp2f(-1.4426950408889634f * x)); }

template <bool PASSC>
__device__ __forceinline__ void hgrn_task(const Params& p, int l, int task, float* wl  ) {
  const int lane = otid() & 63;
  const int chunk = task % NCHUNK, r = task / NCHUNK, h = r & 3, dir = (r >> 2) & 1, b = r >> 3;
  float* lf = wl; float* lq = wl + 1024; float* lv = wl + 2048;
  f32x2 S[32];
  if (PASSC) {
#pragma unroll
    for (int d = 0; d < 32; ++d) { S[d].x = p.hgU()[((size_t)task * 64 + 2 * d) * 64 + lane]; S[d].y = p.hgU()[((size_t)task * 64 + 2 * d + 1) * 64 + lane]; }
  } else {
#pragma unroll
    for (int d = 0; d < 32; ++d) S[d] = (f32x2){0.f, 0.f};
  }
  const int d8 = (lane & 7) * 8;
  float lb8[8], dp[8];
#pragma unroll
  for (int j = 0; j < 8; ++j) { lb8[j] = p.lb()[(l * 2 + dir) * 256 + h * 64 + d8 + j]; dp[j] = 1.0f; }
  uint4 rf[2], rq[2], rv[2];
  auto gload = [&](int sub) {
#pragma unroll
    for (int k = 0; k < 2; ++k) {
      const int i = (lane >> 3) + 8 * k;
      const bf16_t* z = p.zmix() + (size_t)scan_tok(chunk * 64 + sub * 16 + i, dir, b) * NMIX + h * 64 + d8;
      rf[k] = *(const uint4*)(z + C_HGF + dir * 256);
      if (PASSC) rq[k] = *(const uint4*)(z + C_HGQ);
      rv[k] = *(const uint4*)(z + C_HGI);
    }
  };
  float* outp = p.hgo() + (size_t)dir * NTOK * 256;
  gload(0);
  for (int sub = 0; sub < 4; ++sub) {
    LDS_FENCE();
#pragma unroll
    for (int k = 0; k < 2; ++k) {
      const int i = (lane >> 3) + 8 * k;
      float t8[8];
      unpack8(rf[k], t8);
#pragma unroll
      for (int j = 0; j < 8; ++j) { t8[j] = lb8[j] + (1.0f - lb8[j]) * fsigmoid(t8[j]); dp[j] *= t8[j]; }
      *(f32x4*)&lf[i * 64 + d8] = (f32x4){t8[0], t8[1], t8[2], t8[3]}; *(f32x4*)&lf[i * 64 + d8 + 4] = (f32x4){t8[4], t8[5], t8[6], t8[7]};
      if (PASSC) { unpack8(rq[k], t8); *(f32x4*)&lq[i * 64 + d8] = (f32x4){t8[0], t8[1], t8[2], t8[3]}; *(f32x4*)&lq[i * 64 + d8 + 4] = (f32x4){t8[4], t8[5], t8[6], t8[7]}; }
      unpack8(rv[k], t8);
      *(f32x4*)&lv[i * 64 + d8] = (f32x4){t8[0], t8[1], t8[2], t8[3]}; *(f32x4*)&lv[i * 64 + d8 + 4] = (f32x4){t8[4], t8[5], t8[6], t8[7]};
    }
    LDS_FENCE();
    if (sub < 3) gload(sub + 1);
    const int s0 = chunk * 64 + sub * 16;
    for (int i = 0; i < 16; ++i) {
      const float v = lv[i * 64 + lane];
      const f32x2 v2 = {v, v};
      f32x2 o2 = {0.f, 0.f};
#pragma unroll
      for (int d4 = 0; d4 < 16; ++d4) {
        const f32x4 f4 = *(const f32x4*)&lf[i * 64 + d4 * 4];
        const f32x2 fa = {f4.x, f4.y}, fb = {f4.z, f4.w};
        S[2 * d4] = fa * (S[2 * d4] - v2) + v2;
        S[2 * d4 + 1] = fb * (S[2 * d4 + 1] - v2) + v2;
        if (PASSC) {
          const f32x4 q4 = *(const f32x4*)&lq[i * 64 + d4 * 4];
          o2 = S[2 * d4] * (f32x2){q4.x, q4.y} + o2;
          o2 = S[2 * d4 + 1] * (f32x2){q4.z, q4.w} + o2;
        }
      }
      if (PASSC) outp[(size_t)scan_tok(s0 + i, dir, b) * 256 + h * 64 + lane] = o2.x + o2.y;
    }
  }
  if (!PASSC) {
#pragma unroll
    for (int d = 0; d < 32; ++d) { p.hgU()[((size_t)task * 64 + 2 * d) * 64 + lane] = S[d].x; p.hgU()[((size_t)task * 64 + 2 * d + 1) * 64 + lane] = S[d].y; }
#pragma unroll
    for (int j = 0; j < 8; ++j) { dp[j] *= __shfl_xor(dp[j], 8); dp[j] *= __shfl_xor(dp[j], 16); dp[j] *= __shfl_xor(dp[j], 32); }
    if (lane < 8) {
#pragma unroll
      for (int j = 0; j < 8; ++j) p.hgD()[(size_t)task * 64 + d8 + j] = dp[j];
    }
  }
}

template <bool PASSC>
__device__ __forceinline__ void ret_task(const Params& p, int l, int task, float* wl) {
  const int lane = otid() & 63;
  const int chunk = task % NCHUNK, r = task / NCHUNK, h = r & 3, dir = (r >> 2) & 1, b = r >> 3;
  float* lq = wl; float* lk = wl + 512; float* lv = wl + 1024;
  const float gamma = sigmoidf_(p.in[I_RETDEC][(l * 2 + dir) * 4 + h]);
  const f32x2 g2 = {gamma, gamma};
  f32x2 S[16];
  if (PASSC) {
#pragma unroll
    for (int d = 0; d < 16; ++d) { S[d].x = p.rtU()[((size_t)task * 32 + 2 * d) * 64 + lane]; S[d].y = p.rtU()[((size_t)task * 32 + 2 * d + 1) * 64 + lane]; }
  } else {
#pragma unroll
    for (int d = 0; d < 16; ++d) S[d] = (f32x2){0.f, 0.f};
  }
  const int qi = lane >> 2, qd8 = (lane & 3) * 8;
  const int vd8 = (lane & 7) * 8;
  uint4 rq, rk, rv[2];
  auto gload = [&](int sub) {
    const bf16_t* z = p.zmix() + (size_t)scan_tok(chunk * 64 + sub * 16 + qi, dir, b) * NMIX + h * 32 + qd8;
    if (PASSC) rq = *(const uint4*)(z + C_RQ);
    rk = *(const uint4*)(z + C_RK);
#pragma unroll
    for (int k = 0; k < 2; ++k) {
      const int i = (lane >> 3) + 8 * k;
      rv[k] = *(const uint4*)(p.zmix() + (size_t)scan_tok(chunk * 64 + sub * 16 + i, dir, b) * NMIX + C_RV + h * 64 + vd8);
    }
  };
  float* outp = p.rto() + (size_t)dir * NTOK * 256;
  gload(0);
  for (int sub = 0; sub < 4; ++sub) {
    const int s0 = chunk * 64 + sub * 16;
    LDS_FENCE();
    {
      const int tok = scan_tok(s0 + qi, dir, b);
      float kq[8], kk[8];
      if (PASSC) unpack8(rq, kq);
      unpack8(rk, kk);
#pragma unroll
      for (int j = 0; j < 8; ++j) kk[j] *= 0.17677669529663687f;
      if (tok >= NCTX) {
        const int tt = (tok - NCTX) & (SEQL - 1);
        const int pos = (qd8 & 16) ? (tt & 63) : (tt >> 6);
        const float* cs = p.rope() + pos * 16;
        const bool second = qd8 & 8;
#pragma unroll
        for (int j = 0; j < 8; ++j) {
          const float c = cs[2 * j], s = cs[2 * j + 1];
          const float okk = __shfl_xor(kk[j], 1);
          kk[j] = second ? (okk * s + kk[j] * c) : (kk[j] * c - okk * s);
          if (PASSC) { const float oq = __shfl_xor(kq[j], 1); kq[j] = second ? (oq * s + kq[j] * c) : (kq[j] * c - oq * s); }
        }
      }
      if (PASSC) { *(f32x4*)&lq[qi * 32 + qd8] = (f32x4){kq[0], kq[1], kq[2], kq[3]}; *(f32x4*)&lq[qi * 32 + qd8 + 4] = (f32x4){kq[4], kq[5], kq[6], kq[7]}; }
      *(f32x4*)&lk[qi * 32 + qd8] = (f32x4){kk[0], kk[1], kk[2], kk[3]}; *(f32x4*)&lk[qi * 32 + qd8 + 4] = (f32x4){kk[4], kk[5], kk[6], kk[7]};
#pragma unroll
      for (int k = 0; k < 2; ++k) {
        const int i = (lane >> 3) + 8 * k;
        float t8[8];
        unpack8(rv[k], t8);
        *(f32x4*)&lv[i * 64 + vd8] = (f32x4){t8[0], t8[1], t8[2], t8[3]}; *(f32x4*)&lv[i * 64 + vd8 + 4] = (f32x4){t8[4], t8[5], t8[6], t8[7]};
      }
    }
    LDS_FENCE();
    if (sub < 3) gload(sub + 1);
    for (int i = 0; i < 16; ++i) {
      const float v = lv[i * 64 + lane];
      const f32x2 v2 = {v, v};
      f32x2 o2 = {0.f, 0.f};
#pragma unroll
      for (int d4 = 0; d4 < 8; ++d4) {
        const f32x4 k4 = *(const f32x4*)&lk[i * 32 + d4 * 4];
        S[2 * d4] = g2 * S[2 * d4] + (f32x2){k4.x, k4.y} * v2;
        S[2 * d4 + 1] = g2 * S[2 * d4 + 1] + (f32x2){k4.z, k4.w} * v2;
        if (PASSC) {
          const f32x4 q4 = *(const f32x4*)&lq[i * 32 + d4 * 4];
          o2 = S[2 * d4] * (f32x2){q4.x, q4.y} + o2;
          o2 = S[2 * d4 + 1] * (f32x2){q4.z, q4.w} + o2;
        }
      }
      if (PASSC) outp[(size_t)scan_tok(s0 + i, dir, b) * 256 + h * 64 + lane] = o2.x + o2.y;
    }
  }
  if (!PASSC) {
#pragma unroll
    for (int d = 0; d < 16; ++d) { p.rtU()[((size_t)task * 32 + 2 * d) * 64 + lane] = S[d].x; p.rtU()[((size_t)task * 32 + 2 * d + 1) * 64 + lane] = S[d].y; }
  }
}

__device__ __forceinline__ f32x4 mfma16(bf16x8 x, bf16x8 y, f32x4 c) { return __builtin_amdgcn_mfma_f32_16x16x32_bf16(x, y, c, 0, 0, 0); }
__device__ __forceinline__ float fexp(float x) { return __builtin_amdgcn_exp2f(1.4426950408889634f * x); }

template <int DK, bool PASSC, bool RET>
__device__ __forceinline__ void chunk_task(const Params& p, int l, int task, unsigned char* wlds  ) {
  const int lane = otid() & 63, fr = lane & 15, fq = lane >> 4;
  const int chunk = task % NCHUNK, r = task / NCHUNK, h = r & 3, dir = (r >> 2) & 1, b = r >> 3;
  constexpr int NDT = DK / 16, NKS = DK / 32;
  bf16_t* Qh = (bf16_t*)wlds;
  bf16_t* Kt = Qh + 1024;
  bf16_t* KtT = Kt + 1024;
  bf16_t* VT = KtT + 1024;
  bf16_t* Pm = VT + 1024;
  bf16_t* ST = Pm + 256;
  float* Dl = (float*)(ST + 4096);
  float* Ustate = RET ? p.rtU() : p.hgU();
  f32x4 S[NDT][4];
#pragma unroll
  for (int dt = 0; dt < NDT; ++dt)
#pragma unroll
    for (int et = 0; et < 4; ++et) {
      if (PASSC) {
#pragma unroll
        for (int j = 0; j < 4; ++j) S[dt][et][j] = Ustate[((size_t)task * DK + 16 * dt + 4 * fq + j) * 64 + 16 * et + fr];
      } else S[dt][et] = (f32x4){0.f, 0.f, 0.f, 0.f};
    }
  float lbv = 0.f, gam = 1.f;
  if (RET) gam = sigmoidf_(p.in[I_RETDEC][(l * 2 + dir) * 4 + h]);
  else if (lane < DK) lbv = p.lb()[(l * 2 + dir) * 256 + h * 64 + lane];
  float btot = 1.f;
  const int colF = RET ? (C_RK + h * 32) : (C_HGF + dir * 256 + h * 64);
  const int colQ = RET ? (C_RQ + h * 32) : (C_HGQ + h * 64);
  const int colV = RET ? (C_RV + h * 64) : (C_HGI + h * 64);
  const int lq = lane < DK ? lane : 0;
  unsigned rf[16], rq[16], rv[16];
  auto gload = [&](int sub) {
#pragma unroll
    for (int t = 0; t < 16; ++t) {
      const bf16_t* z = p.zmix() + (size_t)scan_tok(chunk * 64 + sub * 16 + t, dir, b) * NMIX;
      rf[t] = z[colF + lq];
      if (PASSC) rq[t] = z[colQ + lq];
      rv[t] = z[colV + lane];
    }
  };
  float* outp = (RET ? p.rto() : p.hgo()) + (size_t)dir * NTOK * 256;
  gload(0);
  for (int sub = 0; sub < 4; ++sub) {
    const int s0 = chunk * 64 + sub * 16;
    LDS_FENCE();
    {
      float kk[16], qq[16];
#pragma unroll
      for (int t = 0; t < 16; ++t) { kk[t] = __uint_as_float(rf[t] << 16); qq[t] = PASSC ? __uint_as_float(rq[t] << 16) : 0.f; }
      unsigned vpk[8];
#pragma unroll
      for (int t = 0; t < 8; ++t) vpk[t] = (rv[2 * t] & 0xffffu) | (rv[2 * t + 1] << 16);
      *(uint4*)&VT[lane * 16] = make_uint4(vpk[0], vpk[1], vpk[2], vpk[3]);
      *(uint4*)&VT[lane * 16 + 8] = make_uint4(vpk[4], vpk[5], vpk[6], vpk[7]);
      if (sub < 3) gload(sub + 1);
      if (RET) {
        const bool lat = scan_tok(s0, dir, b) >= NCTX;
        f32x2 cs[16];
#pragma unroll
        for (int t = 0; t < 16; ++t) {
          const int tt = (scan_tok(s0 + t, dir, b) - NCTX) & (SEQL - 1);
          const int pos = lat ? ((lane & 16) ? (tt & 63) : (tt >> 6)) : 0;
          cs[t] = *(const f32x2*)&p.rope()[pos * 16 + 2 * (lane & 7)];
        }
        const bool second = lane & 8;
#pragma unroll
        for (int t = 0; t < 16; ++t) {
          kk[t] *= 0.17677669529663687f;
          const float ok = __shfl_xor(kk[t], 8), oq = __shfl_xor(qq[t], 8);
          const float c = cs[t].x, sn = cs[t].y;
          kk[t] = second ? (ok * sn + kk[t] * c) : (kk[t] * c - ok * sn);
          qq[t] = second ? (oq * sn + qq[t] * c) : (qq[t] * c - oq * sn);
        }
      }
      float cprod = 1.0f;
      unsigned kpk[8];
      float ktv[16];
#pragma unroll
      for (int t = 0; t < 16; ++t) {
        float f, kv;
        if (RET) { f = gam; kv = kk[t]; }
        else { f = lbv + (1.0f - lbv) * fsigmoid(kk[t]); kv = 1.0f - f; }
        cprod *= f;
        const float e1 = fmaxf(cprod, 1e-30f), e2 = __builtin_amdgcn_rcpf(e1);
        ktv[t] = kv * e2;
        if (PASSC) {
          const unsigned qk = pk2(qq[t] * e1, ktv[t]);
          if (lane < DK) { Qh[t * DK + lane] = (bf16_t)(qk & 0xffffu); Kt[t * DK + lane] = (bf16_t)(qk >> 16); }
        }
      }
#pragma unroll
      for (int t = 0; t < 8; ++t) kpk[t] = pk2(ktv[2 * t], ktv[2 * t + 1]);
      if (lane < DK) {
        *(uint4*)&KtT[lane * 16] = make_uint4(kpk[0], kpk[1], kpk[2], kpk[3]);
        *(uint4*)&KtT[lane * 16 + 8] = make_uint4(kpk[4], kpk[5], kpk[6], kpk[7]);
        Dl[lane] = cprod;
      }
      btot *= cprod;
    }
    const bf16x8 zero8 = {0, 0, 0, 0, 0, 0, 0, 0};
    if (PASSC) {
#pragma unroll
      for (int dt = 0; dt < NDT; ++dt)
#pragma unroll
        for (int et = 0; et < 4; ++et)
          *(uint2*)&ST[(16 * et + fr) * DK + 16 * dt + 4 * fq] = make_uint2(pk2(S[dt][et][0], S[dt][et][1]), pk2(S[dt][et][2], S[dt][et][3]));
      LDS_FENCE();
      f32x4 P = {0.f, 0.f, 0.f, 0.f};
#pragma unroll
      for (int ks = 0; ks < NKS; ++ks) {
        const bf16x8 X = *(const bf16x8*)&Kt[fr * DK + 32 * ks + 8 * fq];
        const bf16x8 Y = *(const bf16x8*)&Qh[fr * DK + 32 * ks + 8 * fq];
        P = mfma16(X, Y, P);
      }
#pragma unroll
      for (int j = 0; j < 4; ++j) if (4 * fq + j > fr) P[j] = 0.f;
      *(uint2*)&Pm[fr * 16 + 4 * fq] = make_uint2(pk2(P[0], P[1]), pk2(P[2], P[3]));
      LDS_FENCE();
      const bf16x8 Yp = fq < 2 ? *(const bf16x8*)&Pm[fr * 16 + 8 * fq] : zero8;
      bf16x8 Yq[NKS];
#pragma unroll
      for (int ks = 0; ks < NKS; ++ks) Yq[ks] = *(const bf16x8*)&Qh[fr * DK + 32 * ks + 8 * fq];
      const size_t orow = (size_t)scan_tok(s0 + fr, dir, b) * 256 + h * 64 + 4 * fq;
#pragma unroll
      for (int et = 0; et < 4; ++et) {
        f32x4 O = {0.f, 0.f, 0.f, 0.f};
        const bf16x8 Xv = fq < 2 ? *(const bf16x8*)&VT[(16 * et + fr) * 16 + 8 * fq] : zero8;
        O = mfma16(Xv, Yp, O);
#pragma unroll
        for (int ks = 0; ks < NKS; ++ks) {
          const bf16x8 Xs = *(const bf16x8*)&ST[(16 * et + fr) * DK + 32 * ks + 8 * fq];
          O = mfma16(Xs, Yq[ks], O);
        }
        *(f32x4*)(outp + orow + 16 * et) = O;
      }
    } else {
      LDS_FENCE();
    }
    {
      bf16x8 Yv[4];
#pragma unroll
      for (int et = 0; et < 4; ++et) Yv[et] = fq < 2 ? *(const bf16x8*)&VT[(16 * et + fr) * 16 + 8 * fq] : zero8;
#pragma unroll
      for (int dt = 0; dt < NDT; ++dt) {
        const bf16x8 Xk = fq < 2 ? *(const bf16x8*)&KtT[(16 * dt + fr) * 16 + 8 * fq] : zero8;
        const f32x4 D4 = *(const f32x4*)&Dl[16 * dt + 4 * fq];
#pragma unroll
        for (int et = 0; et < 4; ++et) { S[dt][et] = mfma16(Xk, Yv[et], S[dt][et]); S[dt][et] = S[dt][et] * D4; }
      }
    }
  }
  if (!PASSC) {
#pragma unroll
    for (int dt = 0; dt < NDT; ++dt)
#pragma unroll
      for (int et = 0; et < 4; ++et)
#pragma unroll
        for (int j = 0; j < 4; ++j) Ustate[((size_t)task * DK + 16 * dt + 4 * fq + j) * 64 + 16 * et + fr] = S[dt][et][j];
    if (!RET && lane < DK) p.hgD()[(size_t)task * 64 + lane] = btot;
  }
}

template <bool PASSC>
__device__ __forceinline__ void ph_mix_tasks(const Params& p, int l) {
  const int TID = otid();
  const int wave = TID >> 6;
  unsigned char* wl = smem + wave * 17152;
  const int gw = blockIdx.x * NWAVES + wave, nw = gridDim.x * NWAVES;
  if (PASSC && l == 1) {
    for (int t = gw; t < 16 * 128; t += nw) chunk_task<64, PASSC, false>(p, l, (t >> 7) * NCHUNK + 4 + (t & 127), wl);
    for (int t = gw; t < 16 * 128; t += nw) chunk_task<32, PASSC, true>(p, l, (t >> 7) * NCHUNK + 4 + (t & 127), wl);
  } else {
    for (int t = gw; t < 16 * NCHUNK; t += nw) chunk_task<64, PASSC, false>(p, l, t, wl);
    for (int t = gw >= 64 ? gw - 64 : gw + nw - 64; t < 16 * NCHUNK; t += nw) chunk_task<32, PASSC, true>(p, l, t, wl);
  }
}

__device__ __forceinline__ void ph_scan(const Params& p, int l) {
  const int TID = otid();
  const int gtid = blockIdx.x * NTHREADS + TID, nthr = gridDim.x * NTHREADS;
  for (int idx = gtid; idx < 16 * 4096 + 16 * 2048; idx += nthr) {
    if (idx < 16 * 4096) {
      const int r = idx >> 12, de = idx & 4095, d = de >> 6;
      float s = 0.f;
      float* U = p.hgU() + (size_t)r * NCHUNK * 4096 + de;
      const float* D = p.hgD() + (size_t)r * NCHUNK * 64 + d;
      for (int j0 = 0; j0 < NCHUNK; j0 += 12) {
        float u[12], dd[12];
#pragma unroll
        for (int j = 0; j < 12; ++j) { u[j] = U[(size_t)(j0 + j) * 4096]; dd[j] = D[(j0 + j) * 64]; }
#pragma unroll
        for (int j = 0; j < 12; ++j) { U[(size_t)(j0 + j) * 4096] = s; s = fmaf(dd[j], s, u[j]); }
      }
    } else {
      const int i2 = idx - 16 * 4096;
      const int r = i2 >> 11, de = i2 & 2047, h = r & 3, dir = (r >> 2) & 1;
      const float gamma = sigmoidf_(p.in[I_RETDEC][(l * 2 + dir) * 4 + h]);
      const float g64 = powf(gamma, 64.0f);
      float s = 0.f;
      float* U = p.rtU() + (size_t)r * NCHUNK * 2048 + de;
      for (int j0 = 0; j0 < NCHUNK; j0 += 12) {
        float u[12];
#pragma unroll
        for (int j = 0; j < 12; ++j) u[j] = U[(size_t)(j0 + j) * 2048];
#pragma unroll
        for (int j = 0; j < 12; ++j) { U[(size_t)(j0 + j) * 2048] = s; s = fmaf(g64, s, u[j]); }
      }
    }
  }
}


__device__ __forceinline__ void ph_s5_scan(const Params& p, int l) {
  const int tid = otid();
  f32x2* xl = (f32x2*)smem;
  float* Tl = (float*)smem + 33 * 512 * 2;
  if (blockIdx.x < 128) {
    const int blk = blockIdx.x;
    const int phalf = blk & 1, dir = (blk >> 1) & 1, g = (blk >> 2) & 15, b = blk >> 6;
    const int pl = tid & 31, seg = tid >> 5, pp = phalf * 32 + pl;
    const int sidx = ((l * 2 + dir) * 16 + g) * 64 + pp;
    float ar = p.s5a()[sidx * 2], ai = p.s5a()[sidx * 2 + 1];
#pragma unroll
    for (int k = 0; k < 4; ++k) { const float nr = ar * ar - ai * ai, ni = 2.0f * ar * ai; ar = nr; ai = ni; }
    const unsigned colo = (unsigned)(dir * 128 + pp * 2);
    const char* xbase = (const char*)(p.sX() + (size_t)g * 1280 * 256);
    char* sbase = (char*)(p.sXS() + (size_t)g * 1280 * 256);
    const int sgn = dir ? -1 : 1, offC = b * 16 + (dir ? 15 : 0), offL = b * 512 + (dir ? 559 : 16);
    for (int i0 = 0; i0 < 33; i0 += 11) {
      f32x2 t[11];
#pragma unroll
      for (int k = 0; k < 11; ++k) {
        const int jj = seg * 33 + i0 + k;
        const int row = (jj < 16 ? offC : offL) + sgn * jj;
        t[k] = *(const f32x2*)(xbase + ((unsigned)row * 256u + colo) * 4u);
      }
#pragma unroll
      for (int k = 0; k < 11; ++k) xl[(i0 + k) * 512 + tid] = t[k];
    }
    float sr = 0.f, si = 0.f;
#pragma unroll 3
    for (int i = 0; i < 33; ++i) { const f32x2 t = xl[i * 512 + tid]; xl[i * 512 + tid] = (f32x2){sr, si}; const float nr = ar * sr - ai * si + t.x, ni = ar * si + ai * sr + t.y; sr = nr; si = ni; }
    Tl[tid * 2] = sr; Tl[tid * 2 + 1] = si;
    __syncthreads();
    float br = ar, bi = ai;
#pragma unroll
    for (int k = 0; k < 5; ++k) { const float nr = br * br - bi * bi, ni = 2.0f * br * bi; br = nr; bi = ni; }
    { const float nr = br * ar - bi * ai, ni = br * ai + bi * ar; br = nr; bi = ni; }
    float cr = 0.f, ci = 0.f;
    for (int s2 = 0; s2 < seg; ++s2) { const float tr = Tl[(s2 * 32 + pl) * 2], ti = Tl[(s2 * 32 + pl) * 2 + 1]; const float nr = br * cr - bi * ci + tr, ni = br * ci + bi * cr + ti; cr = nr; ci = ni; }
    float pr = 1.f, pi = 0.f;
#pragma unroll 3
    for (int i = 0; i < 33; ++i) {
      const int jj = seg * 33 + i;
      const int row = (jj < 16 ? offC : offL) + sgn * jj;
      const f32x2 x = xl[i * 512 + tid];
      const float vr = x.x + pr * cr - pi * ci, vi = x.y + pr * ci + pi * cr;
      *(unsigned*)(sbase + ((unsigned)row * 256u + colo) * 2u) = pk2(vr, vi);
      const float nr = pr * ar - pi * ai, ni = pr * ai + pi * ar; pr = nr; pi = ni;
    }
  }
}

__device__ __forceinline__ void cvt_item(const float* W, int ldw, bf16_t* WT, int ldt, int k0, int n0, int ilv, float* scr, int lane) {
  f32x4 v[8];
#pragma unroll
  for (int i = 0; i < 8; ++i) { const int pc = lane + 64 * i; v[i] = *(const f32x4*)(W + (size_t)(k0 + (pc >> 3)) * ldw + n0 + (pc & 7) * 4); }
#pragma unroll
  for (int i = 0; i < 8; ++i) { const int pc = lane + 64 * i; float* d = scr + (pc >> 3) * 33 + (pc & 7) * 4; d[0] = v[i].x; d[1] = v[i].y; d[2] = v[i].z; d[3] = v[i].w; }
  LDS_FENCE();
  const int c = lane & 7;
#pragma unroll
  for (int j = 0; j < 4; ++j) {
    const int n = (lane >> 3) + 8 * j;
    const float* s = scr + (8 * c) * 33 + n;
    uint4 o;
    o.x = pk2(s[0 * 33], s[1 * 33]); o.y = pk2(s[2 * 33], s[3 * 33]); o.z = pk2(s[4 * 33], s[5 * 33]); o.w = pk2(s[6 * 33], s[7 * 33]);
    const int nn = n0 + n;
    const int ilvm = ilv & 255;
    const int drow = ilvm == 0 ? nn : ilvm == 3 ? (nn < NMIX ? nn : NMIX + ((nn - NMIX) & 1023) * 4 + ((nn - NMIX) >> 10)) : ((nn >> 4) * 32 + (ilvm - 1) * 16 + (nn & 15));
    const int drow2 = (ilv & 256) && !((ilv & 255) == 3 && nn >= NMIX) ? ((drow & ~31) | (16 * ((drow >> 2) & 1) + 4 * ((drow >> 3) & 3) + (drow & 3))) : drow;
    *(uint4*)(WT + (size_t)drow2 * ldt + k0 + 8 * c) = o;
  }
  LDS_FENCE();
}
__device__ __forceinline__ void ph_cvt_static(const Params& p) {
  const int tid = otid(), lane = tid & 63, wave = tid >> 6;
  float* scr = (float*)smem + 4096 + wave * 2112;
  constexpr int I_IN = 16 * 224, I_BR = 4 * 4 * 32, I_OUT = 16 * 32, I_GLU = 2 * 4 * 8, I_L = I_IN + I_BR + I_OUT + I_GLU;
  for (int it = blockIdx.x * NWAVES + wave; it < 2 * I_L; it += gridDim.x * NWAVES) {
    const int l = it / I_L; int r = it % I_L;
    if (r < I_IN) { const int kb = r / 224, nb = r % 224; cvt_item(p.in[I_WIN] + (size_t)l * DM * NIN, NIN, p.WinT() + (size_t)l * NIN * DM, DM, kb * 64, nb * 32, 3 | 256, scr, lane); continue; }
    r -= I_IN;
    if (r < I_BR) { const int n = r / 128, q = r % 128, kb = q / 32, nb = q % 32;
      cvt_item(p.in[I_WBR] + (size_t)(l * 4 + n) * 256 * DM, DM, p.WbrT() + (size_t)(l * 4 + n) * DM * 256, 256, kb * 64, nb * 32, 256, scr, lane); continue; }
    r -= I_BR;
    if (r < I_OUT) { const int kb = r / 32, nb = r % 32; cvt_item(p.in[I_WOUT] + (size_t)l * DM * DM, DM, p.WoutT() + (size_t)l * DM * DM, DM, kb * 64, nb * 32, 0, scr, lane); continue; }
    r -= I_OUT;
    { const int which = r / 32, q = r % 32, kb = q / 8, nb = q % 8;
      cvt_item(p.in[which ? I_GLU2 : I_GLU1] + (size_t)l * 256 * 256, 256, p.GluT() + (size_t)l * 512 * 256, 256, kb * 64, nb * 32, 1 + which, scr, lane); }
  }
}
__device__ __forceinline__ void ph_cvt_moe(const Params& p, int l, int part, int vb, int nvb) {
  const int tid = otid(), lane = tid & 63, wave = tid >> 6;
  float* scr = (float*)smem + wave * 2112;
  if (part != 2) {
    for (int it = vb * NWAVES + wave; it < 32 * 512; it += nvb * NWAVES) {
      const int e = it >> 9, r = it & 511;
      const int which = r >> 8, q = r & 255, kb = q / 16, nb = q % 16;
      cvt_item(p.in[which ? I_MW3 : I_MW1] + (size_t)(l * 32 + e) * DM * 512, 512, p.W13T() + (size_t)e * DM * DM, DM, kb * 64, nb * 32, 1 + which, scr, lane);
    }
  }
  if (part != 1) {
    for (int it = vb * NWAVES + wave; it < 32 * 256; it += nvb * NWAVES) {
      const int e = it >> 8, r = it & 255;
      const int kb = r / 32, nb = r % 32;
      cvt_item(p.in[I_MW2] + (size_t)(l * 32 + e) * 512 * DM, DM, p.W2T() + (size_t)e * DM * 512, 512, kb * 64, nb * 32, 256, scr, lane);
    }
  }
}

namespace g8 {
constexpr int BM = 256, BK = 64, HALF = 128, HTB = HALF * BK * 2, STAGE_BYTES = 8 * HTB, NXCD = 8, WGM = 8;
__device__ __forceinline__ int lds_byte(int r, int c) { const int st = (r >> 4) * 2 + (c >> 5), rr = r & 15, cc = c & 31, ob = rr * 64 + cc * 2; return st * 1024 + (ob ^ (((ob >> 9) & 1) << 5)); }
__device__ __forceinline__ void stage_rc(int b, int& R, int& C) { const int st = b / 1024, sb = b % 1024, swz = sb ^ (((sb >> 9) & 1) << 5); R = (st >> 1) * 16 + swz / 64; C = (st & 1) * 32 + (swz % 64) / 2; }

struct Unit { const char* A; const char* B; int pm, pn, aux, keep, info; };
typedef f32x4 Acc[2][2][4][2];

__device__ __forceinline__ bool static_tile(int L, int nM, int nN, int& pm, int& pn) {
  const int nwg = nM * nN;
  if (L >= nwg) return false;
  int wgid = L; { const int q = nwg / NXCD, r = nwg % NXCD, xcd = wgid % NXCD, off = wgid / NXCD; wgid = (xcd < r ? xcd * (q + 1) : r * (q + 1) + (xcd - r) * q) + off; }
  const int nig = WGM * nN, gid = wgid / nig, fm = gid * WGM, gsz = (nM - fm) < WGM ? (nM - fm) : WGM;
  pm = fm + ((wgid % nig) % gsz); pn = (wgid % nig) / gsz;
  return true;
}

template <class Epi> __device__ __forceinline__ void epi_after(const Epi&, const Unit&, int) {}
template <class Src, class Epi>
__device__ __forceinline__ void gemm_stream(LAS unsigned char* lds, const Src& S, const Epi& E, const int K, const int ldb) {
  const int tid = otid(), wid = __builtin_amdgcn_readfirstlane(tid >> 6), lane = tid & 63, wr = wid >> 2, wc = wid & 3, fr = lane & 15, fq = lane >> 4;
  const int nt = K / BK;
  int Rs[2], Cs[2]; unsigned voffB[2];
#pragma unroll
  for (int i = 0; i < 2; ++i) { stage_rc(tid * 16 + i * 8192, Rs[i], Cs[i]); voffB[i] = (unsigned)(Rs[i] * ldb + Cs[i]) * 2u; }
  const size_t kstep = (size_t)(BK * 2);
  const size_t hstepB = (size_t)HALF * ldb * 2;
  const unsigned ldsw = (unsigned)wid * 1024u;
  const int aoff = lds_byte(wr * 64 + fr, fq * 8), boff = lds_byte(wc * 32 + fr, fq * 8);
#define G8_SA(b, h) (((b) * 2 + (h)) * HTB)
#define G8_SB(b, h) ((4 + (b) * 2 + (h)) * HTB)
#define G8_STAGE(bufoff, gbase, voff) do { _Pragma("unroll") for (int _i = 0; _i < 2; ++_i) \
        __builtin_amdgcn_global_load_lds((const unsigned*)((const char*)(gbase) + (voff)[_i]), (LAS unsigned*)(lds + (bufoff) + ldsw + _i * 8192), 16, 0, 0); } while (0)
#define G8_STAGE_A(bufoff, gbase, voff) do { _Pragma("unroll") for (int _i = 0; _i < 2; ++_i) \
        __builtin_amdgcn_global_load_lds((const unsigned*)((const char*)(gbase) + (voff)[_i]), (LAS unsigned*)(lds + (bufoff) + ldsw + _i * 8192), 16, 0, Src::AUXA); } while (0)
#define G8_LDA(dst, b, h) do { _Pragma("unroll") for (int m = 0; m < 4; ++m) _Pragma("unroll") for (int k = 0; k < 2; ++k) dst[m][k] = *(const LAS bf16x8*)(lds + G8_SA(b, h) + aoff + m * 2048 + k * 1024); } while (0)
#define G8_LDB(dst, b, h) do { _Pragma("unroll") for (int n = 0; n < 2; ++n) _Pragma("unroll") for (int k = 0; k < 2; ++k) dst[n][k] = *(const LAS bf16x8*)(lds + G8_SB(b, h) + boff + n * 2048 + k * 1024); } while (0)
#define G8_MMA(ai, bj, At, Bt) do { __builtin_amdgcn_s_setprio(1); _Pragma("unroll") for (int m = 0; m < 4; ++m) _Pragma("unroll") for (int n = 0; n < 2; ++n) _Pragma("unroll") for (int k = 0; k < 2; ++k) \
        acc[ai][bj][m][n] = __builtin_amdgcn_mfma_f32_16x16x32_bf16(Bt[n][k], At[m][k], acc[ai][bj][m][n], 0, 0, 0); __builtin_amdgcn_s_setprio(0); } while (0)
#define G8_WAIT_V(n) asm volatile("s_waitcnt vmcnt(" #n ")" ::: "memory")
#define G8_WAIT_L(n) asm volatile("s_waitcnt lgkmcnt(" #n ")" ::: "memory")
#define G8_BAR __builtin_amdgcn_s_barrier()
#define G8_SCHED __builtin_amdgcn_sched_barrier(0)
  Unit cur, nxt; int ui = 0;
  if (!S.next(0, cur)) return;
  unsigned vAc[2][2], vAn[2][2];
  S.voff(cur, Rs, Cs, vAc);
  Acc acc;
#pragma unroll
  for (int a = 0; a < 2; ++a)
#pragma unroll
    for (int b = 0; b < 2; ++b)
#pragma unroll
      for (int m = 0; m < 4; ++m)
#pragma unroll
        for (int n = 0; n < 2; ++n) acc[a][b][m][n] = (f32x4){0.f, 0.f, 0.f, 0.f};
  bf16x8 At[4][2], B0[2][2], B1[2][2];
  const char* cA = cur.A; const char* cB = cur.B;
  G8_STAGE(G8_SB(0, 0), cB, voffB); G8_STAGE_A(G8_SA(0, 0), cA, vAc[0]); G8_STAGE(G8_SB(0, 1), cB + hstepB, voffB); G8_STAGE_A(G8_SA(0, 1), cA, vAc[1]);
  if (wr == 1) G8_BAR;
  G8_WAIT_V(4); G8_BAR;
  G8_STAGE(G8_SB(1, 0), cB + kstep, voffB); G8_STAGE_A(G8_SA(1, 0), cA + kstep, vAc[0]); G8_STAGE(G8_SB(1, 1), cB + hstepB + kstep, voffB);
  G8_WAIT_V(6); G8_BAR;
  for (;;) {
    const bool has_next = S.next(ui + 1, nxt);
    if (has_next) S.voff(nxt, Rs, Cs, vAn);
    else { vAn[0][0] = vAc[0][0]; vAn[0][1] = vAc[0][1]; vAn[1][0] = vAc[1][0]; vAn[1][1] = vAc[1][1]; }
    const char* nA = has_next ? nxt.A : cA; const char* nB = has_next ? nxt.B : cB;
    for (int t = 0; t < nt; t += 2) {
      const bool last = (t == nt - 2);
      const char* a1 = cA + (size_t)(t + 1) * kstep;
      const char* a2 = last ? nA : cA + (size_t)(t + 2) * kstep; const char* b2 = last ? nB : cB + (size_t)(t + 2) * kstep;
      const char* a3 = a2 + kstep; const char* b3 = b2 + kstep;
      unsigned va2[2][2];
      va2[0][0] = last ? vAn[0][0] : vAc[0][0]; va2[0][1] = last ? vAn[0][1] : vAc[0][1]; va2[1][0] = last ? vAn[1][0] : vAc[1][0]; va2[1][1] = last ? vAn[1][1] : vAc[1][1];
      G8_LDB(B0, 0, 0); G8_SCHED; G8_LDA(At, 0, 0); G8_STAGE_A(G8_SA(1, 1), a1, vAc[1]);
      G8_WAIT_L(8); G8_BAR; G8_WAIT_L(0); G8_MMA(0, 0, At, B0); G8_BAR; G8_SCHED;
      G8_LDB(B1, 0, 1); G8_STAGE(G8_SB(0, 0), b2, voffB);
      G8_BAR; G8_WAIT_L(0); G8_MMA(0, 1, At, B1); G8_BAR;
      G8_LDA(At, 0, 1); G8_STAGE_A(G8_SA(0, 0), a2, va2[0]);
      G8_BAR; G8_WAIT_L(0); G8_MMA(1, 0, At, B0); G8_BAR; G8_SCHED;
      G8_STAGE(G8_SB(0, 1), b2 + hstepB, voffB);
      G8_WAIT_V(6); G8_BAR; G8_MMA(1, 1, At, B1); G8_BAR;
      G8_LDB(B0, 1, 0); G8_SCHED; G8_LDA(At, 1, 0); G8_STAGE_A(G8_SA(0, 1), a2, va2[1]);
      G8_WAIT_L(8); G8_BAR; G8_WAIT_L(0); G8_MMA(0, 0, At, B0); G8_BAR; G8_SCHED;
      G8_LDB(B1, 1, 1); G8_STAGE(G8_SB(1, 0), b3, voffB);
      G8_BAR; G8_WAIT_L(0); G8_MMA(0, 1, At, B1); G8_BAR;
      G8_LDA(At, 1, 1); G8_STAGE_A(G8_SA(1, 0), a3, va2[0]);
      G8_BAR; G8_WAIT_L(0); G8_MMA(1, 0, At, B0); G8_BAR; G8_SCHED;
      G8_STAGE(G8_SB(1, 1), b3 + hstepB, voffB);
      G8_WAIT_V(6); G8_BAR; G8_MMA(1, 1, At, B1); G8_BAR;
    }
    E(acc, cur, wr, wc, fr, fq);
    epi_after(E, cur, tid);
    if (!has_next) break;
    if (!cur.keep) {
#pragma unroll
      for (int a = 0; a < 2; ++a)
#pragma unroll
        for (int b = 0; b < 2; ++b)
#pragma unroll
          for (int m = 0; m < 4; ++m)
#pragma unroll
            for (int n = 0; n < 2; ++n) acc[a][b][m][n] = (f32x4){0.f, 0.f, 0.f, 0.f};
    }
    cur = nxt; cA = nA; cB = nB; ++ui;
    vAc[0][0] = vAn[0][0]; vAc[0][1] = vAn[0][1]; vAc[1][0] = vAn[1][0]; vAc[1][1] = vAn[1][1];
  }
  G8_WAIT_V(0);
  if (wr == 0) G8_BAR;
  G8_BAR;
#undef G8_SA
#undef G8_SB
#undef G8_STAGE
#undef G8_STAGE_A
#undef G8_LDA
#undef G8_LDB
#undef G8_MMA
#undef G8_WAIT_V
#undef G8_WAIT_L
#undef G8_BAR
#undef G8_SCHED
}

struct DenseSrc {
  static constexpr int AUXA = 0;
  const bf16_t* A; const bf16_t* B; int lda, ldb, nM, nN, G, c;
  __device__ __forceinline__ bool next(int i, Unit& u) const {
    int pm, pn;
    if (!static_tile(i * G + c, nM, nN, pm, pn)) return false;
    u.A = (const char*)(A + (size_t)pm * 256 * lda); u.B = (const char*)(B + (size_t)pn * 256 * ldb); u.pm = pm; u.pn = pn; u.aux = 0; u.keep = 0; u.info = 0;
    return true;
  }
  __device__ __forceinline__ void voff(const Unit&, const int (&R)[2], const int (&C)[2], unsigned (&v)[2][2]) const {
#pragma unroll
    for (int h = 0; h < 2; ++h)
#pragma unroll
      for (int i = 0; i < 2; ++i) v[h][i] = (unsigned)((h * 128 + R[i]) * lda + C[i]) * 2u;
  }
};
struct MergeSrc {
  static constexpr int AUXA = 0;
  const bf16_t* A; const bf16_t* B; int nM, G, c;
  __device__ __forceinline__ bool next(int i, Unit& u) const {
    int pm, pn;
    if (!static_tile((i >> 2) * G + c, nM, 4, pm, pn)) return false;
    const int n = i & 3;
    u.A = (const char*)(A + (size_t)pm * 256 * DM + n * 256); u.B = (const char*)(B + ((size_t)n * DM + pn * 256) * 256); u.pm = pm; u.pn = pn; u.aux = n; u.keep = n < 3; u.info = 0;
    return true;
  }
  __device__ __forceinline__ void voff(const Unit&, const int (&R)[2], const int (&C)[2], unsigned (&v)[2][2]) const {
#pragma unroll
    for (int h = 0; h < 2; ++h)
#pragma unroll
      for (int i = 0; i < 2; ++i) v[h][i] = (unsigned)((h * 128 + R[i]) * DM + C[i]) * 2u;
  }
};
__device__ __forceinline__ void moe_build_table(const int* cnt) {
  const int TID = otid();
  int* tb = (int*)(smem + 131072);
  __syncthreads();
  if (TID < 32) tb[TID * 4 + 2] = cnt[TID * 32];
  __syncthreads();
  if (TID < 64) {
    const int lane = TID;
    const int ce = lane < 32 ? tb[lane * 4 + 2] : 0;
    int pre = ce;
#pragma unroll
    for (int o = 1; o < 32; o <<= 1) { const int t = __shfl_up(pre, o); if ((lane & 31) >= o) pre += t; }
    if (lane < 32) tb[lane * 4 + 1] = pre - ce;
    const int key = (lane < 32 && ce > 0) ? (ce * 64 + (63 - lane)) : -1;
    int rank = 0;
#pragma unroll
    for (int j = 0; j < 32; ++j) rank += (__builtin_amdgcn_readlane(key, j) > key) ? 1 : 0;
    const int nact = __popcll(__ballot(key >= 0));
    int gl[8], gc[8];
#pragma unroll
    for (int x = 0; x < 8; ++x) { gl[x] = 0; gc[x] = 0; }
    for (int it = 0; it < nact; ++it) {
      const unsigned long long msk = __ballot(key >= 0 && rank == it);
      const int be = __builtin_amdgcn_readfirstlane(__ffsll((long long)msk) - 1);
      const int bc = __builtin_amdgcn_readlane(ce, be);
      int bx = 0, bl = gl[0];
#pragma unroll
      for (int x = 1; x < 8; ++x) if (gl[x] < bl) { bl = gl[x]; bx = x; }
      int gcb = gc[0];
#pragma unroll
      for (int x = 1; x < 8; ++x) gcb = (bx == x) ? gc[x] : gcb;
      if (lane == 0) { int* g = tb + 256 + bx * 80; g[2 + gcb] = be; g[40 + gcb] = bl; }
      const int add = (bc + 255) >> 8;
#pragma unroll
      for (int x = 0; x < 8; ++x) { gl[x] += (bx == x) ? add : 0; gc[x] += (bx == x) ? 1 : 0; }
    }
    if (lane < 8) {
      int c = gc[0], l = gl[0];
#pragma unroll
      for (int x = 1; x < 8; ++x) { c = (lane == x) ? gc[x] : c; l = (lane == x) ? gl[x] : l; }
      tb[256 + lane * 80] = c; tb[256 + lane * 80 + 1] = l;
    }
  }
  __syncthreads();
}
template <bool GATHER>
struct MoeSrc {
  static constexpr int AUXA = GATHER ? 0 : 16;
  const int* alist; const bf16_t* A; const bf16_t* B; int lda, ldb, G, c; size_t bexp;
  const int* flags;
  __device__ __forceinline__ bool next(int i, Unit& u) const {
    const int* tb = (const int*)(smem + 131072);
    const int x = c & 7, j = c >> 3, per = G >> 3;
    const int* g = tb + 256 + x * 80;
    int q = i * per + j;
    if (!GATHER) {
      const int U = 4 * __builtin_amdgcn_readfirstlane(g[1]), h = U % per, nl = per - h;
      q = j < nl ? (i == 0 ? j : nl + (i - 1) * per + j) : nl + i * per + j;
    }
    const int tq = q >> 2, pn = q & 3;
    if (tq >= __builtin_amdgcn_readfirstlane(g[1])) return false;
    const int ng = __builtin_amdgcn_readfirstlane(g[0]);
    int k = 0;
    for (int kk = 1; kk < ng; ++kk) if (__builtin_amdgcn_readfirstlane(g[40 + kk]) <= tq) k = kk;
    const int e = __builtin_amdgcn_readfirstlane(g[2 + k]), t0 = __builtin_amdgcn_readfirstlane(g[40 + k]);
    const int s0 = __builtin_amdgcn_readfirstlane(tb[e * 4 + 1]), ce = __builtin_amdgcn_readfirstlane(tb[e * 4 + 2]);
    const int r0 = (tq - t0) * 256;
    u.aux = s0 + r0; u.pm = min(256, ce - r0); u.pn = pn; u.keep = 0; u.info = (e << 16) | r0 | tq;
    if (!GATHER) {
      const int* f = flags + x * 256 + tq;
      while (__hip_atomic_load(f, __ATOMIC_RELAXED, __HIP_MEMORY_SCOPE_AGENT) < 4) __builtin_amdgcn_s_sleep(2);
      asm volatile("" ::: "memory");
    }
    u.A = (const char*)A; u.B = (const char*)(B + (size_t)e * bexp + (size_t)pn * 256 * ldb);
    return true;
  }
  __device__ __forceinline__ void voff(const Unit& u, const int (&R)[2], const int (&C)[2], unsigned (&v)[2][2]) const {
    const int e = u.info >> 16, r0 = u.info & 0xff00;
#pragma unroll
    for (int h = 0; h < 2; ++h)
#pragma unroll
      for (int i = 0; i < 2; ++i) {
        const int r = min(h * 128 + R[i], u.pm - 1);
        const int row = GATHER ? (alist[e * NTOK + r0 + r] >> 1) : (u.aux + r);
        v[h][i] = (unsigned)(row * lda + C[i]) * 2u;
      }
  }
};
#define G8_FOREACH(...)                                                                                           \
  _Pragma("unroll") for (int ai = 0; ai < 2; ++ai) _Pragma("unroll") for (int m = 0; m < 4; ++m) {                  \
    const int trow = ai * 128 + wr * 64 + m * 16 + fr;                                                            \
    _Pragma("unroll") for (int bj = 0; bj < 2; ++bj) _Pragma("unroll") for (int n = 0; n < 2; ++n) {                \
      const int tcol = bj * 128 + wc * 32 + n * 16 + fq * 4;                                                      \
      const f32x4 v = acc[ai][bj][m][n];                                                                          \
      __VA_ARGS__                                                                                                     \
    }                                                                                                             \
  }
#define G8_FOREACH_P(...)                                                                                         \
  _Pragma("unroll") for (int ai = 0; ai < 2; ++ai) _Pragma("unroll") for (int m = 0; m < 4; ++m) {                  \
    const int trow = ai * 128 + wr * 64 + m * 16 + fr;                                                            \
    _Pragma("unroll") for (int bj = 0; bj < 2; ++bj) {                                                              \
      const int tcol8 = bj * 128 + wc * 32 + fq * 8;                                                              \
      const f32x4 v0 = acc[ai][bj][m][0], v1 = acc[ai][bj][m][1];                                                 \
      __VA_ARGS__                                                                                                 \
    }                                                                                                             \
  }
struct EpiF32 {
  float* C; int ldc;
  __device__ __forceinline__ void operator()(Acc& acc, const Unit& u, int wr, int wc, int fr, int fq) const {
    G8_FOREACH({ *(f32x4*)(C + (size_t)(u.pm * 256 + trow) * ldc + u.pn * 256 + tcol) = v; })
  }
};
struct EpiBf16 {
  bf16_t* O; int ldc;
  __device__ __forceinline__ void operator()(Acc& acc, const Unit& u, int wr, int wc, int fr, int fq) const {
    G8_FOREACH({ *(uint2*)(O + (size_t)(u.pm * 256 + trow) * ldc + u.pn * 256 + tcol) = make_uint2(pk2(v.x, v.y), pk2(v.z, v.w)); })
  }
};
struct EpiZmix {
  bf16_t* Z; float* hyT; bf16_t* s5u;
  __device__ __forceinline__ void operator()(Acc& acc, const Unit& u, int wr, int wc, int fr, int fq) const {
    if (u.pn == 11) {
      G8_FOREACH_P({
        const int tok = u.pm * 256 + trow;
        *(uint4*)(s5u + ((size_t)(tcol8 >> 4) * 1280 + (tok >> 4)) * 256 + (tok & 15) * 16 + (tcol8 & 15)) = make_uint4(pk2(v0.x, v0.y), pk2(v0.z, v0.w), pk2(v1.x, v1.y), pk2(v1.z, v1.w));
      })
    } else if (u.pn >= 5 && u.pn <= 7 && u.pm >= 2) {
      G8_FOREACH_P({
        float* d = hyT + (size_t)((u.pn - 5) * 256 + tcol8) * NLAT + (u.pm * 256 + trow - NCTX);
        d[0] = v0.x; d[NLAT] = v0.y; d[2 * NLAT] = v0.z; d[3 * NLAT] = v0.w;
        d[4 * NLAT] = v1.x; d[5 * NLAT] = v1.y; d[6 * NLAT] = v1.z; d[7 * NLAT] = v1.w;
      })
    } else {
      G8_FOREACH_P({ *(uint4*)(Z + (size_t)(u.pm * 256 + trow) * NMIX + u.pn * 256 + tcol8) = make_uint4(pk2(v0.x, v0.y), pk2(v0.z, v0.w), pk2(v1.x, v1.y), pk2(v1.z, v1.w)); })
    }
  }
};
struct EpiGlu {
  bf16_t* O;
  __device__ __forceinline__ void operator()(Acc& acc, const Unit& u, int wr, int wc, int fr, int fq) const {
#pragma unroll
    for (int ai = 0; ai < 2; ++ai)
#pragma unroll
      for (int m = 0; m < 4; ++m) {
        const int trow = ai * 128 + wr * 64 + m * 16 + fr;
#pragma unroll
        for (int bj = 0; bj < 2; ++bj) {
          const f32x4 a = acc[ai][bj][m][0], b = acc[ai][bj][m][1];
          const int oc = (u.pn * 256 + bj * 128 + wc * 32) / 2 + fq * 4;
          *(uint2*)(O + (size_t)(u.pm * 256 + trow) * DM + 768 + oc) =
              make_uint2(pk2(a.x * sigmoidf_(b.x), a.y * sigmoidf_(b.y)), pk2(a.z * sigmoidf_(b.z), a.w * sigmoidf_(b.w)));
        }
      }
  }
};
struct EpiGates {
  bf16_t* gf;
  int tok_lo;
  __device__ __forceinline__ void operator()(Acc& acc, const Unit& u, int wr, int wc, int fr, int fq) const {
    const bool b0 = fq & 1, b1 = fq & 2;
    bf16_t* base = gf + ((size_t)fq * NTOK + tok_lo + u.pm * 256 + wr * 64 + fr) * 1024 + ((u.pn * 256 + wc * 32) >> 2);
#pragma unroll
    for (int ai = 0; ai < 2; ++ai)
#pragma unroll
      for (int m = 0; m < 4; ++m) {
        bf16_t* rowp = base + (size_t)(ai * 128 + m * 16) * 1024;
        asm volatile("" : "+v"(rowp));
#pragma unroll
        for (int bj = 0; bj < 2; ++bj) {
          unsigned pw[2][2];
#pragma unroll
          for (int n = 0; n < 2; ++n) {
            const f32x4 v = acc[ai][bj][m][n];
            const float e0 = __builtin_amdgcn_exp2f(-1.4426950408889634f * v.x), e1 = __builtin_amdgcn_exp2f(-1.4426950408889634f * v.y);
            const float e2 = __builtin_amdgcn_exp2f(-1.4426950408889634f * v.z), e3 = __builtin_amdgcn_exp2f(-1.4426950408889634f * v.w);
            float F[4];
            F[0] = (1.0f + e1) * __builtin_amdgcn_rcpf(1.0f + e0); F[1] = (1.0f + e2) * __builtin_amdgcn_rcpf(1.0f + e1);
            F[2] = (1.0f + e3) * __builtin_amdgcn_rcpf(1.0f + e2); F[3] = __builtin_amdgcn_rcpf(1.0f + e3);
            const float sa0 = b0 ? F[0] : F[1], sa1 = b0 ? F[2] : F[3];
            const float ra0 = __shfl_xor(sa0, 16), ra1 = __shfl_xor(sa1, 16);
            const float x00 = b0 ? ra0 : F[0], x01 = b0 ? F[1] : ra0, x10 = b0 ? ra1 : F[2], x11 = b0 ? F[3] : ra1;
            const float sb0 = b1 ? x00 : x10, sb1 = b1 ? x01 : x11;
            const float rb0 = __shfl_xor(sb0, 32), rb1 = __shfl_xor(sb1, 32);
            const float y00 = b1 ? rb0 : x00, y01 = b1 ? rb1 : x01, y10 = b1 ? x10 : rb0, y11 = b1 ? x11 : rb1;
            pw[n][0] = pk2(y00, y01); pw[n][1] = pk2(y10, y11);
          }
          *(uint4*)(rowp + bj * 32) = make_uint4(pw[0][0], pw[0][1], pw[1][0], pw[1][1]);
        }
      }
  }
};
template <bool COH>
struct EpiMerge {
  const bf16_t* gf;
  bf16_t* O;
  int tok_lo;
  int* flags;
  __device__ __forceinline__ void operator()(Acc& acc, const Unit& u, int wr, int wc, int fr, int fq) const {
    const int n = u.aux;
    const bf16_t* gp = gf + ((size_t)n * NTOK + tok_lo + u.pm * 256 + wr * 64 + fr) * 1024 + u.pn * 256 + wc * 32 + fq * 8;
    bf16_t* op = O + (size_t)(u.pm * 256 + wr * 64 + fr) * DM + u.pn * 256 + wc * 32 + fq * 8;
#pragma unroll
    for (int ai = 0; ai < 2; ++ai) {
      const bf16_t* gpa = gp + (size_t)ai * 128 * 1024;
      bf16_t* opa = op + (size_t)ai * 128 * DM;
      asm volatile("" : "+v"(gpa), "+v"(opa));
      uint4 g[4][2];
#pragma unroll
      for (int m = 0; m < 4; ++m)
#pragma unroll
        for (int bj = 0; bj < 2; ++bj) g[m][bj] = *(const uint4*)(gpa + m * 16 * 1024 + bj * 128);
#pragma unroll
      for (int m = 0; m < 4; ++m)
#pragma unroll
        for (int bj = 0; bj < 2; ++bj) {
          const uint4 a = g[m][bj];
          f32x4 v0 = acc[ai][bj][m][0], v1 = acc[ai][bj][m][1];
          v0.x *= __uint_as_float(a.x << 16); v0.y *= __uint_as_float(a.x & 0xffff0000u); v0.z *= __uint_as_float(a.y << 16); v0.w *= __uint_as_float(a.y & 0xffff0000u);
          v1.x *= __uint_as_float(a.z << 16); v1.y *= __uint_as_float(a.z & 0xffff0000u); v1.z *= __uint_as_float(a.w << 16); v1.w *= __uint_as_float(a.w & 0xffff0000u);
          if (n < 3) { acc[ai][bj][m][0] = v0; acc[ai][bj][m][1] = v1; }
          else if (COH) {
            u32x4 pv; pv.x = pk2(v0.x, v0.y); pv.y = pk2(v0.z, v0.w); pv.z = pk2(v1.x, v1.y); pv.w = pk2(v1.z, v1.w);
            asm volatile("global_store_dwordx4 %0, %1, off sc1" :: "v"(opa + m * 16 * DM + bj * 128), "v"(pv) : "memory");
          }
          else *(uint4*)(opa + m * 16 * DM + bj * 128) = make_uint4(pk2(v0.x, v0.y), pk2(v0.z, v0.w), pk2(v1.x, v1.y), pk2(v1.z, v1.w));
        }
    }
  }
};
template <bool COH> __device__ __forceinline__ void epi_after(const EpiMerge<COH>& E, const Unit& u, int tid) {
  if (COH && u.aux == 3) {
    asm volatile("s_waitcnt vmcnt(0)" ::: "memory");
    __builtin_amdgcn_s_barrier();
    if (tid == 256) { atomicAdd(E.flags + u.pm, 1); }
  }
}
template <bool COH>
struct WoutSrc {
  static constexpr int AUXA = COH ? 16 : 0;
  const bf16_t* A; const bf16_t* B; int lda, ldb, nM, nN, G, c; const int* flags;
  __device__ __forceinline__ bool next(int i, Unit& u) const {
    int pm, pn;
    if (!static_tile(i * G + c, nM, nN, pm, pn)) return false;
    u.A = (const char*)(A + (size_t)pm * 256 * lda); u.B = (const char*)(B + (size_t)pn * 256 * ldb); u.pm = pm; u.pn = pn; u.aux = 0; u.keep = 0; u.info = 0;
    if (COH) {
      while (__hip_atomic_load(flags + pm, __ATOMIC_RELAXED, __HIP_MEMORY_SCOPE_AGENT) < 4) __builtin_amdgcn_s_sleep(2);
      asm volatile("" ::: "memory");
    }
    return true;
  }
  __device__ __forceinline__ void voff(const Unit&, const int (&R)[2], const int (&C)[2], unsigned (&v)[2][2]) const {
#pragma unroll
    for (int h = 0; h < 2; ++h)
#pragma unroll
      for (int i = 0; i < 2; ++i) v[h][i] = (unsigned)((h * 128 + R[i]) * lda + C[i]) * 2u;
  }
};
struct EpiWout {
  float* X; const float* mod_l; int tok_lo; const float* Rc; const float* Rx;
  __device__ __forceinline__ void operator()(Acc& acc, const Unit& u, int wr, int wc, int fr, int fq) const {
    const float* grow = mod_l + (size_t)tok_mod_row(tok_lo + u.pm * 256) * 6144 + 2 * 1024 + u.pn * 256 + wc * 32 + fq * 4;
    f32x4 g[2][2];
#pragma unroll
    for (int bj = 0; bj < 2; ++bj)
#pragma unroll
      for (int n = 0; n < 2; ++n) g[bj][n] = *(const f32x4*)(grow + bj * 128 + n * 16);
#pragma unroll
    for (int ai = 0; ai < 2; ++ai)
#pragma unroll
      for (int mh = 0; mh < 2; ++mh) {
        f32x4 xv[2][2][2];
#pragma unroll
        for (int m2 = 0; m2 < 2; ++m2)
#pragma unroll
          for (int bj = 0; bj < 2; ++bj)
#pragma unroll
            for (int n = 0; n < 2; ++n)
              xv[m2][bj][n] = *(const f32x4*)(((tok_lo + u.pm * 256) < NCTX ? Rc : Rx) + (size_t)(u.pm * 256 + ai * 128 + wr * 64 + (mh * 2 + m2) * 16 + fr) * DM + u.pn * 256 + bj * 128 + wc * 32 + n * 16 + fq * 4);
#pragma unroll
        for (int m2 = 0; m2 < 2; ++m2)
#pragma unroll
          for (int bj = 0; bj < 2; ++bj)
#pragma unroll
            for (int n = 0; n < 2; ++n)
              *(f32x4*)(X + (size_t)(u.pm * 256 + ai * 128 + wr * 64 + (mh * 2 + m2) * 16 + fr) * DM + u.pn * 256 + bj * 128 + wc * 32 + n * 16 + fq * 4) =
                  xv[m2][bj][n] + g[bj][n] * acc[ai][bj][mh * 2 + m2][n];
      }
  }
};
struct EpiMoe1 {
  bf16_t* hid; int* flags;
  __device__ __forceinline__ void operator()(Acc& acc, const Unit& u, int wr, int wc, int fr, int fq) const {
    const bool odd = fq & 1;
    bf16_t* base = hid + (size_t)(u.aux + wr * 64 + fr) * 512 + u.pn * 128 + (odd ? 64 : 0) + wc * 16 + (fq >> 1) * 8;
#pragma unroll
    for (int ai = 0; ai < 2; ++ai)
#pragma unroll
      for (int m = 0; m < 4; ++m) {
        const int trow = ai * 128 + wr * 64 + m * 16 + fr;
        unsigned P[2][2];
#pragma unroll
        for (int bj = 0; bj < 2; ++bj) {
          const f32x4 a = acc[ai][bj][m][0], b = acc[ai][bj][m][1];
          P[bj][0] = pk2(siluf_(a.x) * b.x, siluf_(a.y) * b.y); P[bj][1] = pk2(siluf_(a.z) * b.z, siluf_(a.w) * b.w);
        }
        const unsigned s0 = odd ? P[0][0] : P[1][0], s1 = odd ? P[0][1] : P[1][1];
        const unsigned r0 = __shfl_xor(s0, 16), r1 = __shfl_xor(s1, 16);
        u32x4 pv;
        pv.x = odd ? r0 : P[0][0]; pv.y = odd ? r1 : P[0][1]; pv.z = odd ? P[1][0] : r0; pv.w = odd ? P[1][1] : r1;
        if (trow < u.pm) {
          bf16_t* dst = base + (size_t)(ai * 128 + m * 16) * 512;
          asm volatile("global_store_dwordx4 %0, %1, off sc1" :: "v"(dst), "v"(pv) : "memory");
        }
      }
  }
};
__device__ __forceinline__ void epi_after(const EpiMoe1& E, const Unit& u, int tid) {
  asm volatile("s_waitcnt vmcnt(0)" ::: "memory");
  __builtin_amdgcn_s_barrier();
  if (tid == 256) { atomicAdd(E.flags + ((int)blockIdx.x & 7) * 256 + (u.info & 255), 1); }
}
struct EpiMoe2 {
  bf16_t* ybuf; const float* rw; const int* alist; int* aslot;
  __device__ __forceinline__ void operator()(Acc& acc, const Unit& u, int wr, int wc, int fr, int fq) const {
    const int e = u.info >> 16, r0 = u.info & 0xff00;
    int as[2][4]; float ws[2][4];
#pragma unroll
    for (int ai = 0; ai < 2; ++ai)
#pragma unroll
      for (int m = 0; m < 4; ++m) { const int trow = ai * 128 + wr * 64 + m * 16 + fr; as[ai][m] = alist[e * NTOK + r0 + min(trow, u.pm - 1)]; }
#pragma unroll
    for (int ai = 0; ai < 2; ++ai)
#pragma unroll
      for (int m = 0; m < 4; ++m) ws[ai][m] = rw[as[ai][m]];
#pragma unroll
    for (int ai = 0; ai < 2; ++ai)
#pragma unroll
      for (int m = 0; m < 4; ++m) {
        const int trow = ai * 128 + wr * 64 + m * 16 + fr;
        if (trow < u.pm) {
          if (u.pn == 0 && wc == 0 && fq == 0) aslot[as[ai][m]] = u.aux + trow;
          bf16_t* yrow = ybuf + (size_t)(u.aux + trow) * DM + u.pn * 256 + wc * 32 + fq * 8;
#pragma unroll
          for (int bj = 0; bj < 2; ++bj) {
            const f32x4 v0 = acc[ai][bj][m][0] * ws[ai][m], v1 = acc[ai][bj][m][1] * ws[ai][m];
            *(uint4*)(yrow + bj * 128) = make_uint4(pk2(v0.x, v0.y), pk2(v0.z, v0.w), pk2(v1.x, v1.y), pk2(v1.z, v1.w));
          }
        }
      }
  }
};
struct S5Src {
  static constexpr int AUXA = 0;
  const bf16_t* U; const bf16_t* XS; const bf16_t* M1; const bf16_t* M2; int two, G, c;
  __device__ __forceinline__ bool next(int i, Unit& u) const {
    const int L = (two ? (i >> 1) : i) * G + c;
    if (L >= 80) return false;
    const int g = L / 5, rt = L % 5, sub = two ? (i & 1) : 0;
    u.A = (const char*)((sub ? XS : U) + ((size_t)g * 1280 + rt * 256) * 256);
    u.B = (const char*)((sub ? M2 : M1) + (size_t)g * 65536);
    u.pm = rt; u.pn = 0; u.aux = g; u.keep = two && sub == 0; u.info = sub;
    return true;
  }
  __device__ __forceinline__ void voff(const Unit&, const int (&R)[2], const int (&C)[2], unsigned (&v)[2][2]) const {
#pragma unroll
    for (int h = 0; h < 2; ++h)
#pragma unroll
      for (int i = 0; i < 2; ++i) v[h][i] = (unsigned)((h * 128 + R[i]) * 256 + C[i]) * 2u;
  }
};
struct EpiS5X {
  float* X;
  __device__ __forceinline__ void operator()(Acc& acc, const Unit& u, int wr, int wc, int fr, int fq) const {
    G8_FOREACH({ *(f32x4*)(X + ((size_t)u.aux * 1280 + u.pm * 256 + trow) * 256 + tcol) = v; })
  }
};
struct EpiS5Y {
  bf16_t* s5g;
  __device__ __forceinline__ void operator()(Acc& acc, const Unit& u, int wr, int wc, int fr, int fq) const {
    if (u.info == 0) return;
    G8_FOREACH({
      const int row = u.pm * 256 + trow;
      if (row < NTOK / 16) {
        const int tok = row * 16 + (tcol >> 4);
        *(uint2*)(s5g + (size_t)tok * 256 + u.aux * 16 + (tcol & 15)) = make_uint2(pk2(gelu_tanh(v.x), gelu_tanh(v.y)), pk2(gelu_tanh(v.z), gelu_tanh(v.w)));
      }
    })
  }
};
}

__device__ __forceinline__ void ph_gemm_s5_pass1(const Params& p, int l) {
  g8::S5Src S{p.s5u(), p.sXS(), p.s5Nn() + (size_t)l * 16 * 65536, p.s5Nn(), 0, (int)gridDim.x, (int)(gridDim.x - 1 - blockIdx.x)};
  g8::EpiS5X E{p.sX()};
  g8::gemm_stream((LAS unsigned char*)smem, S, E, 256, 256);
}
__device__ __forceinline__ void ph_gemm_s5_pass2(const Params& p, int l) {
  g8::S5Src S{p.s5u(), p.sXS(), p.s5Tz() + (size_t)l * 16 * 65536, p.s5Mm() + (size_t)l * 16 * 65536, 1, (int)gridDim.x, (int)(gridDim.x - 1 - blockIdx.x)};
  g8::EpiS5Y E{p.s5g()};
  g8::gemm_stream((LAS unsigned char*)smem, S, E, 256, 256);
}
__device__ __forceinline__ void ph_gemm_zmix(const Params& p, int l) {
  g8::DenseSrc S{p.hbf(), p.WinT() + (size_t)l * NIN * DM, DM, DM, NTOK / 256, NMIX / 256, (int)gridDim.x, (int)blockIdx.x};
  g8::EpiZmix E{p.zmix(), p.hyT(), p.s5u()};
  g8::gemm_stream((LAS unsigned char*)smem, S, E, DM, DM);
}
__device__ __forceinline__ void ph_gemm_gates_glu(const Params& p, int l, int tok_lo) {
  const int nM = (NTOK - tok_lo) / 256;
  {
    g8::DenseSrc S{p.hbf() + (size_t)tok_lo * DM, p.WinT() + ((size_t)l * NIN + NMIX) * DM, DM, DM, nM, 16, (int)gridDim.x, (int)blockIdx.x};
    g8::EpiGates E{p.gates(), tok_lo};
    g8::gemm_stream((LAS unsigned char*)smem, S, E, DM, DM);
  }
  {
    g8::DenseSrc S{p.s5g() + (size_t)tok_lo * 256, p.GluT() + (size_t)l * 512 * 256, 256, 256, nM, 2, (int)gridDim.x, (int)(gridDim.x - 1 - blockIdx.x)};
    g8::EpiGlu E{p.br() + (size_t)tok_lo * DM};
    g8::gemm_stream((LAS unsigned char*)smem, S, E, 256, 256);
  }
}
__device__ __forceinline__ void ph_gemm_merge(const Params& p, int l, int tok_lo) {
  g8::MergeSrc S{p.br() + (size_t)tok_lo * DM, p.WbrT() + (size_t)l * 4 * DM * 256, (NTOK - tok_lo) / 256, (int)gridDim.x, (int)blockIdx.x};
  g8::EpiMerge<true> E{p.gates(), p.merged() + (size_t)tok_lo * DM, tok_lo, p.mflag() + 4096 + l * 128}; g8::gemm_stream((LAS unsigned char*)smem, S, E, 256, 256);
}
__device__ __forceinline__ void ph_gemm_wout(const Params& p, int l, int tok_lo) {
  g8::EpiWout E{p.xbuf() + (size_t)tok_lo * DM, p.mod() + (size_t)l * 3 * 6144, tok_lo,
                l == 0 ? p.in[I_CTX] : p.xbuf() + (size_t)tok_lo * DM, l == 0 ? p.in[I_X] - (size_t)NCTX * DM : p.xbuf() + (size_t)tok_lo * DM};
  g8::WoutSrc<true> S{p.merged() + (size_t)tok_lo * DM, p.WoutT() + (size_t)l * DM * DM, DM, DM, (NTOK - tok_lo) / 256, 4, (int)gridDim.x, l == 0 ? (int)((blockIdx.x + gridDim.x - 8) % gridDim.x) : (int)blockIdx.x, p.mflag() + 4096 + l * 128};
  g8::gemm_stream((LAS unsigned char*)smem, S, E, DM, DM);
}
__device__ __forceinline__ void ph_gemm_moe1(const Params& p, int l) {
  g8::moe_build_table(p.cnt() + l * 32 * 32);
  g8::MoeSrc<true> S{p.alist(), p.hbf(), p.W13T(), DM, DM, (int)gridDim.x, (int)blockIdx.x, (size_t)DM * DM, nullptr};
  g8::EpiMoe1 E{p.hid(), p.mflag() + l * 2048};
  g8::gemm_stream((LAS unsigned char*)smem, S, E, DM, DM);
}
__device__ __forceinline__ void ph_gemm_moe2(const Params& p, int l) {
  const int crev = (((int)gridDim.x >> 3) - 1 - ((int)blockIdx.x >> 3)) * 8 + ((int)blockIdx.x & 7);
  g8::MoeSrc<false> S{p.alist(), p.hid(), p.W2T(), 512, 512, (int)gridDim.x, crev, (size_t)DM * 512, p.mflag() + l * 2048};
  g8::EpiMoe2 E{p.ybuf(), p.rw(), p.alist(), p.aslot()};
  g8::gemm_stream((LAS unsigned char*)smem, S, E, 512, 512);
}

template <int l>
__device__ __forceinline__ void layer_body(const Params& p, const XcdBarrier& xb) {
    const int lo = (l == 1) ? NCTX : 0;
    ph_norm1(p, l);
    xcd_barrier(xb);
    ph_gemm_zmix(p, l);
    xcd_barrier(xb);
    for (int t = blockIdx.x; t < 256; t += gridDim.x) hyena_fft_task(p, l, t);
    if (l == 0) for (int t = blockIdx.x; t < 512; t += gridDim.x) hyena_task(p, l, CTXL, 0, t >> 8, t & 255, p.hrawc(), p.hscalec());
    __syncthreads();
    ph_mix_tasks<false>(p, l);
    __syncthreads();
    ph_gemm_s5_pass1(p, l);
    xcd_barrier(xb);
    ph_scan(p, l);
    ph_s5_scan(p, l);
    xcd_barrier(xb);
    ph_mix_tasks<true>(p, l);
    __syncthreads();
    ph_gemm_s5_pass2(p, l);
    xcd_barrier(xb);
    ph_reads(p, l, lo);
    xcd_barrier(xb);
    ph_gemm_gates_glu(p, l, lo);
    xcd_barrier(xb);
    ph_gemm_merge(p, l, lo);
    if (l == 1 || (int)blockIdx.x >= 8) { __syncthreads(); ph_cvt_moe(p, l, 1, l == 1 ? blockIdx.x : blockIdx.x - 8, l == 1 ? gridDim.x : gridDim.x - 8); }
    __syncthreads();
    ph_gemm_wout(p, l, lo);
    { const int cw = l == 1 ? (int)blockIdx.x : (int)((blockIdx.x + gridDim.x - 8) % gridDim.x);
      if (l == 1 || cw >= 8) { __syncthreads(); ph_cvt_moe(p, l, 2, l == 1 ? cw : cw - 8, l == 1 ? gridDim.x : gridDim.x - 8); } }
    xcd_barrier(xb);
    ph_router(p, l, lo);
    xcd_barrier(xb);
    ph_gemm_moe1(p, l);
    ph_gemm_moe2(p, l);
    xcd_barrier(xb);
}

__global__ void __launch_bounds__(NTHREADS) mega(Params p) {
  cg::grid_group grid = cg::this_grid();
  volatile LAS unsigned* st = (volatile LAS unsigned*)((LAS unsigned char*)smem + LDS_FFT_BYTES);
  if (threadIdx.x == 0) { st[0] = 0u; st[1] = 0u; st[2] = 0u; st[3] = 0u; }
  __syncthreads();
  const XcdBarrier xb = xcd_barrier_post(p.xbar(), st);
  ph_setup1(p);
  ph_cvt_static(p);
  grid.sync();
  ph_setup2(p);
  __syncthreads();
  ph_setup_s5(p);
  xcd_barrier(xb);
  layer_body<0>(p, xb);
  layer_body<1>(p, xb);
  ph_final(p);
}

static inline size_t al256(size_t x) { return (x + 255) & ~(size_t)255; }

extern "C" void kernel_launch(void* const* d_in, const int* in_sizes, int n_in, void* d_out, int out_size, void* d_ws, size_t ws_size,
                              hipStream_t stream) {
  static int grid_blocks = 0;
  if (grid_blocks == 0) {
    int dev = 0, cus = 0, per_cu = 0;
    (void)hipGetDevice(&dev);
    (void)hipDeviceGetAttribute(&cus, hipDeviceAttributeMultiprocessorCount, dev);
    (void)hipFuncSetAttribute((const void*)mega, hipFuncAttributeMaxDynamicSharedMemorySize, LDS_BYTES);
    (void)hipOccupancyMaxActiveBlocksPerMultiprocessor(&per_cu, (const void*)mega, NTHREADS, LDS_BYTES);
    if (per_cu < 1) { fprintf(stderr, "kernel_launch: occupancy query says %d blocks/CU\n", per_cu); per_cu = 1; }
    if (per_cu > 1) per_cu = 1;
    grid_blocks = cus * per_cu;
  }
  Params p{};
  for (int i = 0; i < N_INPUTS; ++i) p.in[i] = (const float*)d_in[i];
  p.out = (float*)d_out;
  p.ws = (char*)d_ws;
  if (WS.total > ws_size) { fprintf(stderr, "kernel_launch: workspace too small: need %zu have %zu\n", (size_t)WS.total, ws_size); return; }
  (void)hipMemsetAsync(p.ws + WS.xbar, 0, XCD_BAR_WORDS * 4, stream);
  void* args[] = {&p};
  hipError_t e = hipLaunchCooperativeKernel((const void*)mega, dim3(grid_blocks), dim3(NTHREADS), args, LDS_BYTES, stream);
  if (e != hipSuccess) fprintf(stderr, "kernel_launch: cooperative launch failed: %s (grid %d)\n", hipGetErrorString(e), grid_blocks);
}
```
